# Optimizing an MI355X kernel written in HIP

```python
import jax, jax.numpy as jnp
from jax import lax
import numpy as np

D_MODEL = 1024
BATCH = 2
SEQ = 16384
DEPTH = 2

N_EVEN = (DEPTH + 1) // 2
N_ODD = DEPTH // 2

POOL_DIM = D_MODEL // 2
POOL_WINDOWS = (2, 4, 8, 16)
N_POOL_GROUPS = len(POOL_WINDOWS)
POOL_GROUP_DIM = POOL_DIM // N_POOL_GROUPS

MLA_HEADS = 8
QK_NOPE_DIM = 64
QK_ROPE_DIM = 32
QK_DIM = QK_NOPE_DIM + QK_ROPE_DIM
V_HEAD_DIM = 64
Q_LORA_RANK = 256
KV_LORA_RANK = 128
ROPE_BASE = 10000.0
Q_BLOCK = 128

EVEN_IN_DIM = POOL_DIM + Q_LORA_RANK + KV_LORA_RANK + QK_ROPE_DIM
EVEN_MIX_DIM = POOL_DIM + MLA_HEADS * V_HEAD_DIM

LRU_WIDTH = D_MODEL
LRU_HEADS = 4
LRU_HEAD_DIM = LRU_WIDTH // LRU_HEADS
CONV_WIDTH = 4
LRU_C = 8.0

MEM_TOKENS = 256
MEM_HEADS = 4
MEM_HEAD_DIM = D_MODEL // MEM_HEADS

D_FF = -(-8 * D_MODEL // (3 * 256)) * 256

RMS_EPS = 1e-6
NEG_INF = -1e30

kernel_name = "hybrid_pool_mla_rglru_memxattn"


def rms_norm(x, g):
    xf = x.astype(jnp.float32)
    y = xf * lax.rsqrt(jnp.mean(xf * xf, axis=-1, keepdims=True) + RMS_EPS)
    return (y * g).astype(x.dtype)


def rope_tables(positions):
    inv_freq = ROPE_BASE ** (-jnp.arange(0, QK_ROPE_DIM, 2, dtype=jnp.float32) / QK_ROPE_DIM)
    ang = positions.astype(jnp.float32)[..., None] * inv_freq
    return jnp.cos(ang), jnp.sin(ang)


def apply_rope(t, cos, sin):
    t1, t2 = jnp.split(t.astype(jnp.float32), 2, axis=-1)
    out = jnp.concatenate([t1 * cos - t2 * sin, t2 * cos + t1 * sin], axis=-1)
    return out.astype(t.dtype)


def pool_mixer(u, pool_w, pool_scale):
    B, S, _ = u.shape
    ug = u.reshape(B, S, N_POOL_GROUPS, POOL_GROUP_DIM)
    uf = ug.astype(jnp.float32)
    csum = jnp.concatenate([jnp.zeros((B, 1, N_POOL_GROUPS, POOL_GROUP_DIM), jnp.float32),
                            jnp.cumsum(uf, axis=1)], axis=1)
    t = jnp.arange(S)
    means = []
    for g, w in enumerate(POOL_WINDOWS):
        lo = jnp.maximum(t + 1 - w, 0)
        win_sum = csum[:, 1:, g] - csum[:, lo, g]
        cnt = jnp.minimum(t + 1, w).astype(jnp.float32)
        means.append(win_sum / cnt[None, :, None])
    pooled = (jnp.stack(means, axis=2) - uf).astype(u.dtype)
    y = jnp.einsum('bsgc,gcd->bsgd', pooled, pool_w).reshape(B, S, POOL_DIM)
    return y * pool_scale.astype(y.dtype)


def mla_causal_attention(q_nope, q_rope, k_nope, k_rope, v):
    B, S, H, _ = q_nope.shape
    nb = S // Q_BLOCK
    qn = q_nope.reshape(B, nb, Q_BLOCK, H, QK_NOPE_DIM).transpose(1, 0, 2, 3, 4)
    qr = q_rope.reshape(B, nb, Q_BLOCK, H, QK_ROPE_DIM).transpose(1, 0, 2, 3, 4)
    starts = jnp.arange(nb, dtype=jnp.int32) * Q_BLOCK
    kpos = jnp.arange(S, dtype=jnp.int32)
    scale = QK_DIM ** -0.5

    def one_block(args):
        qn_b, qr_b, start = args
        s = (jnp.einsum('bqhd,bkhd->bhqk', qn_b, k_nope).astype(jnp.float32)
             + jnp.einsum('bqhr,bkr->bhqk', qr_b, k_rope).astype(jnp.float32)) * scale
        qpos = start + jnp.arange(Q_BLOCK, dtype=jnp.int32)
        mask = kpos[None, :] <= qpos[:, None]
        s = jnp.where(mask[None, None], s, NEG_INF)
        p = jax.nn.softmax(s, axis=-1).astype(v.dtype)
        return jnp.einsum('bhqk,bkhd->bqhd', p, v)

    out = lax.map(one_block, (qn, qr, starts))
    return out.transpose(1, 0, 2, 3, 4).reshape(B, S, H * V_HEAD_DIM)


def even_mixer(h, cos, sin, w_in, pool_w, pool_scale, q_norm, w_q_up, kv_norm, w_kv_up, w_out):
    B, S, _ = h.shape
    z = h @ w_in
    u, cq, ckv, kr = jnp.split(z, [POOL_DIM, POOL_DIM + Q_LORA_RANK,
                                   POOL_DIM + Q_LORA_RANK + KV_LORA_RANK], axis=-1)
    y_pool = pool_mixer(u, pool_w, pool_scale)
    q = (rms_norm(cq, q_norm) @ w_q_up).reshape(B, S, MLA_HEADS, QK_DIM)
    q_nope, q_rope = jnp.split(q, [QK_NOPE_DIM], axis=-1)
    kv = (rms_norm(ckv, kv_norm) @ w_kv_up).reshape(B, S, MLA_HEADS, QK_NOPE_DIM + V_HEAD_DIM)
    k_nope, v = jnp.split(kv, [QK_NOPE_DIM], axis=-1)
    q_rope = apply_rope(q_rope, cos[:, :, None, :], sin[:, :, None, :])
    k_rope = apply_rope(kr, cos, sin)
    y_att = mla_causal_attention(q_nope, q_rope, k_nope, k_rope, v)
    return jnp.concatenate([y_pool, y_att], axis=-1) @ w_out


def causal_depthwise_conv(xb, conv_w, conv_b):
    y = lax.conv_general_dilated(xb, conv_w[:, None, :].astype(xb.dtype), window_strides=(1,),
                                 padding=((CONV_WIDTH - 1, 0),),
                                 dimension_numbers=('NWC', 'WIO', 'NWC'),
                                 feature_group_count=xb.shape[-1])
    return y + conv_b.astype(y.dtype)


def linear_scan_combine(c1, c2):
    a1, b1 = c1
    a2, b2 = c2
    return a1 * a2, a2 * b1 + b2


def odd_mixer(h, reset, w_in, conv_w, conv_b, w_rgate, b_rgate, w_igate, b_igate, lam, w_out):
    B, S, _ = h.shape
    z = h @ w_in
    gate_branch, xb = jnp.split(z, [LRU_WIDTH], axis=-1)
    xb = causal_depthwise_conv(xb, conv_w, conv_b)
    xg = xb.reshape(B, S, LRU_HEADS, LRU_HEAD_DIM)
    r = jax.nn.sigmoid(jnp.einsum('bshc,hcd->bshd', xg, w_rgate).reshape(B, S, LRU_WIDTH) + b_rgate)
    i = jax.nn.sigmoid(jnp.einsum('bshc,hcd->bshd', xg, w_igate).reshape(B, S, LRU_WIDTH) + b_igate)
    log_a = -LRU_C * r.astype(jnp.float32) * jax.nn.softplus(-lam.astype(jnp.float32))
    a = jnp.exp(log_a)
    mult = jnp.sqrt(jnp.maximum(-jnp.expm1(2.0 * log_a), 0.0))
    a = jnp.where(reset, 0.0, a)
    mult = jnp.where(reset, 1.0, mult)
    b = mult * (i * xb).astype(jnp.float32)
    _, hseq = lax.associative_scan(linear_scan_combine, (a, b), axis=1)
    y = jax.nn.gelu(gate_branch) * hseq.astype(h.dtype)
    return y @ w_out


def mem_cross_attention(h, mem, norm_mem, w_q, w_kv, w_o):
    B, S, _ = h.shape
    m = rms_norm(mem, norm_mem)
    q = (h @ w_q).reshape(B, S, MEM_HEADS, MEM_HEAD_DIM)
    k, v = jnp.split(m @ w_kv, 2, axis=-1)
    k = k.reshape(B, -1, MEM_HEADS, MEM_HEAD_DIM)
    v = v.reshape(B, -1, MEM_HEADS, MEM_HEAD_DIM)
    s = jnp.einsum('bqhd,bkhd->bhqk', q, k).astype(jnp.float32) * (MEM_HEAD_DIM ** -0.5)
    p = jax.nn.softmax(s, axis=-1).astype(v.dtype)
    o = jnp.einsum('bhqk,bkhd->bqhd', p, v).reshape(B, S, D_MODEL)
    return o @ w_o


def swiglu(h, w_gate_up, w_down):
    g, u = jnp.split(h @ w_gate_up, 2, axis=-1)
    return (jax.nn.silu(g) * u) @ w_down


def setup_inputs(seed: int = 0) -> dict:
    key = jax.random.key(seed)
    ks = iter(jax.random.split(key, 48))
    f32 = jnp.float32

    def w(shape, fan_in):
        return jax.random.normal(next(ks), shape, f32) * fan_in ** -0.5

    def gain(shape):
        return 1.0 + 0.02 * jax.random.normal(next(ks), shape, f32)

    def bias(shape):
        return 0.02 * jax.random.normal(next(ks), shape, f32)

    E, O, L = N_EVEN, N_ODD, DEPTH
    x = jax.random.normal(next(ks), (BATCH, SEQ, D_MODEL), f32)
    mem = jax.random.normal(next(ks), (BATCH, MEM_TOKENS, D_MODEL), f32)
    positions = jnp.broadcast_to(jnp.arange(SEQ, dtype=jnp.int32), (BATCH, SEQ))
    a_c = jax.random.uniform(next(ks), (O, LRU_WIDTH), f32, 0.9, 0.999)
    s_l = a_c ** (1.0 / LRU_C)
    lam = jnp.log(s_l) - jnp.log1p(-s_l)
    return {
        "x": x,
        "mem": mem,
        "positions": positions,
        "ev_norm": gain((E, D_MODEL)),
        "ev_w_in": w((E, D_MODEL, EVEN_IN_DIM), D_MODEL),
        "ev_pool_w": w((E, N_POOL_GROUPS, POOL_GROUP_DIM, POOL_GROUP_DIM), POOL_GROUP_DIM),
        "ev_pool_scale": gain((E, POOL_DIM)),
        "ev_q_norm": gain((E, Q_LORA_RANK)),
        "ev_w_q_up": w((E, Q_LORA_RANK, MLA_HEADS * QK_DIM), Q_LORA_RANK),
        "ev_kv_norm": gain((E, KV_LORA_RANK)),
        "ev_w_kv_up": w((E, KV_LORA_RANK, MLA_HEADS * (QK_NOPE_DIM + V_HEAD_DIM)), KV_LORA_RANK),
        "ev_w_out": w((E, EVEN_MIX_DIM, D_MODEL), EVEN_MIX_DIM),
        "od_norm": gain((O, D_MODEL)),
        "od_w_in": w((O, D_MODEL, 2 * LRU_WIDTH), D_MODEL),
        "od_conv_w": w((O, CONV_WIDTH, LRU_WIDTH), CONV_WIDTH),
        "od_conv_b": bias((O, LRU_WIDTH)),
        "od_w_rgate": w((O, LRU_HEADS, LRU_HEAD_DIM, LRU_HEAD_DIM), LRU_HEAD_DIM),
        "od_b_rgate": bias((O, LRU_WIDTH)),
        "od_w_igate": w((O, LRU_HEADS, LRU_HEAD_DIM, LRU_HEAD_DIM), LRU_HEAD_DIM),
        "od_b_igate": bias((O, LRU_WIDTH)),
        "od_lambda": lam,
        "od_w_out": w((O, LRU_WIDTH, D_MODEL), LRU_WIDTH),
        "xa_norm_x": gain((L, D_MODEL)),
        "xa_norm_mem": gain((L, D_MODEL)),
        "xa_w_q": w((L, D_MODEL, D_MODEL), D_MODEL),
        "xa_w_kv": w((L, D_MODEL, 2 * D_MODEL), D_MODEL),
        "xa_w_o": w((L, D_MODEL, D_MODEL), D_MODEL),
        "ffn_norm": gain((L, D_MODEL)),
        "ffn_w_gate_up": w((L, D_MODEL, 2 * D_FF), D_MODEL),
        "ffn_w_down": w((L, D_FF, D_MODEL), D_FF),
        "final_norm": gain((D_MODEL,)),
    }


def reference(x, mem, positions,
              ev_norm, ev_w_in, ev_pool_w, ev_pool_scale, ev_q_norm, ev_w_q_up,
              ev_kv_norm, ev_w_kv_up, ev_w_out,
              od_norm, od_w_in, od_conv_w, od_conv_b, od_w_rgate, od_b_rgate,
              od_w_igate, od_b_igate, od_lambda, od_w_out,
              xa_norm_x, xa_norm_mem, xa_w_q, xa_w_kv, xa_w_o,
              ffn_norm, ffn_w_gate_up, ffn_w_down, final_norm):
    cos, sin = rope_tables(positions)
    reset = (positions == 0)[..., None]
    for layer in range(DEPTH):
        j = layer // 2
        if layer % 2 == 0:
            h = rms_norm(x, ev_norm[j])
            x = x + even_mixer(h, cos, sin, ev_w_in[j], ev_pool_w[j], ev_pool_scale[j],
                               ev_q_norm[j], ev_w_q_up[j], ev_kv_norm[j], ev_w_kv_up[j],
                               ev_w_out[j])
        else:
            h = rms_norm(x, od_norm[j])
            x = x + odd_mixer(h, reset, od_w_in[j], od_conv_w[j], od_conv_b[j],
                              od_w_rgate[j], od_b_rgate[j], od_w_igate[j], od_b_igate[j],
                              od_lambda[j], od_w_out[j])
        x = x + mem_cross_attention(rms_norm(x, xa_norm_x[layer]), mem, xa_norm_mem[layer],
                                    xa_w_q[layer], xa_w_kv[layer], xa_w_o[layer])
        x = x + swiglu(rms_norm(x, ffn_norm[layer]), ffn_w_gate_up[layer], ffn_w_down[layer])
    return rms_norm(x, final_norm)
```

```cpp
#include <hip/hip_runtime.h>
#include <hip/hip_cooperative_groups.h>
#include <cstdio>
#include <cstdint>
namespace cg = cooperative_groups;

#define LAS __attribute__((address_space(3)))
typedef unsigned short bf16;
typedef short bf16x8 __attribute__((ext_vector_type(8)));
typedef short s16x4 __attribute__((ext_vector_type(4)));
typedef float f32x4 __attribute__((ext_vector_type(4)));
typedef float f32x2 __attribute__((ext_vector_type(2)));
typedef float f32x16 __attribute__((ext_vector_type(16)));
typedef unsigned u32x4 __attribute__((ext_vector_type(4)));
typedef unsigned u32x2 __attribute__((ext_vector_type(2)));

constexpr int SEQ = 16384, BATCH = 2, M = BATCH * SEQ, D = 1024;
constexpr int DFF = 2816;
constexpr float RMS_EPS = 1e-6f;
constexpr float LOG2E = 1.4426950408889634f;
constexpr int NTHREADS = 512, NWAVES = 8;
constexpr int RING_BYTES = 131072, LDS_BYTES = 147456, EPI_OFF = RING_BYTES;

typedef __bf16 bf16x2_t __attribute__((ext_vector_type(2)));
__device__ __forceinline__ unsigned pk2(float lo, float hi) { f32x2 v = {lo, hi}; bf16x2_t b = __builtin_convertvector(v, bf16x2_t); return __builtin_bit_cast(unsigned, b); }
__device__ __forceinline__ float bflo(unsigned w) { return __uint_as_float(w << 16); }
__device__ __forceinline__ float bfhi(unsigned w) { return __uint_as_float(w & 0xffff0000u); }
__device__ __forceinline__ float ex2(float x) { return __builtin_amdgcn_exp2f(x); }
__device__ __forceinline__ float rcp(float x) { return __builtin_amdgcn_rcpf(x); }
__device__ __forceinline__ float sigmoidf_(float x) { return rcp(1.0f + ex2(-x * LOG2E)); }
__device__ __forceinline__ float gelu_tanh(float x) { const float u = 0.7978845608028654f * (x + 0.044715f * x * x * x); return x * sigmoidf_(2.0f * u); }
__device__ __forceinline__ float wave_sum(float v) {
#pragma unroll
    for (int o = 1; o < 64; o <<= 1) v += __shfl_xor(v, o);
    return v;
}
#define LDS_WAIT() asm volatile("s_waitcnt lgkmcnt(0)" ::: "memory")

namespace pg8 {
constexpr int BM = 256, BK = 64, HALF = 128, HTB = HALF * BK * 2, NXCD = 8, WGM = 8;
__host__ __device__ __forceinline__ int lds_byte(int r, int c) { const int st = (r >> 4) * 2 + (c >> 5), rr = r & 15, cc = c & 31, ob = rr * 64 + cc * 2; return st * 1024 + (ob ^ (((ob >> 9) & 1) << 5)); }
__host__ __device__ __forceinline__ void stage_rc(int b, int& R, int& C) { const int st = b / 1024, sb = b % 1024, swz = sb ^ (((sb >> 9) & 1) << 5); R = (st >> 1) * 16 + swz / 64; C = (st & 1) * 32 + (swz % 64) / 2; }
struct Unit { int pm, pn; };
struct Gemm { const bf16* A; const bf16* Bt; int Mr, N, K, lda, ldb; long a_pm_off, a_pn_off; int a_pn_shift; long b_pn_off; int b_pm_div; long b_pm_off; };
__device__ __forceinline__ Gemm mk(const bf16* A, const bf16* Bt, int Mr, int N, int K) {
    Gemm g; g.A = A; g.Bt = Bt; g.Mr = Mr; g.N = N; g.K = K; g.lda = K; g.ldb = K; g.a_pm_off = 256L * K; g.a_pn_off = 0; g.a_pn_shift = 0; g.b_pn_off = 256L * K; g.b_pm_div = 1 << 30; g.b_pm_off = 0; return g; }
struct StaticOrder {
    int nM, nN, nwg, G, c;
    __device__ void init(int Mr, int N, int G_, int c_) { nM = Mr / BM; nN = N / BM; nwg = nM * nN; G = G_; c = c_; }
    __device__ bool next(int i, Unit& u) const {
        const long L = (long)i * G + c; if (L >= nwg) return false;
        int wgid = (int)L; { const int q = nwg / NXCD, r = nwg % NXCD, xcd = wgid % NXCD, off = wgid / NXCD; wgid = (xcd < r ? xcd * (q + 1) : r * (q + 1) + (xcd - r) * q) + off; }
        const int nig = WGM * nN, gid = wgid / nig, fm = gid * WGM, gsz = (nM - fm) < WGM ? (nM - fm) : WGM;
        u.pm = fm + ((wgid % nig) % gsz); u.pn = (wgid % nig) / gsz; return true;
    }
};

enum { E_PLAIN = 0, E_EVIN, E_QROPE, E_POOL, E_RES, E_SOFTMAX, E_SWIGLU, E_ODIN, E_GATE, E_VT };
struct Epi {
    int mode;
    bf16* O; int ldc; float scale;
    bf16 *O2, *O3, *O4;
    const float* base; float* out;
    const float *cosT, *sinT;
    const float *vec0, *vec1, *vec2;
    const int* pos;
    const bf16* xb; float* aout;
};
__device__ __forceinline__ void st8(bf16* p, f32x4 v0, f32x4 v1) { u32x4 w; w.x = pk2(v0[0], v0[1]); w.y = pk2(v0[2], v0[3]); w.z = pk2(v1[0], v1[1]); w.w = pk2(v1[2], v1[3]); *(u32x4*)p = w; }
__device__ __forceinline__ void st4(bf16* p, f32x4 v) { u32x2 w; w.x = pk2(v[0], v[1]); w.y = pk2(v[2], v[3]); *(u32x2*)p = w; }

__device__ __forceinline__ void run_epi(const Epi& E, f32x4 (&acc)[2][2][4][2], const Unit& u, int wr, int wc, int fr, int fq, LAS unsigned char* lds) {
    const int rowb = u.pm * BM + wr * 64 + fr, colb = u.pn * BM + wc * 32 + 4 * fq;
    const int colp = u.pn * BM + wc * 32 + 8 * fq;
    switch (E.mode) {
    case E_PLAIN: {
#pragma unroll
        for (int ai = 0; ai < 2; ++ai)
#pragma unroll
            for (int m = 0; m < 4; ++m) { const size_t row = (size_t)(rowb + ai * HALF + m * 16); bf16* rp = E.O + row * E.ldc + colp;
                float sc = E.scale; if (E.vec0) sc *= rsqrtf(E.vec0[row] * (1.f / D) + RMS_EPS);
#pragma unroll
                for (int bj = 0; bj < 2; ++bj) st8(rp + bj * HALF, acc[ai][bj][m][0] * sc, acc[ai][bj][m][1] * sc); }
    } break;
    case E_EVIN: {
        const int pn = u.pn;
#pragma unroll
        for (int ai = 0; ai < 2; ++ai)
#pragma unroll
            for (int m = 0; m < 4; ++m) { const size_t row = (size_t)(rowb + ai * HALF + m * 16);
                if (pn < 2) { bf16* rp = E.O + row * 512 + colb;
#pragma unroll
                    for (int bj = 0; bj < 2; ++bj)
#pragma unroll
                        for (int n = 0; n < 2; ++n) st4(rp + bj * HALF + n * 16, acc[ai][bj][m][n]);
                } else if (pn == 2) { bf16* rp = E.O2 + row * 256 + (colb - 512);
#pragma unroll
                    for (int bj = 0; bj < 2; ++bj)
#pragma unroll
                        for (int n = 0; n < 2; ++n) st4(rp + bj * HALF + n * 16, acc[ai][bj][m][n]);
                } else { bf16* rp = E.O3 + row * 128 + (colb - 768);
#pragma unroll
                    for (int n = 0; n < 2; ++n) st4(rp + n * 16, acc[ai][0][m][n]);
                    if (wc == 0) { const f32x4 c = *(const f32x4*)(E.cosT + row * 16 + 4 * fq), s = *(const f32x4*)(E.sinT + row * 16 + 4 * fq);
                        const f32x4 v0 = acc[ai][1][m][0], v1 = acc[ai][1][m][1];
                        st4(E.O4 + row * 32 + 4 * fq, v0 * c - v1 * s); st4(E.O4 + row * 32 + 16 + 4 * fq, v1 * c + v0 * s); }
                } }
    } break;
    case E_QROPE: {
#pragma unroll
        for (int bj = 0; bj < 2; ++bj) { const int cb = u.pn * BM + bj * HALF + wc * 32; const bool rope = (cb % 96) == 64;
#pragma unroll
            for (int ai = 0; ai < 2; ++ai)
#pragma unroll
                for (int m = 0; m < 4; ++m) { const size_t row = (size_t)(rowb + ai * HALF + m * 16); bf16* rp = E.O + row * 768 + cb + 4 * fq;
                    f32x4 v0 = acc[ai][bj][m][0] * E.scale, v1 = acc[ai][bj][m][1] * E.scale;
                    if (rope) { const f32x4 c = *(const f32x4*)(E.cosT + row * 16 + 4 * fq), s = *(const f32x4*)(E.sinT + row * 16 + 4 * fq);
                        const f32x4 o0 = v0 * c - v1 * s, o1 = v1 * c + v0 * s; v0 = o0; v1 = o1; }
                    st4(rp, v0); st4(rp + 16, v1); } }
    } break;
    case E_POOL: {
#pragma unroll
        for (int bj = 0; bj < 2; ++bj) { const int col = colp + bj * HALF; const f32x4 s0 = *(const f32x4*)(E.vec0 + col), s1 = *(const f32x4*)(E.vec0 + col + 4);
#pragma unroll
            for (int ai = 0; ai < 2; ++ai)
#pragma unroll
                for (int m = 0; m < 4; ++m) st8(E.O + (size_t)(rowb + ai * HALF + m * 16) * E.ldc + col, acc[ai][bj][m][0] * s0, acc[ai][bj][m][1] * s1); }
    } break;
    case E_RES: {
#pragma unroll
        for (int ai = 0; ai < 2; ++ai) {
            f32x4 bs[4][2][2];
#pragma unroll
            for (int m = 0; m < 4; ++m) { const size_t off = (size_t)(rowb + ai * HALF + m * 16) * D + colp;
#pragma unroll
                for (int bj = 0; bj < 2; ++bj)
#pragma unroll
                    for (int n = 0; n < 2; ++n) bs[m][bj][n] = *(const f32x4*)(E.base + off + bj * HALF + n * 4); }
#pragma unroll
            for (int m = 0; m < 4; ++m) { const size_t row = (size_t)(rowb + ai * HALF + m * 16); const size_t off = row * D + colp; float q = 0.f;
#pragma unroll
                for (int bj = 0; bj < 2; ++bj) { const f32x4 o0 = bs[m][bj][0] + acc[ai][bj][m][0], o1 = bs[m][bj][1] + acc[ai][bj][m][1];
                    *(f32x4*)(E.out + off + bj * HALF) = o0; *(f32x4*)(E.out + off + bj * HALF + 4) = o1;
                    if (E.O) st8(E.O + off + bj * HALF, o0, o1);
                    q += (o0[0] * o0[0] + o0[1] * o0[1]) + (o0[2] * o0[2] + o0[3] * o0[3]) + (o1[0] * o1[0] + o1[1] * o1[1]) + (o1[2] * o1[2] + o1[3] * o1[3]); }
                q += __shfl_xor(q, 16); q += __shfl_xor(q, 32);
                if (fq == 0) atomicAdd(E.aout + row, q); }
            asm volatile("" ::: "memory"); }
    } break;
    case E_SOFTMAX: {
        LAS float* RM = (LAS float*)(lds + EPI_OFF);
        LAS float* RS = (LAS float*)(lds + EPI_OFF + 4096);
#pragma unroll
        for (int ai = 0; ai < 2; ++ai)
#pragma unroll
            for (int m = 0; m < 4; ++m) { float mx = -3.0e38f;
#pragma unroll
                for (int bj = 0; bj < 2; ++bj)
#pragma unroll
                    for (int n = 0; n < 2; ++n) { const f32x4 x = acc[ai][bj][m][n]; mx = fmaxf(mx, fmaxf(fmaxf(x[0], x[1]), fmaxf(x[2], x[3]))); }
                mx = fmaxf(mx, __shfl_xor(mx, 16)); mx = fmaxf(mx, __shfl_xor(mx, 32));
                if (fq == 0) RM[(ai * HALF + wr * 64 + m * 16 + fr) * 4 + wc] = mx; }
        LDS_WAIT(); __builtin_amdgcn_s_barrier(); asm volatile("" ::: "memory");
#pragma unroll
        for (int ai = 0; ai < 2; ++ai)
#pragma unroll
            for (int m = 0; m < 4; ++m) { const int rl = ai * HALF + wr * 64 + m * 16 + fr; const f32x4 mm = *(LAS f32x4*)(RM + rl * 4);
                const float mx = fmaxf(fmaxf(mm[0], mm[1]), fmaxf(mm[2], mm[3])); float s = 0.f;
#pragma unroll
                for (int bj = 0; bj < 2; ++bj)
#pragma unroll
                    for (int n = 0; n < 2; ++n) { f32x4 x = acc[ai][bj][m][n]; x[0] = ex2(x[0] - mx); x[1] = ex2(x[1] - mx); x[2] = ex2(x[2] - mx); x[3] = ex2(x[3] - mx); acc[ai][bj][m][n] = x; s += (x[0] + x[1]) + (x[2] + x[3]); }
                s += __shfl_xor(s, 16); s += __shfl_xor(s, 32);
                if (fq == 0) RS[rl * 4 + wc] = s; }
        LDS_WAIT(); __builtin_amdgcn_s_barrier(); asm volatile("" ::: "memory");
#pragma unroll
        for (int ai = 0; ai < 2; ++ai)
#pragma unroll
            for (int m = 0; m < 4; ++m) { const int rl = ai * HALF + wr * 64 + m * 16 + fr; const f32x4 ss = *(LAS f32x4*)(RS + rl * 4);
                const float inv = rcp((ss[0] + ss[1]) + (ss[2] + ss[3])); bf16* rp = E.O + (size_t)(u.pm * BM + rl) * E.ldc + colp;
#pragma unroll
                for (int bj = 0; bj < 2; ++bj) st8(rp + bj * HALF, acc[ai][bj][m][0] * inv, acc[ai][bj][m][1] * inv); }
    } break;
    case E_SWIGLU: {
        const int colh = u.pn * HALF + wc * 32 + 8 * fq;
#pragma unroll
        for (int ai = 0; ai < 2; ++ai)
#pragma unroll
            for (int m = 0; m < 4; ++m) { const size_t row = (size_t)(rowb + ai * HALF + m * 16); const float rs = rsqrtf(E.vec0[row] * (1.f / D) + RMS_EPS); f32x4 o[2];
#pragma unroll
                for (int n = 0; n < 2; ++n) { const f32x4 g = acc[ai][0][m][n] * rs, uu = acc[ai][1][m][n] * rs;
#pragma unroll
                    for (int e = 0; e < 4; ++e) o[n][e] = g[e] * sigmoidf_(g[e]) * uu[e]; }
                st8(E.O + row * DFF + colh, o[0], o[1]); }
    } break;
    case E_ODIN: {
        const bool isg = u.pn < 4;
#pragma unroll
        for (int ai = 0; ai < 2; ++ai)
#pragma unroll
            for (int m = 0; m < 4; ++m) { const size_t row = (size_t)(rowb + ai * HALF + m * 16); const float rs = rsqrtf(E.vec0[row] * (1.f / D) + RMS_EPS);
                bf16* rp = (isg ? E.O + row * D + colp : E.O2 + row * D + (colp - D));
#pragma unroll
                for (int bj = 0; bj < 2; ++bj) { f32x4 v0 = acc[ai][bj][m][0] * rs, v1 = acc[ai][bj][m][1] * rs;
                    if (isg) {
#pragma unroll
                        for (int e = 0; e < 4; ++e) { v0[e] = gelu_tanh(v0[e]); v1[e] = gelu_tanh(v1[e]); } }
                    st8(rp + bj * HALF, v0, v1); } }
    } break;
    case E_GATE: {
        const int c = (u.pn >> 1) * 256 + (u.pn & 1) * HALF + wc * 32 + 8 * fq;
        f32x4 br[2], bi[2], sp[2];
#pragma unroll
        for (int n = 0; n < 2; ++n) { br[n] = *(const f32x4*)(E.vec0 + c + 4 * n); bi[n] = *(const f32x4*)(E.vec1 + c + 4 * n); sp[n] = *(const f32x4*)(E.vec2 + c + 4 * n); }
#pragma unroll
        for (int ai = 0; ai < 2; ++ai)
#pragma unroll
            for (int m = 0; m < 4; ++m) { const size_t row = (size_t)(rowb + ai * HALF + m * 16); const bool rst = E.pos[row] == 0;
                const u32x4 xw = *(const u32x4*)(E.xb + row * D + c); const float xv[8] = {bflo(xw.x), bfhi(xw.x), bflo(xw.y), bfhi(xw.y), bflo(xw.z), bfhi(xw.z), bflo(xw.w), bfhi(xw.w)};
                f32x4 av[2], bv[2];
#pragma unroll
                for (int n = 0; n < 2; ++n) { const f32x4 pr = acc[ai][0][m][n] + br[n], pi = acc[ai][1][m][n] + bi[n];
#pragma unroll
                    for (int e = 0; e < 4; ++e) { const float r = sigmoidf_(pr[e]), ig = sigmoidf_(pi[e]); const float la = -sp[n][e] * r; float a = ex2(la * LOG2E);
                        const float x2 = 2.0f * la; const float om = (x2 > -0.01f) ? -(x2 + x2 * x2 * (0.5f + x2 * (1.0f / 6.0f))) : 1.0f - ex2(x2 * LOG2E);
                        float mult = sqrtf(fmaxf(om, 0.f)); if (rst) { a = 0.f; mult = 1.f; }
                        av[n][e] = a; bv[n][e] = mult * (ig * xv[4 * n + e]); } }
                *(f32x4*)(E.aout + row * D + c) = av[0]; *(f32x4*)(E.aout + row * D + c + 4) = av[1]; st8(E.O + row * D + c, bv[0], bv[1]); }
    } break;
    case E_VT: {
#pragma unroll
        for (int ai = 0; ai < 2; ++ai)
#pragma unroll
            for (int m = 0; m < 4; ++m) { const size_t row = (size_t)(rowb + ai * HALF + m * 16);
#pragma unroll
                for (int bj = 0; bj < 2; ++bj) { const int col = colp + bj * HALF, b16 = col & ~15, hf = (col >> 3) & 1; bf16* rp = E.O + row * E.ldc + b16 + 4 * hf;
                    st4(rp, acc[ai][bj][m][0]); st4(rp + 8, acc[ai][bj][m][1]); } }
    } break;
    default: break;
    }
}

__device__ __forceinline__ void gemm_phase(LAS unsigned char* lds, const Gemm g, const StaticOrder& S, const Epi& E, const int tid) {
    const int wid = __builtin_amdgcn_readfirstlane(tid >> 6), lane = tid & 63, wr = wid >> 2, wc = wid & 3, fr = lane & 15, fq = lane >> 4;
    const int K = g.K, nt = K / BK;
    unsigned voffA, voffB;
    { int R, C; stage_rc(tid * 16, R, C); const bool perm = (E.mode != E_EVIN) && (E.mode != E_QROPE);
      const int rho = R & 31, Rb = perm ? ((R & ~31) + 8 * ((rho & 15) >> 2) + 4 * (rho >> 4) + (rho & 3)) : R;
      voffA = (unsigned)(R * g.lda + C) * 2u; voffB = (unsigned)(Rb * g.ldb + C) * 2u; }
    const size_t q64A = (size_t)64 * g.lda * 2, q64B = (size_t)64 * g.ldb * 2;
    const size_t kstep = (size_t)(BK * 2);
    const size_t hstepA = (size_t)HALF * g.lda * 2, hstepB = (size_t)HALF * g.ldb * 2;
    const unsigned ldsw = (unsigned)wid * 1024u;
    const int aoff = lds_byte(wr * 64 + fr, fq * 8), boff = lds_byte(wc * 32 + fr, fq * 8);
#define PG8_ABASE(u) ((const char*)g.A + ((size_t)(u).pm * g.a_pm_off + (size_t)((u).pn >> g.a_pn_shift) * g.a_pn_off) * 2)
#define PG8_BBASE(u) ((const char*)g.Bt + ((size_t)(u).pn * g.b_pn_off + (size_t)((u).pm / g.b_pm_div) * g.b_pm_off) * 2)
#define PG8_SA(b, h) (((b) * 2 + (h)) * HTB)
#define PG8_SB(b, h) ((4 + (b) * 2 + (h)) * HTB)
#define PG8_Q64(v) PG8_Q64_##v
#define PG8_Q64_voffA q64A
#define PG8_Q64_voffB q64B
#define PG8_STAGE(bufoff, gbase, voff) do { \
        __builtin_amdgcn_global_load_lds((const unsigned*)((const char*)(gbase) + (voff)), (LAS unsigned*)(lds + (bufoff) + ldsw), 16, 0, 0); \
        __builtin_amdgcn_global_load_lds((const unsigned*)((const char*)(gbase) + PG8_Q64(voff) + (voff)), (LAS unsigned*)(lds + (bufoff) + ldsw + 8192), 16, 0, 0); } while (0)
#define PG8_LDA(dst, b, h) do { _Pragma("unroll") for (int m = 0; m < 4; ++m) _Pragma("unroll") for (int k = 0; k < 2; ++k) dst[m][k] = *(const LAS bf16x8*)(lds + PG8_SA(b, h) + aoff + m * 2048 + k * 1024); } while (0)
#define PG8_LDB(dst, b, h) do { _Pragma("unroll") for (int n = 0; n < 2; ++n) _Pragma("unroll") for (int k = 0; k < 2; ++k) dst[n][k] = *(const LAS bf16x8*)(lds + PG8_SB(b, h) + boff + n * 2048 + k * 1024); } while (0)
#define PG8_MMA(ai, bj, At, Bt) do { __builtin_amdgcn_s_setprio(1); _Pragma("unroll") for (int m = 0; m < 4; ++m) _Pragma("unroll") for (int n = 0; n < 2; ++n) _Pragma("unroll") for (int k = 0; k < 2; ++k) \
        acc[ai][bj][m][n] = __builtin_amdgcn_mfma_f32_16x16x32_bf16(Bt[n][k], At[m][k], acc[ai][bj][m][n], 0, 0, 0); __builtin_amdgcn_s_setprio(0); } while (0)
#define PG8_WAIT_V(n) asm volatile("s_waitcnt vmcnt(" #n ")" ::: "memory")
#define PG8_WAIT_L(n) asm volatile("s_waitcnt lgkmcnt(" #n ")" ::: "memory")
#define PG8_BAR __builtin_amdgcn_s_barrier()
#define PG8_SCHED __builtin_amdgcn_sched_barrier(0)
    Unit cur, nxt; int ui = 0;
    if (!S.next(0, cur)) return;
    f32x4 acc[2][2][4][2];
#pragma unroll
    for (int a = 0; a < 2; ++a)
#pragma unroll
        for (int b = 0; b < 2; ++b)
#pragma unroll
            for (int m = 0; m < 4; ++m)
#pragma unroll
                for (int n = 0; n < 2; ++n) acc[a][b][m][n] = (f32x4){0.f, 0.f, 0.f, 0.f};
    bf16x8 At[4][2], B0[2][2], B1[2][2];
    const char* cA = PG8_ABASE(cur); const char* cB = PG8_BBASE(cur);
    PG8_STAGE(PG8_SB(0, 0), cB, voffB); PG8_STAGE(PG8_SB(0, 1), cB + hstepB, voffB); PG8_STAGE(PG8_SA(0, 0), cA, voffA); PG8_STAGE(PG8_SA(0, 1), cA + hstepA, voffA);
    if (wr == 1) PG8_BAR;
    PG8_WAIT_V(2); PG8_BAR;
    PG8_STAGE(PG8_SB(1, 0), cB + kstep, voffB); PG8_STAGE(PG8_SA(1, 0), cA + kstep, voffA); PG8_STAGE(PG8_SB(1, 1), cB + hstepB + kstep, voffB);
    PG8_WAIT_V(6); PG8_BAR;
    for (;;) {
        const bool has_next = S.next(ui + 1, nxt);
        const char* nA = has_next ? PG8_ABASE(nxt) : cA; const char* nB = has_next ? PG8_BBASE(nxt) : cB;
        for (int t = 0; t < nt; t += 2) {
            const bool last = (t == nt - 2);
            const char* a1 = cA + (size_t)(t + 1) * kstep;
            const char* a2 = last ? nA : cA + (size_t)(t + 2) * kstep; const char* b2 = last ? nB : cB + (size_t)(t + 2) * kstep;
            const char* a3 = a2 + kstep; const char* b3 = b2 + kstep;
            PG8_LDB(B0, 0, 0); PG8_LDB(B1, 0, 1); PG8_SCHED; PG8_LDA(At, 0, 0); PG8_STAGE(PG8_SA(1, 1), a1 + hstepA, voffA);
            PG8_WAIT_V(8); PG8_WAIT_L(0); PG8_BAR; PG8_MMA(0, 0, At, B0); PG8_MMA(0, 1, At, B1); PG8_BAR; PG8_SCHED;
            PG8_LDA(At, 0, 1); PG8_STAGE(PG8_SB(0, 0), b2, voffB); PG8_STAGE(PG8_SB(0, 1), b2 + hstepB, voffB); PG8_STAGE(PG8_SA(0, 0), a2, voffA);
            PG8_WAIT_V(8); PG8_WAIT_L(0); PG8_BAR; PG8_MMA(1, 0, At, B0); PG8_MMA(1, 1, At, B1); PG8_BAR; PG8_SCHED;
            PG8_LDB(B0, 1, 0); PG8_LDB(B1, 1, 1); PG8_SCHED; PG8_LDA(At, 1, 0); PG8_STAGE(PG8_SA(0, 1), a2 + hstepA, voffA);
            PG8_WAIT_V(8); PG8_WAIT_L(0); PG8_BAR; PG8_MMA(0, 0, At, B0); PG8_MMA(0, 1, At, B1); PG8_BAR; PG8_SCHED;
            PG8_LDA(At, 1, 1); PG8_STAGE(PG8_SB(1, 0), b3, voffB); PG8_STAGE(PG8_SB(1, 1), b3 + hstepB, voffB); PG8_STAGE(PG8_SA(1, 0), a3, voffA);
            PG8_WAIT_V(8); PG8_WAIT_L(0); PG8_BAR; PG8_MMA(1, 0, At, B0); PG8_MMA(1, 1, At, B1); PG8_BAR; PG8_SCHED;
        }
        if (wr == 0) PG8_BAR;
        run_epi(E, acc, cur, wr, wc, fr, fq, lds);
        if (!has_next) break;
#pragma unroll
        for (int a = 0; a < 2; ++a)
#pragma unroll
            for (int b = 0; b < 2; ++b)
#pragma unroll
                for (int m = 0; m < 4; ++m)
#pragma unroll
                    for (int n = 0; n < 2; ++n) acc[a][b][m][n] = (f32x4){0.f, 0.f, 0.f, 0.f};
        cur = nxt; cA = nA; cB = nB; ++ui;
        if (wr == 1) PG8_BAR;
    }
    PG8_WAIT_V(0);
    PG8_BAR;
#undef PG8_ABASE
#undef PG8_BBASE
#undef PG8_SA
#undef PG8_SB
#undef PG8_STAGE
#undef PG8_Q64
#undef PG8_Q64_voffA
#undef PG8_Q64_voffB
#undef PG8_LDA
#undef PG8_LDB
#undef PG8_MMA
#undef PG8_WAIT_V
#undef PG8_WAIT_L
#undef PG8_BAR
#undef PG8_SCHED
}
}

namespace att {
#define ATT_BAR() do { asm volatile("s_waitcnt lgkmcnt(0)" ::: "memory"); __builtin_amdgcn_s_barrier(); asm volatile("" ::: "memory"); } while (0)
constexpr int KST_B = 208  , VST_B = 144  ;
constexpr int KBYTES = 64 * KST_B, VBYTES = 64 * VST_B, BUFB = KBYTES + VBYTES;
__device__ __forceinline__ int crow(int r, int hi) { return (r & 3) + 8 * (r >> 2) + 4 * hi; }
constexpr int NSLOT = 4, NPIECE = 22;
__device__ __forceinline__ void attn_unit(int b, int h, int qb, const bf16* Q, const bf16* KN, const bf16* KR, const bf16* VT, bf16* OUT, LAS unsigned char* lds, const int tid) {
    const int lane = tid & 63, r32 = lane & 31, hi = lane >> 5, wid = __builtin_amdgcn_readfirstlane(tid >> 6);
    const size_t rowbase = (size_t)b * SEQ; const int q0 = qb * 256; const int qrow = q0 + wid * 32 + r32;
    const int NT = (q0 + 256) / 64;
    const char* gp[3]; unsigned ginc[3];
#pragma unroll
    for (int i = 0; i < 3; ++i) { const int p = wid + 8 * i;
        if (p < 13) { const int c = p * 64 + lane, row = c / 13, c16 = c % 13;
            if (c16 >= 8 && c16 < 12) { gp[i] = (const char*)(KR + (rowbase + row) * 32 + (c16 - 8) * 8); ginc[i] = 64 * 32 * 2; }
            else { gp[i] = (const char*)(KN + (rowbase + row) * 512 + h * 64 + (c16 < 8 ? c16 : 0) * 8); ginc[i] = 64 * 512 * 2; } }
        else { const int c = ((p < NPIECE ? p : 13) - 13) * 64 + lane, d = c / 9, c16 = c % 9;
            gp[i] = (const char*)(VT + (size_t)(h * 64 + d) * M + rowbase + (c16 < 8 ? c16 : 0) * 8); ginc[i] = 64 * 2; } }
#define ATT_DMA(t) do { LAS unsigned char* sl_ = lds + ((t) & (NSLOT - 1)) * BUFB + wid * 1024; \
        __builtin_amdgcn_global_load_lds((const unsigned*)(gp[0] + (size_t)(t) * ginc[0]), (LAS unsigned*)(sl_), 16, 0, 0); \
        __builtin_amdgcn_global_load_lds((const unsigned*)(gp[1] + (size_t)(t) * ginc[1]), (LAS unsigned*)(sl_ + 8192), 16, 0, 0); \
        if (wid < NPIECE - 16) __builtin_amdgcn_global_load_lds((const unsigned*)(gp[2] + (size_t)(t) * ginc[2]), (LAS unsigned*)(sl_ + 16384), 16, 0, 0); } while (0)
    bf16x8 qr[6];
    { const bf16* qp = Q + (rowbase + qrow) * 768 + h * 96 + hi * 8;
#pragma unroll
      for (int ks = 0; ks < 6; ++ks) qr[ks] = *(const bf16x8*)(qp + ks * 16); }
    asm volatile("s_waitcnt vmcnt(0)" ::: "memory");
    ATT_DMA(0); ATT_DMA(1); ATT_DMA(2);
    f32x16 o0, o1;
#pragma unroll
    for (int r = 0; r < 16; ++r) { o0[r] = 0.f; o1[r] = 0.f; }
    float mrun = 0.f, lrun = 0.f;
    f32x16 negm;
#pragma unroll
    for (int r = 0; r < 16; ++r) negm[r] = 0.f;
    const int qmin = q0 + wid * 32;
    asm volatile("s_waitcnt vmcnt(4)" ::: "memory");
    ATT_BAR();
    if (wid >= 4) ATT_BAR();
#pragma unroll 1
    for (int t = 0; t < NT; ++t) {
        if (t + 3 < NT) ATT_DMA(t + 3);
        const int kv0 = t * 64;
        const bool active = kv0 <= qmin + 31;
        bf16x8 vf0[4], vf1[4]; f32x16 p0, p1;
        if (active) {
            const LAS unsigned char* buf = lds + (t & (NSLOT - 1)) * BUFB;
            const LAS unsigned char* kb = buf + r32 * KST_B + hi * 16;
            const LAS unsigned char* vb = buf + KBYTES + r32 * VST_B + hi * 16;
#pragma unroll
            for (int s = 0; s < 4; ++s) { vf0[s] = *(const LAS bf16x8*)(vb + s * 32); vf1[s] = *(const LAS bf16x8*)(vb + 32 * VST_B + s * 32); }
            __builtin_amdgcn_sched_barrier(0);
#pragma unroll
            for (int ks = 0; ks < 6; ++ks) { const bf16x8 a0 = *(const LAS bf16x8*)(kb + ks * 32), a1 = *(const LAS bf16x8*)(kb + 32 * KST_B + ks * 32);
                if (ks == 0) { p0 = __builtin_amdgcn_mfma_f32_32x32x16_bf16(a0, qr[0], negm, 0, 0, 0); p1 = __builtin_amdgcn_mfma_f32_32x32x16_bf16(a1, qr[0], negm, 0, 0, 0); }
                else { p0 = __builtin_amdgcn_mfma_f32_32x32x16_bf16(a0, qr[ks], p0, 0, 0, 0); p1 = __builtin_amdgcn_mfma_f32_32x32x16_bf16(a1, qr[ks], p1, 0, 0, 0); } }
        }
        if (t + 3 < NT) asm volatile("s_waitcnt vmcnt(4)" ::: "memory");
        else asm volatile("s_waitcnt vmcnt(0)" ::: "memory");
        ATT_BAR();
        if (active) {
            if (kv0 + 63 > qmin) {
#pragma unroll
                for (int r = 0; r < 16; ++r) { const int kv = kv0 + crow(r, hi); if (kv > qrow) p0[r] = -1e30f; if (kv + 32 > qrow) p1[r] = -1e30f; }
            }
            float mx = __builtin_amdgcn_fmed3f(p0[0], p1[0], __builtin_inff());
#pragma unroll
            for (int r = 1; r < 16; ++r) { mx = __builtin_amdgcn_fmed3f(mx, p0[r], __builtin_inff()); mx = __builtin_amdgcn_fmed3f(mx, p1[r], __builtin_inff()); }
            { auto rr = __builtin_amdgcn_permlane32_swap(__float_as_uint(mx), __float_as_uint(mx), false, false); mx = fmaxf(__uint_as_float(rr[0]), __uint_as_float(rr[1])); }
            const bool first = (t == 0);
            if (first || __builtin_amdgcn_ballot_w64(mx > 0.f) != 0ull) {
                const float d = first ? mx : fmaxf(mx, 0.f); mrun += d;
                if (!first) { const float alpha = ex2(-d); lrun *= alpha;
#pragma unroll
                    for (int r = 0; r < 16; ++r) { o0[r] *= alpha; o1[r] *= alpha; } }
#pragma unroll
                for (int r = 0; r < 16; ++r) { p0[r] -= d; p1[r] -= d; negm[r] = -mrun; }
            }
            float rs0 = 0.f, rs1 = 0.f;
#pragma unroll
            for (int r = 0; r < 16; ++r) { p0[r] = ex2(p0[r]); p1[r] = ex2(p1[r]); rs0 += p0[r]; asm volatile("" : "+v"(rs0)); rs1 += p1[r]; asm volatile("" : "+v"(rs1)); }
            lrun += rs0 + rs1;
            u32x4 pw[4];
#pragma unroll
            for (int j = 0; j < 4; ++j) { pw[0][j] = pk2(p0[2 * j], p0[2 * j + 1]); pw[1][j] = pk2(p0[8 + 2 * j], p0[8 + 2 * j + 1]); pw[2][j] = pk2(p1[2 * j], p1[2 * j + 1]); pw[3][j] = pk2(p1[8 + 2 * j], p1[8 + 2 * j + 1]); }
#pragma unroll
            for (int s = 0; s < 4; ++s) { const bf16x8 pf = __builtin_bit_cast(bf16x8, pw[s]);
                o0 = __builtin_amdgcn_mfma_f32_32x32x16_bf16(vf0[s], pf, o0, 0, 0, 0); o1 = __builtin_amdgcn_mfma_f32_32x32x16_bf16(vf1[s], pf, o1, 0, 0, 0); }
        }
        ATT_BAR();
    }
    if (wid < 4) ATT_BAR();
#undef ATT_DMA
    float ltot; { auto rr = __builtin_amdgcn_permlane32_swap(__float_as_uint(lrun), __float_as_uint(lrun), false, false); ltot = __uint_as_float(rr[0]) + __uint_as_float(rr[1]); }
    const float inv = rcp(ltot);
    bf16* op = OUT + (rowbase + qrow) * 1024 + h * 64 + 4 * hi;
#pragma unroll
    for (int g = 0; g < 4; ++g) {
        u32x2 w0, w1; w0.x = pk2(o0[4 * g] * inv, o0[4 * g + 1] * inv); w0.y = pk2(o0[4 * g + 2] * inv, o0[4 * g + 3] * inv);
        w1.x = pk2(o1[4 * g] * inv, o1[4 * g + 1] * inv); w1.y = pk2(o1[4 * g + 2] * inv, o1[4 * g + 3] * inv);
        *(u32x2*)(op + 8 * g) = w0; *(u32x2*)(op + 32 + 8 * g) = w1; }
    asm volatile("s_waitcnt vmcnt(0)" ::: "memory");
}
}

constexpr size_t MiB = 1u << 20;
constexpr size_t WS_BAR = 32 * 1024;
constexpr size_t WS_SP8 = 0;
constexpr size_t WS_CA = 64 * 1024, WS_CB = WS_CA + 256 * 1024 * 4;
constexpr size_t WS_SSQ = 2 * MiB + 128 * 1024;
constexpr size_t WS_COS = 3 * MiB, WS_SIN = 5 * MiB;
constexpr size_t WS_MN = 7 * MiB;
constexpr size_t WS_MK = 9 * MiB;
constexpr size_t WS_MVT = 11 * MiB;
constexpr size_t WS_W = 13 * MiB;
constexpr size_t W_EVIN = WS_W, W_POOL = W_EVIN + 2 * MiB, W_QUP = W_POOL + MiB, W_KN = W_QUP + MiB, W_V = W_KN + MiB / 4, W_EVOUT = W_KN + MiB;
constexpr size_t W_ODIN = W_EVOUT + 2 * MiB, W_GATE = W_ODIN + 4 * MiB, W_ODOUT = W_GATE + MiB, W_XAQ = W_ODOUT + 2 * MiB  , W_XAKV = W_XAQ + 4 * MiB  ;
constexpr size_t W_XAO = W_XAKV + 8 * MiB  , W_FFN1 = W_XAO + 4 * MiB  , W_FFN2 = W_FFN1 + 22 * MiB  , W_END = W_FFN2 + 11 * MiB;
static_assert(W_END <= 80 * MiB, "weights");
constexpr size_t WS_XN = 80 * MiB;
constexpr size_t WS_MIX = 144 * MiB;
constexpr size_t WS_H = 208 * MiB;
constexpr size_t WS_U = 208 * MiB, WS_CQ = 240 * MiB, WS_CKV = 256 * MiB, WS_KR = 264 * MiB, WS_POOLED = 266 * MiB, WS_CQN = 298 * MiB, WS_CKVN = 314 * MiB, WS_Q = 322 * MiB;
constexpr size_t WS_KN = 384 * MiB, WS_VT = 416 * MiB;
constexpr size_t WS_XQ = 208 * MiB, WS_P = 272 * MiB;
constexpr size_t WS_GB = 208 * MiB, WS_XBP = 272 * MiB, WS_B = 272 * MiB, WS_A = 336 * MiB;
constexpr size_t WS_NEED = 464 * MiB;

struct Args {
    const float* x; const float* mem; const int* pos;
    const float *ev_norm, *ev_w_in, *ev_pool_w, *ev_pool_scale, *ev_q_norm, *ev_w_q_up, *ev_kv_norm, *ev_w_kv_up, *ev_w_out;
    const float *od_norm, *od_w_in, *od_conv_w, *od_conv_b, *od_w_rgate, *od_b_rgate, *od_w_igate, *od_b_igate, *od_lambda, *od_w_out;
    const float *xa_norm_x, *xa_norm_mem, *xa_w_q, *xa_w_kv, *xa_w_o, *ffn_norm, *ffn_w_gate_up, *ffn_w_down, *final_norm;
    float* out; unsigned char* ws; int ph_lo, ph_hi;
};

__device__ __forceinline__ void tr_item(const float* W, int ldw, int k0, int n0, bf16* dst, int ldd, LAS float* scr, int lane, const float* kg) {
#pragma unroll
    for (int i = 0; i < 32; ++i) { const int kk = 2 * i + (lane >> 5); float w = W[(size_t)(k0 + kk) * ldw + n0 + (lane & 31)]; if (kg) w *= kg[k0 + kk]; scr[kk * 33 + (lane & 31)] = w; }
    LDS_WAIT(); asm volatile("" ::: "memory");
    const int c = lane & 7;
#pragma unroll
    for (int j = 0; j < 4; ++j) { const int n = (lane >> 3) + 8 * j; const LAS float* s = scr + (8 * c) * 33 + n;
        u32x4 o; o.x = pk2(s[0 * 33], s[1 * 33]); o.y = pk2(s[2 * 33], s[3 * 33]); o.z = pk2(s[4 * 33], s[5 * 33]); o.w = pk2(s[6 * 33], s[7 * 33]);
        *(u32x4*)(dst + (size_t)n * ldd + k0 + 8 * c) = o; }
    LDS_WAIT(); asm volatile("" ::: "memory");
}
template <class RM> __device__ __forceinline__ void tr_matrix(const float* W, int K, int N, int ldd, RM rowptr, LAS float* scr, int gw, int NGW, int lane, int& rot, const float* kg = nullptr) {
    const int nblk = N / 32, nit = (K / 64) * nblk;
    int start = (gw - (rot % NGW) + NGW) % NGW;
    for (int it = start; it < nit; it += NGW) { const int kb = it / nblk, nb = it % nblk; tr_item(W, N, 64 * kb, 32 * nb, rowptr(32 * nb), ldd, scr, lane, kg); }
    rot += nit;
}
__device__ __forceinline__ void rms_row_bf16(const float* xrow, const float* g, bf16* orow, int lane) {
    const f32x4* xr = (const f32x4*)xrow + lane; const f32x4* gr = (const f32x4*)g + lane;
    f32x4 v[4]; float s = 0.f;
#pragma unroll
    for (int j = 0; j < 4; ++j) { v[j] = xr[64 * j]; s += (v[j][0] * v[j][0] + v[j][1] * v[j][1]) + (v[j][2] * v[j][2] + v[j][3] * v[j][3]); }
    const float rstd = rsqrtf(wave_sum(s) * (1.f / D) + RMS_EPS);
#pragma unroll
    for (int j = 0; j < 4; ++j) { const f32x4 o = v[j] * rstd * gr[64 * j]; u32x2 w; w.x = pk2(o[0], o[1]); w.y = pk2(o[2], o[3]); *(u32x2*)(orow + 4 * lane + 256 * j) = w; }
}
__device__ __forceinline__ void norm_pass(const float* X, const float* g, bf16* XN, int gw, int NGW, int lane) {
    for (int m = gw; m < M; m += NGW) rms_row_bf16(X + (size_t)m * D, g, XN + (size_t)m * D, lane);
}

__device__ __forceinline__ int fresh_tid(int wave) { int l; asm volatile("v_mbcnt_lo_u32_b32 %0, -1, 0\n\tv_mbcnt_hi_u32_b32 %0, -1, %0" : "=v"(l)); return wave * 64 + l; }
#define XB_TMO      128
#define XB_XCNT(j)  (256  + 64 * (j))
#define XB_XSUB(j)  (1280 + 64 * (j))
#define XB_XGEN(j)  (2304 + 64 * (j))
#define XB_TOP      3328
#define XB_TOPGEN   3392
#define XCD_BAR_WORDS 3456
#define XB_SPIN_CAP (1u << 18)
__device__ __forceinline__ unsigned xb_ld(unsigned* p)              { return __hip_atomic_load(p, __ATOMIC_RELAXED, __HIP_MEMORY_SCOPE_AGENT); }
__device__ __forceinline__ unsigned xb_add(unsigned* p, unsigned v) { return __hip_atomic_fetch_add(p, v, __ATOMIC_RELAXED, __HIP_MEMORY_SCOPE_AGENT); }
__device__ __forceinline__ unsigned xb_xcc_id() { return (unsigned)__builtin_amdgcn_s_getreg((3 << 11) | 20) & 0xFu; }
#define XB_SPIN(cond, bar) do { unsigned _sp = 0; while (cond) { __builtin_amdgcn_s_sleep(1); \
    if ((++_sp & 255u) == 0u) { if (xb_ld(&(bar)[XB_TMO])) break; if (_sp > XB_SPIN_CAP) { atomicAdd(&(bar)[XB_TMO], 1u); break; } } } } while (0)
__device__ __forceinline__ void xcd_barrier_complete(unsigned* bar, unsigned x, unsigned G, unsigned& nloc, unsigned& nx) {
    unsigned sum, cnt, mine, sp = 0u;
    for (;;) {
        sum = 0u; cnt = 0u; mine = 0u;
#pragma unroll
        for (unsigned j = 0; j < 16; ++j) { const unsigned c = xb_ld(&bar[XB_XCNT(j)]); sum += c; cnt += (c > 0u) ? 1u : 0u; mine = (j == x) ? c : mine; }
        if (sum == G) break;
        __builtin_amdgcn_s_sleep(1);
        if ((++sp & 255u) == 0u) { if (xb_ld(&bar[XB_TMO])) break; if (sp > XB_SPIN_CAP) { atomicAdd(&bar[XB_TMO], 1u); break; } }
    }
    nloc = mine > 0u ? mine : 1u; nx = cnt > 0u ? cnt : 1u;
}
__device__ __forceinline__ void xcd_barrier(unsigned* bar, unsigned x, volatile LAS unsigned* st, unsigned G, int tid) {
    asm volatile("s_waitcnt vmcnt(0)" ::: "memory");
    __syncthreads();
    if (tid == 0) {
        __builtin_amdgcn_s_waitcnt(0);
        unsigned nloc = st[0], nx = st[1];
        if (nloc == 0u) { xcd_barrier_complete(bar, x, G, nloc, nx); st[0] = nloc; st[1] = nx; }
        const unsigned old = xb_add(&bar[XB_XSUB(x)], 1u);
        const unsigned gen = old / nloc;
        if (old + 1u == (gen + 1u) * nloc) {
            __builtin_amdgcn_fence(__ATOMIC_RELEASE, "agent");
            asm volatile("s_waitcnt vmcnt(0)" ::: "memory");
            const unsigned og = xb_add(&bar[XB_TOP], 1u);
            const unsigned tg = og / nx;
            if (og + 1u == (tg + 1u) * nx) xb_add(&bar[XB_TOPGEN], 1u);
            else XB_SPIN(xb_ld(&bar[XB_TOPGEN]) == tg, bar);
            __builtin_amdgcn_fence(__ATOMIC_ACQUIRE, "agent");
            xb_add(&bar[XB_XGEN(x)], 1u);
            asm volatile("s_waitcnt vmcnt(0)" ::: "memory");
        } else {
            XB_SPIN(xb_ld(&bar[XB_XGEN(x)]) == gen, bar);
            __builtin_amdgcn_fence(__ATOMIC_ACQUIRE, "agent");
            asm volatile("s_waitcnt vmcnt(0)" ::: "memory");
        }
    }
    __syncthreads();
}

typedef const __attribute__((address_space(4))) Args* KArgs;
__global__ void __launch_bounds__(NTHREADS, 2) hybrid_fwd(Args a_) {
    extern __shared__ __attribute__((aligned(16))) unsigned char lds_raw[];
    LAS unsigned char* lds = (LAS unsigned char*)lds_raw;
    cg::grid_group grid = cg::this_grid();
    const int wave = __builtin_amdgcn_readfirstlane(threadIdx.x >> 6);
    const int G = gridDim.x, bx = blockIdx.x;
    volatile LAS unsigned* const xst = (volatile LAS unsigned*)(lds + EPI_OFF + 16000);
    if (threadIdx.x == 0) { xst[0] = 0u; xst[1] = 0u; }
    if (threadIdx.x == 0) (void)xb_add((unsigned*)(a_.ws + WS_BAR) + XB_XCNT(xb_xcc_id()), 1u);
    __syncthreads();
    const int vcu = (G % 8 == 0) ? (bx % 8) * (G / 8) + bx / 8 : bx;
    const int gw = vcu * NWAVES + wave, NGW = G * NWAVES;
#ifndef PREFIX_K
#define PREFIX_K 0
#endif
#pragma unroll 1
    for (int pass = (PREFIX_K > 0 ? 0 : 1); pass < 2; ++pass) {
    const int lo = a_.ph_lo, hi = (pass == 0) ? PREFIX_K : a_.ph_hi;
    int ph = 0;
#define a (*ap)
#ifndef PROBE_MASK
#define PROBE_MASK (0ull)
#endif
#define PHASE_BEGIN if (lo <= ph && ph < hi) for (int rep_ = ((PROBE_MASK >> ph) & 1ull) ? 2 : 1; rep_ > 0; --rep_) { KArgs ap = (KArgs)__builtin_amdgcn_kernarg_segment_ptr(); asm volatile("" : "+s"(ap)); int lane; asm volatile("v_mbcnt_lo_u32_b32 %0, -1, 0\n\tv_mbcnt_hi_u32_b32 %0, -1, %0" : "=v"(lane)); const int tid = wave * 64 + lane; (void)tid; unsigned char* const ws = a.ws; float* const outp = a.out; \
    bf16* const XN = WSP(bf16, WS_XN); bf16* const MIX = WSP(bf16, WS_MIX); const float* cosT = WSP(float, WS_COS); const float* sinT = WSP(float, WS_SIN); (void)XN; (void)MIX; (void)cosT; (void)sinT; (void)outp;
#define PHASE_END_CG if (rep_ == 1 && (ph + 1 < hi || pass == 0)) { if (pass == (PREFIX_K > 0 ? 0 : 1)) grid.sync(); else { xcd_barrier((unsigned*)(ws + WS_BAR), xb_xcc_id(), (volatile LAS unsigned*)(lds + EPI_OFF + 16000), (unsigned)G, tid); } } } ++ph;
#define PHASE_END   if (rep_ == 1 && (ph + 1 < hi || pass == 0)) { xcd_barrier((unsigned*)(ws + WS_BAR), xb_xcc_id(), (volatile LAS unsigned*)(lds + EPI_OFF + 16000), (unsigned)G, tid); } } ++ph;
#define WSP(T, off) ((T*)(ws + (off)))
    using pg8::Gemm; using pg8::Epi; using pg8::StaticOrder;

    PHASE_BEGIN
    {
        LAS float* scr = (LAS float*)(lds + wave * 16384);
        int rot = 0;
        tr_matrix(a.ev_w_in, 1024, 928, 1024, [&](int n0) { return WSP(bf16, W_EVIN) + (size_t)n0 * 1024; }, scr, gw, NGW, lane, rot);
        tr_matrix(a.ev_w_q_up, 256, 768, 256, [&](int n0) { return WSP(bf16, W_QUP) + (size_t)n0 * 256; }, scr, gw, NGW, lane, rot);
        tr_matrix(a.ev_w_kv_up, 128, 1024, 128, [&](int n0) { const int h = n0 >> 7, j0 = n0 & 127; return (j0 < 64 ? WSP(bf16, W_KN) : WSP(bf16, W_V)) + (size_t)(h * 64 + (j0 & 63)) * 128; }, scr, gw, NGW, lane, rot);
        tr_matrix(a.ev_w_out, 1024, 1024, 1024, [&](int n0) { return WSP(bf16, W_EVOUT) + (size_t)n0 * 1024; }, scr, gw, NGW, lane, rot);
        tr_matrix(a.od_w_in, 1024, 2048, 1024, [&](int n0) { return WSP(bf16, W_ODIN) + (size_t)n0 * 1024; }, scr, gw, NGW, lane, rot, a.od_norm);
        for (int h = 0; h < 4; ++h) {
            tr_matrix(a.od_w_rgate + (size_t)h * 65536, 256, 256, 256, [&](int n0) { return WSP(bf16, W_GATE) + (size_t)(256 * (2 * h + (n0 >> 7)) + (n0 & 127)) * 256; }, scr, gw, NGW, lane, rot);
            tr_matrix(a.od_w_igate + (size_t)h * 65536, 256, 256, 256, [&](int n0) { return WSP(bf16, W_GATE) + (size_t)(256 * (2 * h + (n0 >> 7)) + 128 + (n0 & 127)) * 256; }, scr, gw, NGW, lane, rot);
        }
        tr_matrix(a.od_w_out, 1024, 1024, 1024, [&](int n0) { return WSP(bf16, W_ODOUT) + (size_t)n0 * 1024; }, scr, gw, NGW, lane, rot);
        for (int l = 0; l < 2; ++l) {
            tr_matrix(a.xa_w_q + (size_t)l * 1048576, 1024, 1024, 1024, [&](int n0) { return WSP(bf16, W_XAQ + l * 2 * MiB) + (size_t)n0 * 1024; }, scr, gw, NGW, lane, rot, a.xa_norm_x + l * D);
            tr_matrix(a.xa_w_kv + (size_t)l * 2097152, 1024, 2048, 1024, [&](int n0) { return WSP(bf16, W_XAKV + l * 4 * MiB) + (size_t)n0 * 1024; }, scr, gw, NGW, lane, rot);
            tr_matrix(a.xa_w_o + (size_t)l * 1048576, 1024, 1024, 1024, [&](int n0) { return WSP(bf16, W_XAO + l * 2 * MiB) + (size_t)n0 * 1024; }, scr, gw, NGW, lane, rot);
            tr_matrix(a.ffn_w_gate_up + (size_t)l * 1024 * 5632, 1024, 5632, 1024, [&](int n0) { const int isu = n0 >= DFF, nn = isu ? n0 - DFF : n0; return WSP(bf16, W_FFN1 + l * 11 * MiB) + (size_t)(256 * (nn >> 7) + 128 * isu + (nn & 127)) * 1024; }, scr, gw, NGW, lane, rot, a.ffn_norm + l * D);
            tr_matrix(a.ffn_w_down + (size_t)l * DFF * 1024, DFF, 1024, DFF, [&](int n0) { return WSP(bf16, W_FFN2) + (size_t)l * (1024 * DFF) + (size_t)n0 * DFF; }, scr, gw, NGW, lane, rot);
        }
        const int gt = vcu * NTHREADS + tid, NGT = G * NTHREADS;
        for (int i = gt; i < 512 * 256; i += NGT) { const int n = i >> 8, kk = i & 255, g = n >> 7; float v = 0.f; if ((kk >> 7) == (g & 1)) v = a.ev_pool_w[(size_t)g * 16384 + (size_t)(kk & 127) * 128 + (n & 127)];
            WSP(bf16, W_POOL)[i] = (bf16)(pk2(v, 0.f) & 0xffffu); }
        for (int i = gt; i < M * 16; i += NGT) { const int row = i >> 4, j = i & 15; const int f = j & 3, e = j >> 2;
            const float fa = f == 0 ? 1.0f : (f == 1 ? 0.5623413251903491f : (f == 2 ? 0.31622776601683794f : 0.1778279410038923f));
            const float fb = e == 0 ? 1.0f : (e == 1 ? 0.1f : (e == 2 ? 0.01f : 0.001f));
            const float inv_freq = fa * fb; const float ang = (float)a.pos[row] * inv_freq;
            const double t = (double)ang * 0.15915494309189535; const float fr = (float)(t - __builtin_floor(t));
            WSP(float, WS_COS)[i] = __builtin_amdgcn_cosf(fr); WSP(float, WS_SIN)[i] = __builtin_amdgcn_sinf(fr); }
        for (int i = gt; i < 6 * M; i += NGT) WSP(float, WS_SSQ)[i] = 0.f;
        for (int i = gt; i < 1024; i += NGT) { const float l = a.od_lambda[i]; const float y = ex2(-l * LOG2E);
            const float sp = (y < 0.03f) ? y * (1.0f - y * (0.5f - y * (1.0f / 3.0f - 0.25f * y))) : 0.6931471805599453f * __builtin_amdgcn_logf(1.0f + y);
            WSP(float, WS_SP8)[i] = 8.0f * sp; }
        for (int r = gw; r < 1024; r += NGW) { const int l = r >> 9, mr = r & 511; rms_row_bf16(a.mem + (size_t)mr * D, a.xa_norm_mem + l * D, WSP(bf16, WS_MN) + (size_t)r * D, lane); }
        norm_pass(a.x, a.ev_norm, XN, gw, NGW, lane);
    }
    PHASE_END_CG

    PHASE_BEGIN
    {
        { Gemm g = pg8::mk(XN, WSP(bf16, W_EVIN), M, 1024, 1024); StaticOrder S; S.init(M, 1024, G, bx);
          Epi E{}; E.mode = pg8::E_EVIN; E.O = WSP(bf16, WS_U); E.O2 = WSP(bf16, WS_CQ); E.O3 = WSP(bf16, WS_CKV); E.O4 = WSP(bf16, WS_KR); E.cosT = cosT; E.sinT = sinT;
          pg8::gemm_phase(lds, g, S, E, fresh_tid(wave)); }
        for (int l = 0; l < 2; ++l) {
            { Gemm g = pg8::mk(WSP(bf16, WS_MN) + (size_t)l * 512 * D, WSP(bf16, W_XAKV + l * 4 * MiB), 512, 1024, 1024); StaticOrder S; S.init(512, 1024, G, (bx + G - (l * 16) % G) % G);
              Epi E{}; E.mode = pg8::E_PLAIN; E.O = WSP(bf16, WS_MK) + (size_t)l * 512 * D; E.ldc = 1024; E.scale = 1.f; pg8::gemm_phase(lds, g, S, E, fresh_tid(wave)); }
            { Gemm g = pg8::mk(WSP(bf16, W_XAKV + l * 4 * MiB) + (size_t)1024 * 1024, WSP(bf16, WS_MN) + (size_t)l * 512 * D, 1024, 512, 1024); StaticOrder S; S.init(1024, 512, G, (bx + G - (l * 16 + 8) % G) % G);
              Epi E{}; E.mode = pg8::E_PLAIN; E.O = WSP(bf16, WS_MVT) + (size_t)l * 1024 * 512; E.ldc = 512; E.scale = 1.f; pg8::gemm_phase(lds, g, S, E, fresh_tid(wave)); }
        }
    }
    PHASE_END

    PHASE_BEGIN
    {
        const bf16* U = WSP(bf16, WS_U); const bf16* CQ = WSP(bf16, WS_CQ); const bf16* CKV = WSP(bf16, WS_CKV);
        bf16* PO = WSP(bf16, WS_POOLED); bf16* CQN = WSP(bf16, WS_CQN); bf16* CKVN = WSP(bf16, WS_CKVN);
        const int w = 2 << (lane >> 4);
        const f32x4 gq = *(const f32x4*)(a.ev_q_norm + 4 * lane); const f32x2 gk = *(const f32x2*)(a.ev_kv_norm + 2 * lane);
        for (int row = gw; row < M; row += NGW) {
            const int s = row & (SEQ - 1); const int cnt = (s + 1 < w) ? s + 1 : w;
            float sum[8]; float self[8];
            { const u32x4 v = *(const u32x4*)(U + (size_t)row * 512 + 8 * lane);
              self[0] = bflo(v.x); self[1] = bfhi(v.x); self[2] = bflo(v.y); self[3] = bfhi(v.y); self[4] = bflo(v.z); self[5] = bfhi(v.z); self[6] = bflo(v.w); self[7] = bfhi(v.w);
#pragma unroll
              for (int e = 0; e < 8; ++e) sum[e] = self[e]; }
            for (int tt = 1; tt < cnt; ++tt) { const u32x4 v = *(const u32x4*)(U + (size_t)(row - tt) * 512 + 8 * lane);
                sum[0] += bflo(v.x); sum[1] += bfhi(v.x); sum[2] += bflo(v.y); sum[3] += bfhi(v.y); sum[4] += bflo(v.z); sum[5] += bfhi(v.z); sum[6] += bflo(v.w); sum[7] += bfhi(v.w); }
            const float ic = 1.0f / (float)cnt;
            u32x4 o; o.x = pk2(sum[0] * ic - self[0], sum[1] * ic - self[1]); o.y = pk2(sum[2] * ic - self[2], sum[3] * ic - self[3]);
            o.z = pk2(sum[4] * ic - self[4], sum[5] * ic - self[5]); o.w = pk2(sum[6] * ic - self[6], sum[7] * ic - self[7]);
            *(u32x4*)(PO + (size_t)row * 512 + 8 * lane) = o;
            { const u32x2 v = *(const u32x2*)(CQ + (size_t)row * 256 + 4 * lane); const float x0 = bflo(v.x), x1 = bfhi(v.x), x2 = bflo(v.y), x3 = bfhi(v.y);
              const float rstd = rsqrtf(wave_sum((x0 * x0 + x1 * x1) + (x2 * x2 + x3 * x3)) * (1.f / 256.f) + RMS_EPS);
              u32x2 q; q.x = pk2(x0 * rstd * gq[0], x1 * rstd * gq[1]); q.y = pk2(x2 * rstd * gq[2], x3 * rstd * gq[3]); *(u32x2*)(CQN + (size_t)row * 256 + 4 * lane) = q; }
            { const unsigned v = *(const unsigned*)(CKV + (size_t)row * 128 + 2 * lane); const float x0 = bflo(v), x1 = bfhi(v);
              const float rstd = rsqrtf(wave_sum(x0 * x0 + x1 * x1) * (1.f / 128.f) + RMS_EPS);
              *(unsigned*)(CKVN + (size_t)row * 128 + 2 * lane) = pk2(x0 * rstd * gk[0], x1 * rstd * gk[1]); }
        }
    }
    PHASE_END

    PHASE_BEGIN
    {
        { Gemm g = pg8::mk(WSP(bf16, WS_CQN), WSP(bf16, W_QUP), M, 768, 256); StaticOrder S; S.init(M, 768, G, bx);
          Epi E{}; E.mode = pg8::E_QROPE; E.O = WSP(bf16, WS_Q); E.scale = 0.10206207261596577f * LOG2E; E.cosT = cosT; E.sinT = sinT; pg8::gemm_phase(lds, g, S, E, fresh_tid(wave)); }
        { Gemm g = pg8::mk(WSP(bf16, WS_CKVN), WSP(bf16, W_KN), M, 512, 128); StaticOrder S; S.init(M, 512, G, bx);
          Epi E{}; E.mode = pg8::E_PLAIN; E.O = WSP(bf16, WS_KN); E.ldc = 512; E.scale = 1.f; pg8::gemm_phase(lds, g, S, E, fresh_tid(wave)); }
        { Gemm g = pg8::mk(WSP(bf16, W_V), WSP(bf16, WS_CKVN), 512, M, 128); StaticOrder S; S.init(512, M, G, bx);
          Epi E{}; E.mode = pg8::E_VT; E.O = WSP(bf16, WS_VT); E.ldc = M; pg8::gemm_phase(lds, g, S, E, fresh_tid(wave)); }
        { Gemm g = pg8::mk(WSP(bf16, WS_POOLED), WSP(bf16, W_POOL), M, 512, 256); g.lda = 512; g.a_pm_off = 256L * 512; g.a_pn_off = 256; StaticOrder S; S.init(M, 512, G, bx);
          Epi E{}; E.mode = pg8::E_POOL; E.O = MIX; E.ldc = 1024; E.vec0 = a.ev_pool_scale; pg8::gemm_phase(lds, g, S, E, fresh_tid(wave)); }
    }
    PHASE_END

    PHASE_BEGIN
    {
        for (int vw = vcu; vw < 256; vw += G) { const int bh = vw >> 4, s = vw & 15;
#pragma unroll 1
            for (int i = 0; i < 4; ++i) { const int qb = (i == 0) ? 63 - s : (i == 1) ? s : (i == 2) ? 32 + s : 31 - s;
                size_t z0 = 0; asm volatile("" : "+s"(z0)); unsigned char* w2 = ws + z0;
                att::attn_unit(bh >> 3, bh & 7, qb, (const bf16*)(w2 + WS_Q), (const bf16*)(w2 + WS_KN), (const bf16*)(w2 + WS_KR), (const bf16*)(w2 + WS_VT), (bf16*)(w2 + WS_MIX) + 512, lds, fresh_tid(wave)); } }
    }
    PHASE_END

    PHASE_BEGIN
    { Gemm g = pg8::mk(MIX, WSP(bf16, W_EVOUT), M, 1024, 1024); StaticOrder S; S.init(M, 1024, G, bx);
      Epi E{}; E.mode = pg8::E_RES; E.base = a.x; E.out = outp; E.O = XN; E.aout = WSP(float, WS_SSQ); pg8::gemm_phase(lds, g, S, E, fresh_tid(wave)); }
    PHASE_END

#pragma unroll 1
    for (int l = 0; l < 2; ++l) {
        if (l == 1) {
            PHASE_BEGIN
            { Gemm g = pg8::mk(XN, WSP(bf16, W_ODIN), M, 2048, 1024); StaticOrder S; S.init(M, 2048, G, bx);
              Epi E{}; E.mode = pg8::E_ODIN; E.O = WSP(bf16, WS_GB); E.O2 = WSP(bf16, WS_XBP); E.vec0 = WSP(float, WS_SSQ) + 2 * (size_t)M; pg8::gemm_phase(lds, g, S, E, fresh_tid(wave)); }
            PHASE_END
            PHASE_BEGIN
            {
                const bf16* XBP = WSP(bf16, WS_XBP); bf16* XB = XN;
                const int half = gw & 1; const int c0 = half * 512 + 8 * lane;
                float wv[4][8], bias[8];
#pragma unroll
                for (int j = 0; j < 4; ++j)
#pragma unroll
                    for (int e = 0; e < 8; ++e) wv[j][e] = a.od_conv_w[j * 1024 + c0 + e];
#pragma unroll
                for (int e = 0; e < 8; ++e) bias[e] = a.od_conv_b[c0 + e];
                for (int row = gw >> 1; row < M; row += NGW >> 1) { const int s = row & (SEQ - 1); float acc[8];
#pragma unroll
                    for (int e = 0; e < 8; ++e) acc[e] = bias[e];
#pragma unroll
                    for (int j = 0; j < 4; ++j) { if (s - 3 + j >= 0) { const u32x4 v = *(const u32x4*)(XBP + (size_t)(row - 3 + j) * D + c0);
                        acc[0] += wv[j][0] * bflo(v.x); acc[1] += wv[j][1] * bfhi(v.x); acc[2] += wv[j][2] * bflo(v.y); acc[3] += wv[j][3] * bfhi(v.y);
                        acc[4] += wv[j][4] * bflo(v.z); acc[5] += wv[j][5] * bfhi(v.z); acc[6] += wv[j][6] * bflo(v.w); acc[7] += wv[j][7] * bfhi(v.w); } }
                    u32x4 o; o.x = pk2(acc[0], acc[1]); o.y = pk2(acc[2], acc[3]); o.z = pk2(acc[4], acc[5]); o.w = pk2(acc[6], acc[7]);
                    *(u32x4*)(XB + (size_t)row * D + c0) = o; }
            }
            PHASE_END
            PHASE_BEGIN
            { Gemm g = pg8::mk(XN, WSP(bf16, W_GATE), M, 2048, 256); g.lda = 1024; g.a_pm_off = 256L * 1024; g.a_pn_off = 256; g.a_pn_shift = 1; StaticOrder S; S.init(M, 2048, G, bx);
              Epi E{}; E.mode = pg8::E_GATE; E.O = WSP(bf16, WS_B); E.aout = WSP(float, WS_A); E.vec0 = a.od_b_rgate; E.vec1 = a.od_b_igate; E.vec2 = WSP(float, WS_SP8); E.pos = a.pos; E.xb = XN;
              pg8::gemm_phase(lds, g, S, E, fresh_tid(wave)); }
            PHASE_END
            PHASE_BEGIN
            {
                const float* A_ = WSP(float, WS_A); const bf16* B_ = WSP(bf16, WS_B);
                for (int it = vcu; it < 256; it += G) { const size_t r0 = (size_t)it * 128; const int c = 2 * tid;
                    float A0 = 1.f, A1 = 1.f, B0 = 0.f, B1 = 0.f;
#pragma unroll 8
                    for (int t = 0; t < 128; ++t) { const f32x2 av = *(const f32x2*)(A_ + (r0 + t) * D + c); const unsigned bw = *(const unsigned*)(B_ + (r0 + t) * D + c);
                        B0 = av[0] * B0 + bflo(bw); B1 = av[1] * B1 + bfhi(bw); A0 *= av[0]; A1 *= av[1]; }
                    *(f32x2*)(WSP(float, WS_CA) + (size_t)it * D + c) = (f32x2){A0, A1}; *(f32x2*)(WSP(float, WS_CB) + (size_t)it * D + c) = (f32x2){B0, B1}; }
            }
            PHASE_END
            PHASE_BEGIN
            {
                const float* A_ = WSP(float, WS_A); const bf16* B_ = WSP(bf16, WS_B); const bf16* GB = WSP(bf16, WS_GB);
                for (int it = vcu; it < 256; it += G) { const size_t r0 = (size_t)it * 128; const int c = 2 * tid; const int j = it & 127, it0 = it - j;
                    float h0 = 0.f, h1 = 0.f;
#pragma unroll 8
                    for (int jj = 0; jj < j; ++jj) { const f32x2 ca = *(const f32x2*)(WSP(float, WS_CA) + (size_t)(it0 + jj) * D + c), cb = *(const f32x2*)(WSP(float, WS_CB) + (size_t)(it0 + jj) * D + c);
                        h0 = ca[0] * h0 + cb[0]; h1 = ca[1] * h1 + cb[1]; }
#pragma unroll 8
                    for (int t = 0; t < 128; ++t) { const f32x2 av = *(const f32x2*)(A_ + (r0 + t) * D + c); const unsigned bw = *(const unsigned*)(B_ + (r0 + t) * D + c); const unsigned gv = *(const unsigned*)(GB + (r0 + t) * D + c);
                        h0 = av[0] * h0 + bflo(bw); h1 = av[1] * h1 + bfhi(bw);
                        *(unsigned*)(MIX + (r0 + t) * D + c) = pk2(bflo(gv) * h0, bfhi(gv) * h1); }
                }
            }
            PHASE_END
            PHASE_BEGIN
            { Gemm g = pg8::mk(MIX, WSP(bf16, W_ODOUT), M, 1024, 1024); StaticOrder S; S.init(M, 1024, G, bx);
              Epi E{}; E.mode = pg8::E_RES; E.base = outp; E.out = outp; E.O = XN; E.aout = WSP(float, WS_SSQ) + 3 * (size_t)M; pg8::gemm_phase(lds, g, S, E, fresh_tid(wave)); }
            PHASE_END
        }
        PHASE_BEGIN
        { Gemm g = pg8::mk(XN, WSP(bf16, W_XAQ + l * 2 * MiB), M, 1024, 1024); StaticOrder S; S.init(M, 1024, G, bx);
          Epi E{}; E.mode = pg8::E_PLAIN; E.O = WSP(bf16, WS_XQ); E.ldc = 1024; E.scale = 0.0625f * LOG2E; E.vec0 = WSP(float, WS_SSQ) + (size_t)(3 * l) * M; pg8::gemm_phase(lds, g, S, E, fresh_tid(wave)); }
        PHASE_END
        PHASE_BEGIN
        { Gemm g = pg8::mk(WSP(bf16, WS_XQ), WSP(bf16, WS_MK) + (size_t)l * 512 * D, M, 1024, 256); g.lda = 1024; g.a_pm_off = 256L * 1024; g.a_pn_off = 256;
          g.ldb = 1024; g.b_pn_off = 256; g.b_pm_div = 64; g.b_pm_off = 256L * 1024; StaticOrder S; S.init(M, 1024, G, bx);
          Epi E{}; E.mode = pg8::E_SOFTMAX; E.O = WSP(bf16, WS_P); E.ldc = 1024; pg8::gemm_phase(lds, g, S, E, fresh_tid(wave)); }
        PHASE_END
        PHASE_BEGIN
        { Gemm g = pg8::mk(WSP(bf16, WS_P), WSP(bf16, WS_MVT) + (size_t)l * 1024 * 512, M, 1024, 256); g.lda = 1024; g.a_pm_off = 256L * 1024; g.a_pn_off = 256;
          g.ldb = 512; g.b_pn_off = 256L * 512; g.b_pm_div = 64; g.b_pm_off = 256; StaticOrder S; S.init(M, 1024, G, bx);
          Epi E{}; E.mode = pg8::E_PLAIN; E.O = MIX; E.ldc = 1024; E.scale = 1.f; pg8::gemm_phase(lds, g, S, E, fresh_tid(wave)); }
        PHASE_END
        PHASE_BEGIN
        { Gemm g = pg8::mk(MIX, WSP(bf16, W_XAO + l * 2 * MiB), M, 1024, 1024); StaticOrder S; S.init(M, 1024, G, bx);
          Epi E{}; E.mode = pg8::E_RES; E.base = outp; E.out = outp; E.O = XN; E.aout = WSP(float, WS_SSQ) + (size_t)(3 * l + 1) * M; pg8::gemm_phase(lds, g, S, E, fresh_tid(wave)); }
        PHASE_END
        PHASE_BEGIN
        { Gemm g = pg8::mk(XN, WSP(bf16, W_FFN1 + l * 11 * MiB), M, 2 * DFF, 1024); StaticOrder S; S.init(M, 2 * DFF, G, bx);
          Epi E{}; E.mode = pg8::E_SWIGLU; E.O = WSP(bf16, WS_H); E.vec0 = WSP(float, WS_SSQ) + (size_t)(3 * l + 1) * M; pg8::gemm_phase(lds, g, S, E, fresh_tid(wave)); }
        PHASE_END
        PHASE_BEGIN
        { Gemm g = pg8::mk(WSP(bf16, WS_H), WSP(bf16, W_FFN2) + (size_t)l * (1024 * DFF), M, 1024, DFF); StaticOrder S; S.init(M, 1024, G, bx);
          Epi E{}; E.mode = pg8::E_RES; E.base = outp; E.out = outp; E.O = (l == 0) ? XN : nullptr; E.aout = WSP(float, WS_SSQ) + (size_t)(l == 0 ? 2 : 5) * M; pg8::gemm_phase(lds, g, S, E, fresh_tid(wave)); }
        PHASE_END
    }

    PHASE_BEGIN
    {
        const f32x4* gr = (const f32x4*)a.final_norm + lane; const float* ssq = WSP(float, WS_SSQ) + 5 * (size_t)M;
        for (int m = gw; m < M; m += NGW) { f32x4* xr = (f32x4*)(outp + (size_t)m * D) + lane; const float rstd = rsqrtf(ssq[m] * (1.f / D) + RMS_EPS);
#pragma unroll
            for (int j = 0; j < 4; ++j) xr[64 * j] = xr[64 * j] * rstd * gr[64 * j]; }
    }
    PHASE_END
    }
}
#undef a
constexpr int N_PHASES = 6 + 6 + 12 + 1;

#ifndef MK_N_LAUNCHES
#define MK_N_LAUNCHES 1
#endif
extern "C" void kernel_launch(void* const* d_in, const int* in_sizes, int n_in, void* d_out, int out_size, void* d_ws, size_t ws_size, hipStream_t stream) {
    static int grid = 0;
    if (grid == 0) {
        if (n_in != 31 || ws_size < WS_NEED) { fprintf(stderr, "kernel_launch: unexpected n_in %d or ws_size %zu\n", n_in, ws_size); grid = -1; return; }
        int dev = 0, cus = 0, per_cu = 0;
        hipGetDevice(&dev); hipDeviceGetAttribute(&cus, hipDeviceAttributeMultiprocessorCount, dev);
        if (hipFuncSetAttribute((const void*)hybrid_fwd, hipFuncAttributeMaxDynamicSharedMemorySize, LDS_BYTES) != hipSuccess) { fprintf(stderr, "kernel_launch: hipFuncSetAttribute failed\n"); grid = -1; return; }
        hipOccupancyMaxActiveBlocksPerMultiprocessor(&per_cu, (const void*)hybrid_fwd, NTHREADS, LDS_BYTES);
        (void)hipGetLastError();
        if (per_cu < 1) per_cu = 1;
        grid = cus * 1;
        if (grid > 256) grid = 256;
    }
    if (grid < 0) return;
    Args a{};
    const float* const* f = (const float* const*)d_in;
    a.x = f[0]; a.mem = f[1]; a.pos = (const int*)d_in[2];
    a.ev_norm = f[3]; a.ev_w_in = f[4]; a.ev_pool_w = f[5]; a.ev_pool_scale = f[6]; a.ev_q_norm = f[7]; a.ev_w_q_up = f[8]; a.ev_kv_norm = f[9]; a.ev_w_kv_up = f[10]; a.ev_w_out = f[11];
    a.od_norm = f[12]; a.od_w_in = f[13]; a.od_conv_w = f[14]; a.od_conv_b = f[15]; a.od_w_rgate = f[16]; a.od_b_rgate = f[17]; a.od_w_igate = f[18]; a.od_b_igate = f[19]; a.od_lambda = f[20]; a.od_w_out = f[21];
    a.xa_norm_x = f[22]; a.xa_norm_mem = f[23]; a.xa_w_q = f[24]; a.xa_w_kv = f[25]; a.xa_w_o = f[26]; a.ffn_norm = f[27]; a.ffn_w_gate_up = f[28]; a.ffn_w_down = f[29]; a.final_norm = f[30];
    a.out = (float*)d_out; a.ws = (unsigned char*)d_ws;
#if MK_N_LAUNCHES == 1
    if (hipMemsetAsync((unsigned char*)d_ws + WS_BAR, 0, 16384, stream) != hipSuccess) { fprintf(stderr, "kernel_launch: memset failed\n"); return; }
    a.ph_lo = 0; a.ph_hi = N_PHASES;
    void* args[] = {&a};
    hipError_t e = hipLaunchCooperativeKernel((const void*)hybrid_fwd, dim3(grid), dim3(NTHREADS), args, LDS_BYTES, stream);
    if (e != hipSuccess) fprintf(stderr, "kernel_launch: cooperative launch failed: %s (grid %d)\n", hipGetErrorString(e), grid);
#else
    for (int p = 0; p < N_PHASES; ++p) { a.ph_lo = p; a.ph_hi = p + 1; hipLaunchKernelGGL(hybrid_fwd, dim3(grid), dim3(NTHREADS), LDS_BYTES, stream, a); }
#endif
}
```

```cpp
#include <hip/hip_runtime.h>
#include <hip/hip_cooperative_groups.h>
#include <cstdio>
#include <cstdint>
namespace cg = cooperative_groups;

#define LAS __attribute__((address_space(3)))
typedef unsigned short bf16;
typedef short bf16x8 __attribute__((ext_vector_type(8)));
typedef short s16x4 __attribute__((ext_vector_type(4)));
typedef float f32x4 __attribute__((ext_vector_type(4)));
typedef float f32x2 __attribute__((ext_vector_type(2)));
typedef float f32x16 __attribute__((ext_vector_type(16)));
typedef unsigned u32x4 __attribute__((ext_vector_type(4)));
typedef unsigned u32x2 __attribute__((ext_vector_type(2)));

constexpr int SEQ = 16384, BATCH = 2, M = BATCH * SEQ, D = 1024;
constexpr int DFF = 2816;
constexpr float RMS_EPS = 1e-6f;
constexpr float LOG2E = 1.4426950408889634f;
constexpr int NTHREADS = 512, NWAVES = 8;
constexpr int RING_BYTES = 131072, LDS_BYTES = 147456, EPI_OFF = RING_BYTES;

typedef __bf16 bf16x2_t __attribute__((ext_vector_type(2)));
__device__ __forceinline__ unsigned pk2(float lo, float hi) { f32x2 v = {lo, hi}; bf16x2_t b = __builtin_convertvector(v, bf16x2_t); return __builtin_bit_cast(unsigned, b); }
__device__ __forceinline__ float bflo(unsigned w) { return __uint_as_float(w << 16); }
__device__ __forceinline__ float bfhi(unsigned w) { return __uint_as_float(w & 0xffff0000u); }
__device__ __forceinline__ float ex2(float x) { return __builtin_amdgcn_exp2f(x); }
__device__ __forceinline__ float rcp(float x) { return __builtin_amdgcn_rcpf(x); }
__device__ __forceinline__ float sigmoidf_(float x) { return rcp(1.0f + ex2(-x * LOG2E)); }
__device__ __forceinline__ float gelu_tanh(float x) { const float u = 0.7978845608028654f * (x + 0.044715f * x * x * x); return x * sigmoidf_(2.0f * u); }
__device__ __forceinline__ float wave_sum(float v) {
#pragma unroll
    for (int o = 1; o < 64; o <<= 1) v += __shfl_xor(v, o);
    return v;
}
#define LDS_WAIT() asm volatile("s_waitcnt lgkmcnt(0)" ::: "memory")

namespace pg8 {
constexpr int BM = 256, BK = 64, HALF = 128, HTB = HALF * BK * 2, NXCD = 8, WGM = 4;
__host__ __device__ __forceinline__ int lds_byte(int r, int c) { const int st = (r >> 4) * 2 + (c >> 5), rr = r & 15, cc = c & 31, ob = rr * 64 + cc * 2; return st * 1024 + (ob ^ (((ob >> 9) & 1) << 5)); }
__host__ __device__ __forceinline__ void stage_rc(int b, int& R, int& C) { const int st = b / 1024, sb = b % 1024, swz = sb ^ (((sb >> 9) & 1) << 5); R = (st >> 1) * 16 + swz / 64; C = (st & 1) * 32 + (swz % 64) / 2; }
struct Unit { int pm, pn; };
struct Gemm { const bf16* A; const bf16* Bt; int Mr, N, K, lda, ldb; long a_pm_off, a_pn_off; int a_pn_shift; long b_pn_off; int b_pm_div; long b_pm_off; };
__device__ __forceinline__ Gemm mk(const bf16* A, const bf16* Bt, int Mr, int N, int K) {
    Gemm g; g.A = A; g.Bt = Bt; g.Mr = Mr; g.N = N; g.K = K; g.lda = K; g.ldb = K; g.a_pm_off = 256L * K; g.a_pn_off = 0; g.a_pn_shift = 0; g.b_pn_off = 256L * K; g.b_pm_div = 1 << 30; g.b_pm_off = 0; return g; }
struct StaticOrder {
    int nM, nN, nwg, G, c;
    __device__ void init(int Mr, int N, int G_, int c_) { nM = Mr / BM; nN = N / BM; nwg = nM * nN; G = G_; c = c_; }
    __device__ bool next(int i, Unit& u) const {
        const long L = (long)i * G + c; if (L >= nwg) return false;
        int wgid = (int)L; { const int q = nwg / NXCD, r = nwg % NXCD, xcd = wgid % NXCD, off = wgid / NXCD; wgid = (xcd < r ? xcd * (q + 1) : r * (q + 1) + (xcd - r) * q) + off; }
        const int nig = WGM * nN, gid = wgid / nig, fm = gid * WGM, gsz = (nM - fm) < WGM ? (nM - fm) : WGM;
        u.pm = fm + ((wgid % nig) % gsz); u.pn = (wgid % nig) / gsz; return true;
    }
};

enum { E_PLAIN = 0, E_EVIN, E_QROPE, E_POOL, E_RES, E_SOFTMAX, E_SWIGLU, E_ODIN, E_GATE, E_VT };
struct Epi {
    int mode;
    bf16* O; int ldc; float scale;
    bf16 *O2, *O3, *O4;
    const float* base; float* out;
    const float *cosT, *sinT;
    const float *vec0, *vec1, *vec2;
    const int* pos;
    const bf16* xb; float* aout;
};
__device__ __forceinline__ void st8(bf16* p, f32x4 v0, f32x4 v1) { u32x4 w; w.x = pk2(v0[0], v0[1]); w.y = pk2(v0[2], v0[3]); w.z = pk2(v1[0], v1[1]); w.w = pk2(v1[2], v1[3]); *(u32x4*)p = w; }
__device__ __forceinline__ void st4(bf16* p, f32x4 v) { u32x2 w; w.x = pk2(v[0], v[1]); w.y = pk2(v[2], v[3]); *(u32x2*)p = w; }

__device__ __forceinline__ void run_epi(const Epi& E, f32x4 (&acc)[2][2][4][2], const Unit& u, int wr, int wc, int fr, int fq, LAS unsigned char* lds) {
    const int rowb = u.pm * BM + wr * 64 + fr, colb = u.pn * BM + wc * 32 + 4 * fq;
    const int colp = u.pn * BM + wc * 32 + 8 * fq;
    switch (E.mode) {
    case E_PLAIN: {
#pragma unroll
        for (int ai = 0; ai < 2; ++ai)
#pragma unroll
            for (int m = 0; m < 4; ++m) { const size_t row = (size_t)(rowb + ai * HALF + m * 16); bf16* rp = E.O + row * E.ldc + colp;
                float sc = E.scale; if (E.vec0) sc *= rsqrtf(E.vec0[row] * (1.f / D) + RMS_EPS);
#pragma unroll
                for (int bj = 0; bj < 2; ++bj) st8(rp + bj * HALF, acc[ai][bj][m][0] * sc, acc[ai][bj][m][1] * sc); }
    } break;
    case E_EVIN: {
        const int pn = u.pn;
#pragma unroll
        for (int ai = 0; ai < 2; ++ai)
#pragma unroll
            for (int m = 0; m < 4; ++m) { const size_t row = (size_t)(rowb + ai * HALF + m * 16);
                if (pn < 2) { bf16* rp = E.O + row * 512 + colb;
#pragma unroll
                    for (int bj = 0; bj < 2; ++bj)
#pragma unroll
                        for (int n = 0; n < 2; ++n) st4(rp + bj * HALF + n * 16, acc[ai][bj][m][n]);
                } else if (pn == 2) { bf16* rp = E.O2 + row * 256 + (colb - 512);
#pragma unroll
                    for (int bj = 0; bj < 2; ++bj)
#pragma unroll
                        for (int n = 0; n < 2; ++n) st4(rp + bj * HALF + n * 16, acc[ai][bj][m][n]);
                } else { bf16* rp = E.O3 + row * 128 + (colb - 768);
#pragma unroll
                    for (int n = 0; n < 2; ++n) st4(rp + n * 16, acc[ai][0][m][n]);
                    if (wc == 0) { const f32x4 c = *(const f32x4*)(E.cosT + row * 16 + 4 * fq), s = *(const f32x4*)(E.sinT + row * 16 + 4 * fq);
                        const f32x4 v0 = acc[ai][1][m][0], v1 = acc[ai][1][m][1];
                        st4(E.O4 + row * 32 + 4 * fq, v0 * c - v1 * s); st4(E.O4 + row * 32 + 16 + 4 * fq, v1 * c + v0 * s); }
                } }
    } break;
    case E_QROPE: {
#pragma unroll
        for (int bj = 0; bj < 2; ++bj) { const int cb = u.pn * BM + bj * HALF + wc * 32; const bool rope = (cb % 96) == 64;
#pragma unroll
            for (int ai = 0; ai < 2; ++ai)
#pragma unroll
                for (int m = 0; m < 4; ++m) { const size_t row = (size_t)(rowb + ai * HALF + m * 16); bf16* rp = E.O + row * 768 + cb + 4 * fq;
                    f32x4 v0 = acc[ai][bj][m][0] * E.scale, v1 = acc[ai][bj][m][1] * E.scale;
                    if (rope) { const f32x4 c = *(const f32x4*)(E.cosT + row * 16 + 4 * fq), s = *(const f32x4*)(E.sinT + row * 16 + 4 * fq);
                        const f32x4 o0 = v0 * c - v1 * s, o1 = v1 * c + v0 * s; v0 = o0; v1 = o1; }
                    st4(rp, v0); st4(rp + 16, v1); } }
    } break;
    case E_POOL: {
#pragma unroll
        for (int bj = 0; bj < 2; ++bj) { const int col = colp + bj * HALF; const f32x4 s0 = *(const f32x4*)(E.vec0 + col), s1 = *(const f32x4*)(E.vec0 + col + 4);
#pragma unroll
            for (int ai = 0; ai < 2; ++ai)
#pragma unroll
                for (int m = 0; m < 4; ++m) st8(E.O + (size_t)(rowb + ai * HALF + m * 16) * E.ldc + col, acc[ai][bj][m][0] * s0, acc[ai][bj][m][1] * s1); }
    } break;
    case E_RES: {
#pragma unroll
        for (int ai = 0; ai < 2; ++ai) {
            f32x4 bs[4][2][2];
#pragma unroll
            for (int m = 0; m < 4; ++m) { const size_t off = (size_t)(rowb + ai * HALF + m * 16) * D + colp;
#pragma unroll
                for (int bj = 0; bj < 2; ++bj)
#pragma unroll
                    for (int n = 0; n < 2; ++n) bs[m][bj][n] = *(const f32x4*)(E.base + off + bj * HALF + n * 4); }
#pragma unroll
            for (int m = 0; m < 4; ++m) { const size_t row = (size_t)(rowb + ai * HALF + m * 16); const size_t off = row * D + colp; float q = 0.f;
#pragma unroll
                for (int bj = 0; bj < 2; ++bj) { const f32x4 o0 = bs[m][bj][0] + acc[ai][bj][m][0], o1 = bs[m][bj][1] + acc[ai][bj][m][1];
                    *(f32x4*)(E.out + off + bj * HALF) = o0; *(f32x4*)(E.out + off + bj * HALF + 4) = o1;
                    if (E.O) st8(E.O + off + bj * HALF, o0, o1);
                    q += (o0[0] * o0[0] + o0[1] * o0[1]) + (o0[2] * o0[2] + o0[3] * o0[3]) + (o1[0] * o1[0] + o1[1] * o1[1]) + (o1[2] * o1[2] + o1[3] * o1[3]); }
                q += __shfl_xor(q, 16); q += __shfl_xor(q, 32);
                if (fq == 0) atomicAdd(E.aout + row, q); }
            asm volatile("" ::: "memory"); }
    } break;
    case E_SOFTMAX: {
        LAS float* RM = (LAS float*)(lds + EPI_OFF);
        LAS float* RS = (LAS float*)(lds + EPI_OFF + 4096);
#pragma unroll
        for (int ai = 0; ai < 2; ++ai)
#pragma unroll
            for (int m = 0; m < 4; ++m) { float mx = -3.0e38f;
#pragma unroll
                for (int bj = 0; bj < 2; ++bj)
#pragma unroll
                    for (int n = 0; n < 2; ++n) { const f32x4 x = acc[ai][bj][m][n]; mx = fmaxf(mx, fmaxf(fmaxf(x[0], x[1]), fmaxf(x[2], x[3]))); }
                mx = fmaxf(mx, __shfl_xor(mx, 16)); mx = fmaxf(mx, __shfl_xor(mx, 32));
                if (fq == 0) RM[(ai * HALF + wr * 64 + m * 16 + fr) * 4 + wc] = mx; }
        LDS_WAIT(); __builtin_amdgcn_s_barrier(); asm volatile("" ::: "memory");
#pragma unroll
        for (int ai = 0; ai < 2; ++ai)
#pragma unroll
            for (int m = 0; m < 4; ++m) { const int rl = ai * HALF + wr * 64 + m * 16 + fr; const f32x4 mm = *(LAS f32x4*)(RM + rl * 4);
                const float mx = fmaxf(fmaxf(mm[0], mm[1]), fmaxf(mm[2], mm[3])); float s = 0.f;
#pragma unroll
                for (int bj = 0; bj < 2; ++bj)
#pragma unroll
                    for (int n = 0; n < 2; ++n) { f32x4 x = acc[ai][bj][m][n]; x[0] = ex2(x[0] - mx); x[1] = ex2(x[1] - mx); x[2] = ex2(x[2] - mx); x[3] = ex2(x[3] - mx); acc[ai][bj][m][n] = x; s += (x[0] + x[1]) + (x[2] + x[3]); }
                s += __shfl_xor(s, 16); s += __shfl_xor(s, 32);
                if (fq == 0) RS[rl * 4 + wc] = s; }
        LDS_WAIT(); __builtin_amdgcn_s_barrier(); asm volatile("" ::: "memory");
#pragma unroll
        for (int ai = 0; ai < 2; ++ai)
#pragma unroll
            for (int m = 0; m < 4; ++m) { const int rl = ai * HALF + wr * 64 + m * 16 + fr; const f32x4 ss = *(LAS f32x4*)(RS + rl * 4);
                const float inv = rcp((ss[0] + ss[1]) + (ss[2] + ss[3])); bf16* rp = E.O + (size_t)(u.pm * BM + rl) * E.ldc + colp;
#pragma unroll
                for (int bj = 0; bj < 2; ++bj) st8(rp + bj * HALF, acc[ai][bj][m][0] * inv, acc[ai][bj][m][1] * inv); }
    } break;
    case E_SWIGLU: {
        const int colh = u.pn * HALF + wc * 32 + 8 * fq;
#pragma unroll
        for (int ai = 0; ai < 2; ++ai)
#pragma unroll
            for (int m = 0; m < 4; ++m) { const size_t row = (size_t)(rowb + ai * HALF + m * 16); const float rs = rsqrtf(E.vec0[row] * (1.f / D) + RMS_EPS); f32x4 o[2];
#pragma unroll
                for (int n = 0; n < 2; ++n) { const f32x4 g = acc[ai][0][m][n] * rs, uu = acc[ai][1][m][n] * rs;
#pragma unroll
                    for (int e = 0; e < 4; ++e) o[n][e] = g[e] * sigmoidf_(g[e]) * uu[e]; }
                st8(E.O + row * DFF + colh, o[0], o[1]); }
    } break;
    case E_ODIN: {
        const bool isg = u.pn < 4;
#pragma unroll
        for (int ai = 0; ai < 2; ++ai)
#pragma unroll
            for (int m = 0; m < 4; ++m) { const size_t row = (size_t)(rowb + ai * HALF + m * 16); const float rs = rsqrtf(E.vec0[row] * (1.f / D) + RMS_EPS);
                bf16* rp = (isg ? E.O + row * D + colp : E.O2 + row * D + (colp - D));
#pragma unroll
                for (int bj = 0; bj < 2; ++bj) { f32x4 v0 = acc[ai][bj][m][0] * rs, v1 = acc[ai][bj][m][1] * rs;
                    if (isg) {
#pragma unroll
                        for (int e = 0; e < 4; ++e) { v0[e] = gelu_tanh(v0[e]); v1[e] = gelu_tanh(v1[e]); } }
                    st8(rp + bj * HALF, v0, v1); } }
    } break;
    case E_GATE: {
        const int c = (u.pn >> 1) * 256 + (u.pn & 1) * HALF + wc * 32 + 8 * fq;
        f32x4 br[2], bi[2], sp[2];
#pragma unroll
        for (int n = 0; n < 2; ++n) { br[n] = *(const f32x4*)(E.vec0 + c + 4 * n); bi[n] = *(const f32x4*)(E.vec1 + c + 4 * n); sp[n] = *(const f32x4*)(E.vec2 + c + 4 * n); }
#pragma unroll
        for (int ai = 0; ai < 2; ++ai)
#pragma unroll
            for (int m = 0; m < 4; ++m) { const size_t row = (size_t)(rowb + ai * HALF + m * 16); const bool rst = E.pos[row] == 0;
                const u32x4 xw = *(const u32x4*)(E.xb + row * D + c); const float xv[8] = {bflo(xw.x), bfhi(xw.x), bflo(xw.y), bfhi(xw.y), bflo(xw.z), bfhi(xw.z), bflo(xw.w), bfhi(xw.w)};
                f32x4 av[2], bv[2];
#pragma unroll
                for (int n = 0; n < 2; ++n) { const f32x4 pr = acc[ai][0][m][n] + br[n], pi = acc[ai][1][m][n] + bi[n];
#pragma unroll
                    for (int e = 0; e < 4; ++e) { const float r = sigmoidf_(pr[e]), ig = sigmoidf_(pi[e]); const float la = -sp[n][e] * r; float a = ex2(la * LOG2E);
                        const float x2 = 2.0f * la; const float om = (x2 > -0.01f) ? -(x2 + x2 * x2 * (0.5f + x2 * (1.0f / 6.0f))) : 1.0f - ex2(x2 * LOG2E);
                        float mult = sqrtf(fmaxf(om, 0.f)); if (rst) { a = 0.f; mult = 1.f; }
                        av[n][e] = a; bv[n][e] = mult * (ig * xv[4 * n + e]); } }
                *(f32x4*)(E.aout + row * D + c) = av[0]; *(f32x4*)(E.aout + row * D + c + 4) = av[1]; st8(E.O + row * D + c, bv[0], bv[1]); }
    } break;
    case E_VT: {
#pragma unroll
        for (int ai = 0; ai < 2; ++ai)
#pragma unroll
            for (int m = 0; m < 4; ++m) { const size_t row = (size_t)(rowb + ai * HALF + m * 16);
#pragma unroll
                for (int bj = 0; bj < 2; ++bj) { const int col = colp + bj * HALF, b16 = col & ~15, hf = (col >> 3) & 1; bf16* rp = E.O + row * E.ldc + b16 + 4 * hf;
                    st4(rp, acc[ai][bj][m][0]); st4(rp + 8, acc[ai][bj][m][1]); } }
    } break;
    default: break;
    }
}

__device__ __forceinline__ void gemm_phase(LAS unsigned char* lds, const Gemm g, const StaticOrder& S, const Epi& E, const int tid) {
    const int wid = __builtin_amdgcn_readfirstlane(tid >> 6), lane = tid & 63, wr = wid >> 2, wc = wid & 3, fr = lane & 15, fq = lane >> 4;
    const int K = g.K, nt = K / BK;
    unsigned voffA, voffB;
    { int R, C; stage_rc(tid * 16, R, C); const bool perm = (E.mode != E_EVIN) && (E.mode != E_QROPE);
      const int rho = R & 31, Rb = perm ? ((R & ~31) + 8 * ((rho & 15) >> 2) + 4 * (rho >> 4) + (rho & 3)) : R;
      voffA = (unsigned)(R * g.lda + C) * 2u; voffB = (unsigned)(Rb * g.ldb + C) * 2u; }
    const size_t q64A = (size_t)64 * g.lda * 2, q64B = (size_t)64 * g.ldb * 2;
    const size_t kstep = (size_t)(BK * 2);
    const size_t hstepA = (size_t)HALF * g.lda * 2, hstepB = (size_t)HALF * g.ldb * 2;
    const unsigned ldsw = (unsigned)wid * 1024u;
    const int aoff = lds_byte(wr * 64 + fr, fq * 8), boff = lds_byte(wc * 32 + fr, fq * 8);
#define PG8_ABASE(u) ((const char*)g.A + ((size_t)(u).pm * g.a_pm_off + (size_t)((u).pn >> g.a_pn_shift) * g.a_pn_off) * 2)
#define PG8_BBASE(u) ((const char*)g.Bt + ((size_t)(u).pn * g.b_pn_off + (size_t)((u).pm / g.b_pm_div) * g.b_pm_off) * 2)
#define PG8_SA(b, h) (((b) * 2 + (h)) * HTB)
#define PG8_SB(b, h) ((4 + (b) * 2 + (h)) * HTB)
#define PG8_Q64(v) PG8_Q64_##v
#define PG8_Q64_voffA q64A
#define PG8_Q64_voffB q64B
#define PG8_STAGE(bufoff, gbase, voff) do { \
        __builtin_amdgcn_global_load_lds((const unsigned*)((const char*)(gbase) + (voff)), (LAS unsigned*)(lds + (bufoff) + ldsw), 16, 0, 0); \
        __builtin_amdgcn_global_load_lds((const unsigned*)((const char*)(gbase) + PG8_Q64(voff) + (voff)), (LAS unsigned*)(lds + (bufoff) + ldsw + 8192), 16, 0, 0); } while (0)
#define PG8_LDA(dst, b, h) do { _Pragma("unroll") for (int m = 0; m < 4; ++m) _Pragma("unroll") for (int k = 0; k < 2; ++k) dst[m][k] = *(const LAS bf16x8*)(lds + PG8_SA(b, h) + aoff + m * 2048 + k * 1024); } while (0)
#define PG8_LDB(dst, b, h) do { _Pragma("unroll") for (int n = 0; n < 2; ++n) _Pragma("unroll") for (int k = 0; k < 2; ++k) dst[n][k] = *(const LAS bf16x8*)(lds + PG8_SB(b, h) + boff + n * 2048 + k * 1024); } while (0)
#define PG8_MMA(ai, bj, At, Bt) do { __builtin_amdgcn_s_setprio(1); _Pragma("unroll") for (int m = 0; m < 4; ++m) _Pragma("unroll") for (int n = 0; n < 2; ++n) _Pragma("unroll") for (int k = 0; k < 2; ++k) \
        acc[ai][bj][m][n] = __builtin_amdgcn_mfma_f32_16x16x32_bf16(Bt[n][k], At[m][k], acc[ai][bj][m][n], 0, 0, 0); __builtin_amdgcn_s_setprio(0); } while (0)
#define PG8_WAIT_V(n) asm volatile("s_waitcnt vmcnt(" #n ")" ::: "memory")
#define PG8_WAIT_L(n) asm volatile("s_waitcnt lgkmcnt(" #n ")" ::: "memory")
#define PG8_BAR __builtin_amdgcn_s_barrier()
#define PG8_SCHED __builtin_amdgcn_sched_barrier(0)
    Unit cur, nxt; int ui = 0;
    if (!S.next(0, cur)) return;
    f32x4 acc[2][2][4][2];
#pragma unroll
    for (int a = 0; a < 2; ++a)
#pragma unroll
        for (int b = 0; b < 2; ++b)
#pragma unroll
            for (int m = 0; m < 4; ++m)
#pragma unroll
                for (int n = 0; n < 2; ++n) acc[a][b][m][n] = (f32x4){0.f, 0.f, 0.f, 0.f};
    bf16x8 At[4][2], B0[2][2], B1[2][2];
    const char* cA = PG8_ABASE(cur); const char* cB = PG8_BBASE(cur);
    PG8_STAGE(PG8_SB(0, 0), cB, voffB); PG8_STAGE(PG8_SB(0, 1), cB + hstepB, voffB); PG8_STAGE(PG8_SA(0, 0), cA, voffA); PG8_STAGE(PG8_SA(0, 1), cA + hstepA, voffA);
    if (wr == 1) PG8_BAR;
    PG8_WAIT_V(2); PG8_BAR;
    PG8_STAGE(PG8_SB(1, 0), cB + kstep, voffB); PG8_STAGE(PG8_SA(1, 0), cA + kstep, voffA); PG8_STAGE(PG8_SB(1, 1), cB + hstepB + kstep, voffB);
    PG8_WAIT_V(6); PG8_BAR;
    for (;;) {
        const bool has_next = S.next(ui + 1, nxt);
        const char* nA = has_next ? PG8_ABASE(nxt) : cA; const char* nB = has_next ? PG8_BBASE(nxt) : cB;
        for (int t = 0; t < nt; t += 2) {
            const bool last = (t == nt - 2);
            const char* a1 = cA + (size_t)(t + 1) * kstep;
            const char* a2 = last ? nA : cA + (size_t)(t + 2) * kstep; const char* b2 = last ? nB : cB + (size_t)(t + 2) * kstep;
            const char* a3 = a2 + kstep; const char* b3 = b2 + kstep;
            PG8_LDB(B0, 0, 0); PG8_LDB(B1, 0, 1); PG8_SCHED; PG8_LDA(At, 0, 0); PG8_STAGE(PG8_SA(1, 1), a1 + hstepA, voffA);
            PG8_WAIT_V(8); PG8_WAIT_L(0); PG8_BAR; PG8_MMA(0, 0, At, B0); PG8_MMA(0, 1, At, B1); PG8_BAR; PG8_SCHED;
            PG8_LDA(At, 0, 1); PG8_STAGE(PG8_SB(0, 0), b2, voffB); PG8_STAGE(PG8_SB(0, 1), b2 + hstepB, voffB); PG8_STAGE(PG8_SA(0, 0), a2, voffA);
            PG8_WAIT_V(8); PG8_WAIT_L(0); PG8_BAR; PG8_MMA(1, 0, At, B0); PG8_MMA(1, 1, At, B1); PG8_BAR; PG8_SCHED;
            PG8_LDB(B0, 1, 0); PG8_LDB(B1, 1, 1); PG8_SCHED; PG8_LDA(At, 1, 0); PG8_STAGE(PG8_SA(0, 1), a2 + hstepA, voffA);
            PG8_WAIT_V(8); PG8_WAIT_L(0); PG8_BAR; PG8_MMA(0, 0, At, B0); PG8_MMA(0, 1, At, B1); PG8_BAR; PG8_SCHED;
            PG8_LDA(At, 1, 1); PG8_STAGE(PG8_SB(1, 0), b3, voffB); PG8_STAGE(PG8_SB(1, 1), b3 + hstepB, voffB); PG8_STAGE(PG8_SA(1, 0), a3, voffA);
            PG8_WAIT_V(8); PG8_WAIT_L(0); PG8_BAR; PG8_MMA(1, 0, At, B0); PG8_MMA(1, 1, At, B1); PG8_BAR; PG8_SCHED;
        }
        if (wr == 0) PG8_BAR;
        run_epi(E, acc, cur, wr, wc, fr, fq, lds);
        if (!has_next) break;
#pragma unroll
        for (int a = 0; a < 2; ++a)
#pragma unroll
            for (int b = 0; b < 2; ++b)
#pragma unroll
                for (int m = 0; m < 4; ++m)
#pragma unroll
                    for (int n = 0; n < 2; ++n) acc[a][b][m][n] = (f32x4){0.f, 0.f, 0.f, 0.f};
        cur = nxt; cA = nA; cB = nB; ++ui;
        if (wr == 1) PG8_BAR;
    }
    PG8_WAIT_V(0);
    PG8_BAR;
#undef PG8_ABASE
#undef PG8_BBASE
#undef PG8_SA
#undef PG8_SB
#undef PG8_STAGE
#undef PG8_Q64
#undef PG8_Q64_voffA
#undef PG8_Q64_voffB
#undef PG8_LDA
#undef PG8_LDB
#undef PG8_MMA
#undef PG8_WAIT_V
#undef PG8_WAIT_L
#undef PG8_BAR
#undef PG8_SCHED
}
}

namespace att {
#define ATT_BAR() do { asm volatile("s_waitcnt lgkmcnt(0)" ::: "memory"); __builtin_amdgcn_s_barrier(); asm volatile("" ::: "memory"); } while (0)
constexpr int KST_B = 208  , VST_B = 144  ;
constexpr int KBYTES = 64 * KST_B, VBYTES = 64 * VST_B, BUFB = KBYTES + VBYTES;
__device__ __forceinline__ int crow(int r, int hi) { return (r & 3) + 8 * (r >> 2) + 4 * hi; }
constexpr int NSLOT = 4, NPIECE = 22;
__device__ __forceinline__ void attn_unit(int b, int h, int qb, const bf16* Q, const bf16* KN, const bf16* KR, const bf16* VT, bf16* OUT, LAS unsigned char* lds, const int tid) {
    const int lane = tid & 63, r32 = lane & 31, hi = lane >> 5, wid = __builtin_amdgcn_readfirstlane(tid >> 6);
    const size_t rowbase = (size_t)b * SEQ; const int q0 = qb * 256; const int qrow = q0 + wid * 32 + r32;
    const int NT = (q0 + 256) / 64;
    const char* gp[3]; unsigned ginc[3];
#pragma unroll
    for (int i = 0; i < 3; ++i) { const int p = wid + 8 * i;
        if (p < 13) { const int c = p * 64 + lane, row = c / 13, c16 = c % 13;
            if (c16 >= 8 && c16 < 12) { gp[i] = (const char*)(KR + (rowbase + row) * 32 + (c16 - 8) * 8); ginc[i] = 64 * 32 * 2; }
            else { gp[i] = (const char*)(KN + (rowbase + row) * 512 + h * 64 + (c16 < 8 ? c16 : 0) * 8); ginc[i] = 64 * 512 * 2; } }
        else { const int c = ((p < NPIECE ? p : 13) - 13) * 64 + lane, d = c / 9, c16 = c % 9;
            gp[i] = (const char*)(VT + (size_t)(h * 64 + d) * M + rowbase + (c16 < 8 ? c16 : 0) * 8); ginc[i] = 64 * 2; } }
#define ATT_DMA(t) do { LAS unsigned char* sl_ = lds + ((t) & (NSLOT - 1)) * BUFB + wid * 1024; \
        __builtin_amdgcn_global_load_lds((const unsigned*)(gp[0] + (size_t)(t) * ginc[0]), (LAS unsigned*)(sl_), 16, 0, 0); \
        __builtin_amdgcn_global_load_lds((const unsigned*)(gp[1] + (size_t)(t) * ginc[1]), (LAS unsigned*)(sl_ + 8192), 16, 0, 0); \
        if (wid < NPIECE - 16) __builtin_amdgcn_global_load_lds((const unsigned*)(gp[2] + (size_t)(t) * ginc[2]), (LAS unsigned*)(sl_ + 16384), 16, 0, 0); } while (0)
    bf16x8 qr[6];
    { const bf16* qp = Q + (rowbase + qrow) * 768 + h * 96 + hi * 8;
#pragma unroll
      for (int ks = 0; ks < 6; ++ks) qr[ks] = *(const bf16x8*)(qp + ks * 16); }
    asm volatile("s_waitcnt vmcnt(0)" ::: "memory");
    ATT_DMA(0); ATT_DMA(1); ATT_DMA(2);
    f32x16 o0, o1;
#pragma unroll
    for (int r = 0; r < 16; ++r) { o0[r] = 0.f; o1[r] = 0.f; }
    float mrun = 0.f, lrun = 0.f;
    f32x16 negm;
#pragma unroll
    for (int r = 0; r < 16; ++r) negm[r] = 0.f;
    const int qmin = q0 + wid * 32;
    asm volatile("s_waitcnt vmcnt(4)" ::: "memory");
    ATT_BAR();
    if (wid >= 4) ATT_BAR();
#pragma unroll 1
    for (int t = 0; t < NT; ++t) {
        if (t + 3 < NT) ATT_DMA(t + 3);
        const int kv0 = t * 64;
        const bool active = kv0 <= qmin + 31;
        bf16x8 vf0[4], vf1[4]; f32x16 p0, p1;
        if (active) {
            const LAS unsigned char* buf = lds + (t & (NSLOT - 1)) * BUFB;
            const LAS unsigned char* kb = buf + r32 * KST_B + hi * 16;
            const LAS unsigned char* vb = buf + KBYTES + r32 * VST_B + hi * 16;
#pragma unroll
            for (int s = 0; s < 4; ++s) { vf0[s] = *(const LAS bf16x8*)(vb + s * 32); vf1[s] = *(const LAS bf16x8*)(vb + 32 * VST_B + s * 32); }
            __builtin_amdgcn_sched_barrier(0);
#pragma unroll
            for (int ks = 0; ks < 6; ++ks) { const bf16x8 a0 = *(const LAS bf16x8*)(kb + ks * 32), a1 = *(const LAS bf16x8*)(kb + 32 * KST_B + ks * 32);
                if (ks == 0) { p0 = __builtin_amdgcn_mfma_f32_32x32x16_bf16(a0, qr[0], negm, 0, 0, 0); p1 = __builtin_amdgcn_mfma_f32_32x32x16_bf16(a1, qr[0], negm, 0, 0, 0); }
                else { p0 = __builtin_amdgcn_mfma_f32_32x32x16_bf16(a0, qr[ks], p0, 0, 0, 0); p1 = __builtin_amdgcn_mfma_f32_32x32x16_bf16(a1, qr[ks], p1, 0, 0, 0); } }
        }
        if (t + 3 < NT) asm volatile("s_waitcnt vmcnt(4)" ::: "memory");
        else asm volatile("s_waitcnt vmcnt(0)" ::: "memory");
        ATT_BAR();
        if (active) {
            if (kv0 + 63 > qmin) {
#pragma unroll
                for (int r = 0; r < 16; ++r) { const int kv = kv0 + crow(r, hi); if (kv > qrow) p0[r] = -1e30f; if (kv + 32 > qrow) p1[r] = -1e30f; }
            }
            float mx = __builtin_amdgcn_fmed3f(p0[0], p1[0], __builtin_inff());
#pragma unroll
            for (int r = 1; r < 16; ++r) { mx = __builtin_amdgcn_fmed3f(mx, p0[r], __builtin_inff()); mx = __builtin_amdgcn_fmed3f(mx, p1[r], __builtin_inff()); }
            { auto rr = __builtin_amdgcn_permlane32_swap(__float_as_uint(mx), __float_as_uint(mx), false, false); mx = fmaxf(__uint_as_float(rr[0]), __uint_as_float(rr[1])); }
            const bool first = (t == 0);
            if (first || __builtin_amdgcn_ballot_w64(mx > 0.f) != 0ull) {
                const float d = first ? mx : fmaxf(mx, 0.f); mrun += d;
                if (!first) { const float alpha = ex2(-d); lrun *= alpha;
#pragma unroll
                    for (int r = 0; r < 16; ++r) { o0[r] *= alpha; o1[r] *= alpha; } }
#pragma unroll
                for (int r = 0; r < 16; ++r) { p0[r] -= d; p1[r] -= d; negm[r] = -mrun; }
            }
            float rs0 = 0.f, rs1 = 0.f;
#pragma unroll
            for (int r = 0; r < 16; ++r) { p0[r] = ex2(p0[r]); p1[r] = ex2(p1[r]); rs0 += p0[r]; asm volatile("" : "+v"(rs0)); rs1 += p1[r]; asm volatile("" : "+v"(rs1)); }
            lrun += rs0 + rs1;
            u32x4 pw[4];
#pragma unroll
            for (int j = 0; j < 4; ++j) { pw[0][j] = pk2(p0[2 * j], p0[2 * j + 1]); pw[1][j] = pk2(p0[8 + 2 * j], p0[8 + 2 * j + 1]); pw[2][j] = pk2(p1[2 * j], p1[2 * j + 1]); pw[3][j] = pk2(p1[8 + 2 * j], p1[8 + 2 * j + 1]); }
#pragma unroll
            for (int s = 0; s < 4; ++s) { const bf16x8 pf = __builtin_bit_cast(bf16x8, pw[s]);
                o0 = __builtin_amdgcn_mfma_f32_32x32x16_bf16(vf0[s], pf, o0, 0, 0, 0); o1 = __builtin_amdgcn_mfma_f32_32x32x16_bf16(vf1[s], pf, o1, 0, 0, 0); }
        }
        ATT_BAR();
    }
    if (wid < 4) ATT_BAR();
#undef ATT_DMA
    float ltot; { auto rr = __builtin_amdgcn_permlane32_swap(__float_as_uint(lrun), __float_as_uint(lrun), false, false); ltot = __uint_as_float(rr[0]) + __uint_as_float(rr[1]); }
    const float inv = rcp(ltot);
    bf16* op = OUT + (rowbase + qrow) * 1024 + h * 64 + 4 * hi;
#pragma unroll
    for (int g = 0; g < 4; ++g) {
        u32x2 w0, w1; w0.x = pk2(o0[4 * g] * inv, o0[4 * g + 1] * inv); w0.y = pk2(o0[4 * g + 2] * inv, o0[4 * g + 3] * inv);
        w1.x = pk2(o1[4 * g] * inv, o1[4 * g + 1] * inv); w1.y = pk2(o1[4 * g + 2] * inv, o1[4 * g + 3] * inv);
        *(u32x2*)(op + 8 * g) = w0; *(u32x2*)(op + 32 + 8 * g) = w1; }
    asm volatile("s_waitcnt vmcnt(0)" ::: "memory");
}
}

constexpr size_t MiB = 1u << 20;
constexpr size_t WS_BAR = 32 * 1024;
constexpr size_t WS_SP8 = 0;
constexpr size_t WS_CA = 64 * 1024, WS_CB = WS_CA + 256 * 1024 * 4;
constexpr size_t WS_SSQ = 2 * MiB + 128 * 1024;
constexpr size_t WS_COS = 3 * MiB, WS_SIN = 5 * MiB;
constexpr size_t WS_MN = 7 * MiB;
constexpr size_t WS_MK = 9 * MiB;
constexpr size_t WS_MVT = 11 * MiB;
constexpr size_t WS_W = 13 * MiB;
constexpr size_t W_EVIN = WS_W, W_POOL = W_EVIN + 2 * MiB, W_QUP = W_POOL + MiB, W_KN = W_QUP + MiB, W_V = W_KN + MiB / 4, W_EVOUT = W_KN + MiB;
constexpr size_t W_ODIN = W_EVOUT + 2 * MiB, W_GATE = W_ODIN + 4 * MiB, W_ODOUT = W_GATE + MiB, W_XAQ = W_ODOUT + 2 * MiB  , W_XAKV = W_XAQ + 4 * MiB  ;
constexpr size_t W_XAO = W_XAKV + 8 * MiB  , W_FFN1 = W_XAO + 4 * MiB  , W_FFN2 = W_FFN1 + 22 * MiB  , W_END = W_FFN2 + 11 * MiB;
static_assert(W_END <= 80 * MiB, "weights");
constexpr size_t WS_XN = 80 * MiB;
constexpr size_t WS_MIX = 144 * MiB;
constexpr size_t WS_H = 208 * MiB;
constexpr size_t WS_U = 208 * MiB, WS_CQ = 240 * MiB, WS_CKV = 256 * MiB, WS_KR = 264 * MiB, WS_POOLED = 266 * MiB, WS_CQN = 298 * MiB, WS_CKVN = 314 * MiB, WS_Q = 322 * MiB;
constexpr size_t WS_KN = 384 * MiB, WS_VT = 416 * MiB;
constexpr size_t WS_XQ = 208 * MiB, WS_P = 272 * MiB;
constexpr size_t WS_GB = 208 * MiB, WS_XBP = 272 * MiB, WS_B = 272 * MiB, WS_A = 336 * MiB;
constexpr size_t WS_NEED = 464 * MiB;

struct Args {
    const float* x; const float* mem; const int* pos;
    const float *ev_norm, *ev_w_in, *ev_pool_w, *ev_pool_scale, *ev_q_norm, *ev_w_q_up, *ev_kv_norm, *ev_w_kv_up, *ev_w_out;
    const float *od_norm, *od_w_in, *od_conv_w, *od_conv_b, *od_w_rgate, *od_b_rgate, *od_w_igate, *od_b_igate, *od_lambda, *od_w_out;
    const float *xa_norm_x, *xa_norm_mem, *xa_w_q, *xa_w_kv, *xa_w_o, *ffn_norm, *ffn_w_gate_up, *ffn_w_down, *final_norm;
    float* out; unsigned char* ws; int ph_lo, ph_hi;
};

__device__ __forceinline__ void tr_item(const float* W, int ldw, int k0, int n0, bf16* dst, int ldd, LAS float* scr, int lane, const float* kg) {
#pragma unroll
    for (int i = 0; i < 32; ++i) { const int kk = 2 * i + (lane >> 5); float w = W[(size_t)(k0 + kk) * ldw + n0 + (lane & 31)]; if (kg) w *= kg[k0 + kk]; scr[kk * 33 + (lane & 31)] = w; }
    LDS_WAIT(); asm volatile("" ::: "memory");
    const int c = lane & 7;
#pragma unroll
    for (int j = 0; j < 4; ++j) { const int n = (lane >> 3) + 8 * j; const LAS float* s = scr + (8 * c) * 33 + n;
        u32x4 o; o.x = pk2(s[0 * 33], s[1 * 33]); o.y = pk2(s[2 * 33], s[3 * 33]); o.z = pk2(s[4 * 33], s[5 * 33]); o.w = pk2(s[6 * 33], s[7 * 33]);
        *(u32x4*)(dst + (size_t)n * ldd + k0 + 8 * c) = o; }
    LDS_WAIT(); asm volatile("" ::: "memory");
}
template <class RM> __device__ __forceinline__ void tr_matrix(const float* W, int K, int N, int ldd, RM rowptr, LAS float* scr, int gw, int NGW, int lane, int& rot, const float* kg = nullptr) {
    const int nblk = N / 32, nit = (K / 64) * nblk;
    int start = (gw - (rot % NGW) + NGW) % NGW;
    for (int it = start; it < nit; it += NGW) { const int kb = it / nblk, nb = it % nblk; tr_item(W, N, 64 * kb, 32 * nb, rowptr(32 * nb), ldd, scr, lane, kg); }
    rot += nit;
}
__device__ __forceinline__ void rms_row_bf16(const float* xrow, const float* g, bf16* orow, int lane) {
    const f32x4* xr = (const f32x4*)xrow + lane; const f32x4* gr = (const f32x4*)g + lane;
    f32x4 v[4]; float s = 0.f;
#pragma unroll
    for (int j = 0; j < 4; ++j) { v[j] = xr[64 * j]; s += (v[j][0] * v[j][0] + v[j][1] * v[j][1]) + (v[j][2] * v[j][2] + v[j][3] * v[j][3]); }
    const float rstd = rsqrtf(wave_sum(s) * (1.f / D) + RMS_EPS);
#pragma unroll
    for (int j = 0; j < 4; ++j) { const f32x4 o = v[j] * rstd * gr[64 * j]; u32x2 w; w.x = pk2(o[0], o[1]); w.y = pk2(o[2], o[3]); *(u32x2*)(orow + 4 * lane + 256 * j) = w; }
}
__device__ __forceinline__ void norm_pass(const float* X, const float* g, bf16* XN, int gw, int NGW, int lane) {
    for (int m = gw; m < M; m += NGW) rms_row_bf16(X + (size_t)m * D, g, XN + (size_t)m * D, lane);
}

__device__ __forceinline__ int fresh_tid(int wave) { int l; asm volatile("v_mbcnt_lo_u32_b32 %0, -1, 0\n\tv_mbcnt_hi_u32_b32 %0, -1, %0" : "=v"(l)); return wave * 64 + l; }
#define XB_TMO      128
#define XB_XCNT(j)  (256  + 64 * (j))
#define XB_XSUB(j)  (1280 + 64 * (j))
#define XB_XGEN(j)  (2304 + 64 * (j))
#define XB_TOP      3328
#define XB_TOPGEN   3392
#define XCD_BAR_WORDS 3456
#define XB_SPIN_CAP (1u << 18)
__device__ __forceinline__ unsigned xb_ld(unsigned* p)              { return __hip_atomic_load(p, __ATOMIC_RELAXED, __HIP_MEMORY_SCOPE_AGENT); }
__device__ __forceinline__ unsigned xb_add(unsigned* p, unsigned v) { return __hip_atomic_fetch_add(p, v, __ATOMIC_RELAXED, __HIP_MEMORY_SCOPE_AGENT); }
__device__ __forceinline__ unsigned xb_xcc_id() { return (unsigned)__builtin_amdgcn_s_getreg((3 << 11) | 20) & 0xFu; }
#define XB_SPIN(cond, bar) do { unsigned _sp = 0; while (cond) { __builtin_amdgcn_s_sleep(1); \
    if ((++_sp & 255u) == 0u) { if (xb_ld(&(bar)[XB_TMO])) break; if (_sp > XB_SPIN_CAP) { atomicAdd(&(bar)[XB_TMO], 1u); break; } } } } while (0)
__device__ __forceinline__ void xcd_barrier_complete(unsigned* bar, unsigned x, unsigned G, unsigned& nloc, unsigned& nx) {
    unsigned sum, cnt, mine, sp = 0u;
    for (;;) {
        sum = 0u; cnt = 0u; mine = 0u;
#pragma unroll
        for (unsigned j = 0; j < 16; ++j) { const unsigned c = xb_ld(&bar[XB_XCNT(j)]); sum += c; cnt += (c > 0u) ? 1u : 0u; mine = (j == x) ? c : mine; }
        if (sum == G) break;
        __builtin_amdgcn_s_sleep(1);
        if ((++sp & 255u) == 0u) { if (xb_ld(&bar[XB_TMO])) break; if (sp > XB_SPIN_CAP) { atomicAdd(&bar[XB_TMO], 1u); break; } }
    }
    nloc = mine > 0u ? mine : 1u; nx = cnt > 0u ? cnt : 1u;
}
__device__ __forceinline__ void xcd_barrier(unsigned* bar, unsigned x, volatile LAS unsigned* st, unsigned G, int tid) {
    asm volatile("s_waitcnt vmcnt(0)" ::: "memory");
    __syncthreads();
    if (tid == 0) {
        __builtin_amdgcn_s_waitcnt(0);
        unsigned nloc = st[0], nx = st[1];
        if (nloc == 0u) { xcd_barrier_complete(bar, x, G, nloc, nx); st[0] = nloc; st[1] = nx; }
        const unsigned old = xb_add(&bar[XB_XSUB(x)], 1u);
        const unsigned gen = old / nloc;
        if (old + 1u == (gen + 1u) * nloc) {
            __builtin_amdgcn_fence(__ATOMIC_RELEASE, "agent");
            asm volatile("s_waitcnt vmcnt(0)" ::: "memory");
            const unsigned og = xb_add(&bar[XB_TOP], 1u);
            const unsigned tg = og / nx;
            if (og + 1u == (tg + 1u) * nx) xb_add(&bar[XB_TOPGEN], 1u);
            else XB_SPIN(xb_ld(&bar[XB_TOPGEN]) == tg, bar);
            __builtin_amdgcn_fence(__ATOMIC_ACQUIRE, "agent");
            xb_add(&bar[XB_XGEN(x)], 1u);
            asm volatile("s_waitcnt vmcnt(0)" ::: "memory");
        } else {
            XB_SPIN(xb_ld(&bar[XB_XGEN(x)]) == gen, bar);
            __builtin_amdgcn_fence(__ATOMIC_ACQUIRE, "agent");
            asm volatile("s_waitcnt vmcnt(0)" ::: "memory");
        }
    }
    __syncthreads();
}

typedef const __attribute__((address_space(4))) Args* KArgs;
__global__ void __launch_bounds__(NTHREADS, 2) hybrid_fwd(Args a_) {
    extern __shared__ __attribute__((aligned(16))) unsigned char lds_raw[];
    LAS unsigned char* lds = (LAS unsigned char*)lds_raw;
    cg::grid_group grid = cg::this_grid();
    const int wave = __builtin_amdgcn_readfirstlane(threadIdx.x >> 6);
    const int G = gridDim.x, bx = blockIdx.x;
    volatile LAS unsigned* const xst = (volatile LAS unsigned*)(lds + EPI_OFF + 16000);
    if (threadIdx.x == 0) { xst[0] = 0u; xst[1] = 0u; }
    if (threadIdx.x == 0) (void)xb_add((unsigned*)(a_.ws + WS_BAR) + XB_XCNT(xb_xcc_id()), 1u);
    __syncthreads();
    if (a_.ph_hi < 0) grid.sync();
    const int vcu = (G % 8 == 0) ? (bx % 8) * (G / 8) + bx / 8 : bx;
    const int gw = vcu * NWAVES + wave, NGW = G * NWAVES;
#ifndef PREFIX_K
#define PREFIX_K 0
#endif
#pragma unroll 1
    for (int pass = (PREFIX_K > 0 ? 0 : 1); pass < 2; ++pass) {
    const int lo = a_.ph_lo, hi = (pass == 0) ? PREFIX_K : a_.ph_hi;
    int ph = 0;
#define a (*ap)
#ifndef PROBE_MASK
#define PROBE_MASK (0ull)
#endif
#define PHASE_BEGIN if (lo <= ph && ph < hi) for (int rep_ = ((PROBE_MASK >> ph) & 1ull) ? 2 : 1; rep_ > 0; --rep_) { KArgs ap = (KArgs)__builtin_amdgcn_kernarg_segment_ptr(); asm volatile("" : "+s"(ap)); int lane; asm volatile("v_mbcnt_lo_u32_b32 %0, -1, 0\n\tv_mbcnt_hi_u32_b32 %0, -1, %0" : "=v"(lane)); const int tid = wave * 64 + lane; (void)tid; unsigned char* const ws = a.ws; float* const outp = a.out; \
    bf16* const XN = WSP(bf16, WS_XN); bf16* const MIX = WSP(bf16, WS_MIX); const float* cosT = WSP(float, WS_COS); const float* sinT = WSP(float, WS_SIN); (void)XN; (void)MIX; (void)cosT; (void)sinT; (void)outp;
#define PHASE_END   if (rep_ == 1 && (ph + 1 < hi || pass == 0)) { xcd_barrier((unsigned*)(ws + WS_BAR), xb_xcc_id(), (volatile LAS unsigned*)(lds + EPI_OFF + 16000), (unsigned)G, tid); } } ++ph;
#define WSP(T, off) ((T*)(ws + (off)))
    using pg8::Gemm; using pg8::Epi; using pg8::StaticOrder;

    PHASE_BEGIN
    {
        LAS float* scr = (LAS float*)(lds + wave * 16384);
        int rot = 0;
        tr_matrix(a.ev_w_in, 1024, 928, 1024, [&](int n0) { return WSP(bf16, W_EVIN) + (size_t)n0 * 1024; }, scr, gw, NGW, lane, rot);
        tr_matrix(a.ev_w_q_up, 256, 768, 256, [&](int n0) { return WSP(bf16, W_QUP) + (size_t)n0 * 256; }, scr, gw, NGW, lane, rot);
        tr_matrix(a.ev_w_kv_up, 128, 1024, 128, [&](int n0) { const int h = n0 >> 7, j0 = n0 & 127; return (j0 < 64 ? WSP(bf16, W_KN) : WSP(bf16, W_V)) + (size_t)(h * 64 + (j0 & 63)) * 128; }, scr, gw, NGW, lane, rot);
        tr_matrix(a.ev_w_out, 1024, 1024, 1024, [&](int n0) { return WSP(bf16, W_EVOUT) + (size_t)n0 * 1024; }, scr, gw, NGW, lane, rot);
        tr_matrix(a.od_w_in, 1024, 2048, 1024, [&](int n0) { return WSP(bf16, W_ODIN) + (size_t)n0 * 1024; }, scr, gw, NGW, lane, rot, a.od_norm);
        for (int h = 0; h < 4; ++h) {
            tr_matrix(a.od_w_rgate + (size_t)h * 65536, 256, 256, 256, [&](int n0) { return WSP(bf16, W_GATE) + (size_t)(256 * (2 * h + (n0 >> 7)) + (n0 & 127)) * 256; }, scr, gw, NGW, lane, rot);
            tr_matrix(a.od_w_igate + (size_t)h * 65536, 256, 256, 256, [&](int n0) { return WSP(bf16, W_GATE) + (size_t)(256 * (2 * h + (n0 >> 7)) + 128 + (n0 & 127)) * 256; }, scr, gw, NGW, lane, rot);
        }
        tr_matrix(a.od_w_out, 1024, 1024, 1024, [&](int n0) { return WSP(bf16, W_ODOUT) + (size_t)n0 * 1024; }, scr, gw, NGW, lane, rot);
        for (int l = 0; l < 2; ++l) {
            tr_matrix(a.xa_w_q + (size_t)l * 1048576, 1024, 1024, 1024, [&](int n0) { return WSP(bf16, W_XAQ + l * 2 * MiB) + (size_t)n0 * 1024; }, scr, gw, NGW, lane, rot, a.xa_norm_x + l * D);
            tr_matrix(a.xa_w_kv + (size_t)l * 2097152, 1024, 2048, 1024, [&](int n0) { return WSP(bf16, W_XAKV + l * 4 * MiB) + (size_t)n0 * 1024; }, scr, gw, NGW, lane, rot);
            tr_matrix(a.xa_w_o + (size_t)l * 1048576, 1024, 1024, 1024, [&](int n0) { return WSP(bf16, W_XAO + l * 2 * MiB) + (size_t)n0 * 1024; }, scr, gw, NGW, lane, rot);
            tr_matrix(a.ffn_w_gate_up + (size_t)l * 1024 * 5632, 1024, 5632, 1024, [&](int n0) { const int isu = n0 >= DFF, nn = isu ? n0 - DFF : n0; return WSP(bf16, W_FFN1 + l * 11 * MiB) + (size_t)(256 * (nn >> 7) + 128 * isu + (nn & 127)) * 1024; }, scr, gw, NGW, lane, rot, a.ffn_norm + l * D);
            tr_matrix(a.ffn_w_down + (size_t)l * DFF * 1024, DFF, 1024, DFF, [&](int n0) { return WSP(bf16, W_FFN2) + (size_t)l * (1024 * DFF) + (size_t)n0 * DFF; }, scr, gw, NGW, lane, rot);
        }
        const int gt = vcu * NTHREADS + tid, NGT = G * NTHREADS;
        for (int i = gt; i < 512 * 256; i += NGT) { const int n = i >> 8, kk = i & 255, g = n >> 7; float v = 0.f; if ((kk >> 7) == (g & 1)) v = a.ev_pool_w[(size_t)g * 16384 + (size_t)(kk & 127) * 128 + (n & 127)];
            WSP(bf16, W_POOL)[i] = (bf16)(pk2(v, 0.f) & 0xffffu); }
        for (int i = gt; i < M * 16; i += NGT) { const int row = i >> 4, j = i & 15; const int f = j & 3, e = j >> 2;
            const float fa = f == 0 ? 1.0f : (f == 1 ? 0.5623413251903491f : (f == 2 ? 0.31622776601683794f : 0.1778279410038923f));
            const float fb = e == 0 ? 1.0f : (e == 1 ? 0.1f : (e == 2 ? 0.01f : 0.001f));
            const float inv_freq = fa * fb; const float ang = (float)a.pos[row] * inv_freq;
            const double t = (double)ang * 0.15915494309189535; const float fr = (float)(t - __builtin_floor(t));
            WSP(float, WS_COS)[i] = __builtin_amdgcn_cosf(fr); WSP(float, WS_SIN)[i] = __builtin_amdgcn_sinf(fr); }
        for (int i = gt; i < 6 * M; i += NGT) WSP(float, WS_SSQ)[i] = 0.f;
        for (int i = gt; i < 1024; i += NGT) { const float l = a.od_lambda[i]; const float y = ex2(-l * LOG2E);
            const float sp = (y < 0.03f) ? y * (1.0f - y * (0.5f - y * (1.0f / 3.0f - 0.25f * y))) : 0.6931471805599453f * __builtin_amdgcn_logf(1.0f + y);
            WSP(float, WS_SP8)[i] = 8.0f * sp; }
        for (int r = gw; r < 1024; r += NGW) { const int l = r >> 9, mr = r & 511; rms_row_bf16(a.mem + (size_t)mr * D, a.xa_norm_mem + l * D, WSP(bf16, WS_MN) + (size_t)r * D, lane); }
        norm_pass(a.x, a.ev_norm, XN, gw, NGW, lane);
    }
    PHASE_END

    PHASE_BEGIN
    {
        { Gemm g = pg8::mk(XN, WSP(bf16, W_EVIN), M, 1024, 1024); StaticOrder S; S.init(M, 1024, G, bx);
          Epi E{}; E.mode = pg8::E_EVIN; E.O = WSP(bf16, WS_U); E.O2 = WSP(bf16, WS_CQ); E.O3 = WSP(bf16, WS_CKV); E.O4 = WSP(bf16, WS_KR); E.cosT = cosT; E.sinT = sinT;
          pg8::gemm_phase(lds, g, S, E, fresh_tid(wave)); }
    }
    PHASE_END

    PHASE_BEGIN
    {
        const int NMEMWG = (G >= 64) ? 32 : 0;
        if (bx < NMEMWG) {
            const int l = bx >> 4, isv = (bx >> 3) & 1;
            if (!isv) { Gemm g = pg8::mk(WSP(bf16, WS_MN) + (size_t)l * 512 * D, WSP(bf16, W_XAKV + l * 4 * MiB), 512, 1024, 1024); StaticOrder S; S.init(512, 1024, G, bx & 7);
              Epi E{}; E.mode = pg8::E_PLAIN; E.O = WSP(bf16, WS_MK) + (size_t)l * 512 * D; E.ldc = 1024; E.scale = 1.f; pg8::gemm_phase(lds, g, S, E, fresh_tid(wave)); }
            else { Gemm g = pg8::mk(WSP(bf16, W_XAKV + l * 4 * MiB) + (size_t)1024 * 1024, WSP(bf16, WS_MN) + (size_t)l * 512 * D, 1024, 512, 1024); StaticOrder S; S.init(1024, 512, G, bx & 7);
              Epi E{}; E.mode = pg8::E_PLAIN; E.O = WSP(bf16, WS_MVT) + (size_t)l * 1024 * 512; E.ldc = 512; E.scale = 1.f; pg8::gemm_phase(lds, g, S, E, fresh_tid(wave)); }
        } else {
        const int gw = (bx - NMEMWG) * NWAVES + wave, NGW = (G - NMEMWG) * NWAVES;
        const bf16* U = WSP(bf16, WS_U); const bf16* CQ = WSP(bf16, WS_CQ); const bf16* CKV = WSP(bf16, WS_CKV);
        bf16* PO = WSP(bf16, WS_POOLED); bf16* CQN = WSP(bf16, WS_CQN); bf16* CKVN = WSP(bf16, WS_CKVN);
        const int w = 2 << (lane >> 4);
        const f32x4 gq = *(const f32x4*)(a.ev_q_norm + 4 * lane); const f32x2 gk = *(const f32x2*)(a.ev_kv_norm + 2 * lane);
        for (int row = gw; row < M; row += NGW) {
            const int s = row & (SEQ - 1); const int cnt = (s + 1 < w) ? s + 1 : w;
            float sum[8]; float self[8];
            { const u32x4 v = *(const u32x4*)(U + (size_t)row * 512 + 8 * lane);
              self[0] = bflo(v.x); self[1] = bfhi(v.x); self[2] = bflo(v.y); self[3] = bfhi(v.y); self[4] = bflo(v.z); self[5] = bfhi(v.z); self[6] = bflo(v.w); self[7] = bfhi(v.w);
#pragma unroll
              for (int e = 0; e < 8; ++e) sum[e] = self[e]; }
            for (int tt = 1; tt < cnt; ++tt) { const u32x4 v = *(const u32x4*)(U + (size_t)(row - tt) * 512 + 8 * lane);
                sum[0] += bflo(v.x); sum[1] += bfhi(v.x); sum[2] += bflo(v.y); sum[3] += bfhi(v.y); sum[4] += bflo(v.z); sum[5] += bfhi(v.z); sum[6] += bflo(v.w); sum[7] += bfhi(v.w); }
            const float ic = 1.0f / (float)cnt;
            u32x4 o; o.x = pk2(sum[0] * ic - self[0], sum[1] * ic - self[1]); o.y = pk2(sum[2] * ic - self[2], sum[3] * ic - self[3]);
            o.z = pk2(sum[4] * ic - self[4], sum[5] * ic - self[5]); o.w = pk2(sum[6] * ic - self[6], sum[7] * ic - self[7]);
            *(u32x4*)(PO + (size_t)row * 512 + 8 * lane) = o;
            { const u32x2 v = *(const u32x2*)(CQ + (size_t)row * 256 + 4 * lane); const float x0 = bflo(v.x), x1 = bfhi(v.x), x2 = bflo(v.y), x3 = bfhi(v.y);
              const float rstd = rsqrtf(wave_sum((x0 * x0 + x1 * x1) + (x2 * x2 + x3 * x3)) * (1.f / 256.f) + RMS_EPS);
              u32x2 q; q.x = pk2(x0 * rstd * gq[0], x1 * rstd * gq[1]); q.y = pk2(x2 * rstd * gq[2], x3 * rstd * gq[3]); *(u32x2*)(CQN + (size_t)row * 256 + 4 * lane) = q; }
            { const unsigned v = *(const unsigned*)(CKV + (size_t)row * 128 + 2 * lane); const float x0 = bflo(v), x1 = bfhi(v);
              const float rstd = rsqrtf(wave_sum(x0 * x0 + x1 * x1) * (1.f / 128.f) + RMS_EPS);
              *(unsigned*)(CKVN + (size_t)row * 128 + 2 * lane) = pk2(x0 * rstd * gk[0], x1 * rstd * gk[1]); }
        }
        }
    }
    PHASE_END

    PHASE_BEGIN
    {
        { Gemm g = pg8::mk(WSP(bf16, WS_CQN), WSP(bf16, W_QUP), M, 768, 256); StaticOrder S; S.init(M, 768, G, bx);
          Epi E{}; E.mode = pg8::E_QROPE; E.O = WSP(bf16, WS_Q); E.scale = 0.10206207261596577f * LOG2E; E.cosT = cosT; E.sinT = sinT; pg8::gemm_phase(lds, g, S, E, fresh_tid(wave)); }
        { Gemm g = pg8::mk(WSP(bf16, WS_CKVN), WSP(bf16, W_KN), M, 512, 128); StaticOrder S; S.init(M, 512, G, bx);
          Epi E{}; E.mode = pg8::E_PLAIN; E.O = WSP(bf16, WS_KN); E.ldc = 512; E.scale = 1.f; pg8::gemm_phase(lds, g, S, E, fresh_tid(wave)); }
        { Gemm g = pg8::mk(WSP(bf16, W_V), WSP(bf16, WS_CKVN), 512, M, 128); StaticOrder S; S.init(512, M, G, bx);
          Epi E{}; E.mode = pg8::E_VT; E.O = WSP(bf16, WS_VT); E.ldc = M; pg8::gemm_phase(lds, g, S, E, fresh_tid(wave)); }
        { Gemm g = pg8::mk(WSP(bf16, WS_POOLED), WSP(bf16, W_POOL), M, 512, 256); g.lda = 512; g.a_pm_off = 256L * 512; g.a_pn_off = 256; StaticOrder S; S.init(M, 512, G, bx);
          Epi E{}; E.mode = pg8::E_POOL; E.O = MIX; E.ldc = 1024; E.vec0 = a.ev_pool_scale; pg8::gemm_phase(lds, g, S, E, fresh_tid(wave)); }
    }
    PHASE_END

    PHASE_BEGIN
    {
        for (int vw = vcu; vw < 256; vw += G) { const int bh = vw >> 4, s = vw & 15;
#pragma unroll 1
            for (int i = 0; i < 4; ++i) { const int qb = (i == 0) ? 63 - s : (i == 1) ? s : (i == 2) ? 32 + s : 31 - s;
                size_t z0 = 0; asm volatile("" : "+s"(z0)); unsigned char* w2 = ws + z0;
                att::attn_unit(bh >> 3, bh & 7, qb, (const bf16*)(w2 + WS_Q), (const bf16*)(w2 + WS_KN), (const bf16*)(w2 + WS_KR), (const bf16*)(w2 + WS_VT), (bf16*)(w2 + WS_MIX) + 512, lds, fresh_tid(wave)); } }
    }
    PHASE_END

    PHASE_BEGIN
    { Gemm g = pg8::mk(MIX, WSP(bf16, W_EVOUT), M, 1024, 1024); StaticOrder S; S.init(M, 1024, G, bx);
      Epi E{}; E.mode = pg8::E_RES; E.base = a.x; E.out = outp; E.O = XN; E.aout = WSP(float, WS_SSQ); pg8::gemm_phase(lds, g, S, E, fresh_tid(wave)); }
    PHASE_END

#pragma unroll 1
    for (int l = 0; l < 2; ++l) {
        if (l == 1) {
            PHASE_BEGIN
            { Gemm g = pg8::mk(XN, WSP(bf16, W_ODIN), M, 2048, 1024); StaticOrder S; S.init(M, 2048, G, bx);
              Epi E{}; E.mode = pg8::E_ODIN; E.O = WSP(bf16, WS_GB); E.O2 = WSP(bf16, WS_XBP); E.vec0 = WSP(float, WS_SSQ) + 2 * (size_t)M; pg8::gemm_phase(lds, g, S, E, fresh_tid(wave)); }
            PHASE_END
            PHASE_BEGIN
            {
                const bf16* XBP = WSP(bf16, WS_XBP); bf16* XB = XN;
                const int half = gw & 1; const int c0 = half * 512 + 8 * lane;
                float wv[4][8], bias[8];
#pragma unroll
                for (int j = 0; j < 4; ++j)
#pragma unroll
                    for (int e = 0; e < 8; ++e) wv[j][e] = a.od_conv_w[j * 1024 + c0 + e];
#pragma unroll
                for (int e = 0; e < 8; ++e) bias[e] = a.od_conv_b[c0 + e];
                for (int row = gw >> 1; row < M; row += NGW >> 1) { const int s = row & (SEQ - 1); float acc[8];
#pragma unroll
                    for (int e = 0; e < 8; ++e) acc[e] = bias[e];
#pragma unroll
                    for (int j = 0; j < 4; ++j) { if (s - 3 + j >= 0) { const u32x4 v = *(const u32x4*)(XBP + (size_t)(row - 3 + j) * D + c0);
                        acc[0] += wv[j][0] * bflo(v.x); acc[1] += wv[j][1] * bfhi(v.x); acc[2] += wv[j][2] * bflo(v.y); acc[3] += wv[j][3] * bfhi(v.y);
                        acc[4] += wv[j][4] * bflo(v.z); acc[5] += wv[j][5] * bfhi(v.z); acc[6] += wv[j][6] * bflo(v.w); acc[7] += wv[j][7] * bfhi(v.w); } }
                    u32x4 o; o.x = pk2(acc[0], acc[1]); o.y = pk2(acc[2], acc[3]); o.z = pk2(acc[4], acc[5]); o.w = pk2(acc[6], acc[7]);
                    *(u32x4*)(XB + (size_t)row * D + c0) = o; }
            }
            PHASE_END
            PHASE_BEGIN
            { Gemm g = pg8::mk(XN, WSP(bf16, W_GATE), M, 2048, 256); g.lda = 1024; g.a_pm_off = 256L * 1024; g.a_pn_off = 256; g.a_pn_shift = 1; StaticOrder S; S.init(M, 2048, G, bx);
              Epi E{}; E.mode = pg8::E_GATE; E.O = WSP(bf16, WS_B); E.aout = WSP(float, WS_A); E.vec0 = a.od_b_rgate; E.vec1 = a.od_b_igate; E.vec2 = WSP(float, WS_SP8); E.pos = a.pos; E.xb = XN;
              pg8::gemm_phase(lds, g, S, E, fresh_tid(wave)); }
            PHASE_END
            PHASE_BEGIN
            {
                const float* A_ = WSP(float, WS_A); const bf16* B_ = WSP(bf16, WS_B);
                for (int it = vcu; it < 256; it += G) { const size_t r0 = (size_t)it * 128; const int c = 2 * tid;
                    float A0 = 1.f, A1 = 1.f, B0 = 0.f, B1 = 0.f;
#pragma unroll 8
                    for (int t = 0; t < 128; ++t) { const f32x2 av = *(const f32x2*)(A_ + (r0 + t) * D + c); const unsigned bw = *(const unsigned*)(B_ + (r0 + t) * D + c);
                        B0 = av[0] * B0 + bflo(bw); B1 = av[1] * B1 + bfhi(bw); A0 *= av[0]; A1 *= av[1]; }
                    *(f32x2*)(WSP(float, WS_CA) + (size_t)it * D + c) = (f32x2){A0, A1}; *(f32x2*)(WSP(float, WS_CB) + (size_t)it * D + c) = (f32x2){B0, B1}; }
            }
            PHASE_END
            PHASE_BEGIN
            {
                const float* A_ = WSP(float, WS_A); const bf16* B_ = WSP(bf16, WS_B); const bf16* GB = WSP(bf16, WS_GB);
                for (int it = vcu; it < 256; it += G) { const size_t r0 = (size_t)it * 128; const int c = 2 * tid; const int j = it & 127, it0 = it - j;
                    float h0 = 0.f, h1 = 0.f;
#pragma unroll 8
                    for (int jj = 0; jj < j; ++jj) { const f32x2 ca = *(const f32x2*)(WSP(float, WS_CA) + (size_t)(it0 + jj) * D + c), cb = *(const f32x2*)(WSP(float, WS_CB) + (size_t)(it0 + jj) * D + c);
                        h0 = ca[0] * h0 + cb[0]; h1 = ca[1] * h1 + cb[1]; }
#pragma unroll 8
                    for (int t = 0; t < 128; ++t) { const f32x2 av = *(const f32x2*)(A_ + (r0 + t) * D + c); const unsigned bw = *(const unsigned*)(B_ + (r0 + t) * D + c); const unsigned gv = *(const unsigned*)(GB + (r0 + t) * D + c);
                        h0 = av[0] * h0 + bflo(bw); h1 = av[1] * h1 + bfhi(bw);
                        *(unsigned*)(MIX + (r0 + t) * D + c) = pk2(bflo(gv) * h0, bfhi(gv) * h1); }
                }
            }
            PHASE_END
            PHASE_BEGIN
            { Gemm g = pg8::mk(MIX, WSP(bf16, W_ODOUT), M, 1024, 1024); StaticOrder S; S.init(M, 1024, G, bx);
              Epi E{}; E.mode = pg8::E_RES; E.base = outp; E.out = outp; E.O = XN; E.aout = WSP(float, WS_SSQ) + 3 * (size_t)M; pg8::gemm_phase(lds, g, S, E, fresh_tid(wave)); }
            PHASE_END
        }
        PHASE_BEGIN
        { Gemm g = pg8::mk(XN, WSP(bf16, W_XAQ + l * 2 * MiB), M, 1024, 1024); StaticOrder S; S.init(M, 1024, G, bx);
          Epi E{}; E.mode = pg8::E_PLAIN; E.O = WSP(bf16, WS_XQ); E.ldc = 1024; E.scale = 0.0625f * LOG2E; E.vec0 = WSP(float, WS_SSQ) + (size_t)(3 * l) * M; pg8::gemm_phase(lds, g, S, E, fresh_tid(wave)); }
        PHASE_END
        PHASE_BEGIN
        { Gemm g = pg8::mk(WSP(bf16, WS_XQ), WSP(bf16, WS_MK) + (size_t)l * 512 * D, M, 1024, 256); g.lda = 1024; g.a_pm_off = 256L * 1024; g.a_pn_off = 256;
          g.ldb = 1024; g.b_pn_off = 256; g.b_pm_div = 64; g.b_pm_off = 256L * 1024; StaticOrder S; S.init(M, 1024, G, bx);
          Epi E{}; E.mode = pg8::E_SOFTMAX; E.O = WSP(bf16, WS_P); E.ldc = 1024; pg8::gemm_phase(lds, g, S, E, fresh_tid(wave)); }
        PHASE_END
        PHASE_BEGIN
        { Gemm g = pg8::mk(WSP(bf16, WS_P), WSP(bf16, WS_MVT) + (size_t)l * 1024 * 512, M, 1024, 256); g.lda = 1024; g.a_pm_off = 256L * 1024; g.a_pn_off = 256;
          g.ldb = 512; g.b_pn_off = 256L * 512; g.b_pm_div = 64; g.b_pm_off = 256; StaticOrder S; S.init(M, 1024, G, bx);
          Epi E{}; E.mode = pg8::E_PLAIN; E.O = MIX; E.ldc = 1024; E.scale = 1.f; pg8::gemm_phase(lds, g, S, E, fresh_tid(wave)); }
        PHASE_END
        PHASE_BEGIN
        { Gemm g = pg8::mk(MIX, WSP(bf16, W_XAO + l * 2 * MiB), M, 1024, 1024); StaticOrder S; S.init(M, 1024, G, bx);
          Epi E{}; E.mode = pg8::E_RES; E.base = outp; E.out = outp; E.O = XN; E.aout = WSP(float, WS_SSQ) + (size_t)(3 * l + 1) * M; pg8::gemm_phase(lds, g, S, E, fresh_tid(wave)); }
        PHASE_END
        PHASE_BEGIN
        { Gemm g = pg8::mk(XN, WSP(bf16, W_FFN1 + l * 11 * MiB), M, 2 * DFF, 1024); StaticOrder S; S.init(M, 2 * DFF, G, bx);
          Epi E{}; E.mode = pg8::E_SWIGLU; E.O = WSP(bf16, WS_H); E.vec0 = WSP(float, WS_SSQ) + (size_t)(3 * l + 1) * M; pg8::gemm_phase(lds, g, S, E, fresh_tid(wave)); }
        PHASE_END
        PHASE_BEGIN
        { Gemm g = pg8::mk(WSP(bf16, WS_H), WSP(bf16, W_FFN2) + (size_t)l * (1024 * DFF), M, 1024, DFF); StaticOrder S; S.init(M, 1024, G, bx);
          Epi E{}; E.mode = pg8::E_RES; E.base = outp; E.out = outp; E.O = (l == 0) ? XN : nullptr; E.aout = WSP(float, WS_SSQ) + (size_t)(l == 0 ? 2 : 5) * M; pg8::gemm_phase(lds, g, S, E, fresh_tid(wave)); }
        PHASE_END
    }

    PHASE_BEGIN
    {
        const f32x4* gr = (const f32x4*)a.final_norm + lane; const float* ssq = WSP(float, WS_SSQ) + 5 * (size_t)M;
        for (int m = gw; m < M; m += NGW) { f32x4* xr = (f32x4*)(outp + (size_t)m * D) + lane; const float rstd = rsqrtf(ssq[m] * (1.f / D) + RMS_EPS);
#pragma unroll
            for (int j = 0; j < 4; ++j) xr[64 * j] = xr[64 * j] * rstd * gr[64 * j]; }
    }
    PHASE_END
    }
}
#undef a
constexpr int N_PHASES = 6 + 6 + 12 + 1;

#ifndef MK_N_LAUNCHES
#define MK_N_LAUNCHES 1
#endif
extern "C" void kernel_launch(void* const* d_in, const int* in_sizes, int n_in, void* d_out, int out_size, void* d_ws, size_t ws_size, hipStream_t stream) {
    static int grid = 0;
    if (grid == 0) {
        if (n_in != 31 || ws_size < WS_NEED) { fprintf(stderr, "kernel_launch: unexpected n_in %d or ws_size %zu\n", n_in, ws_size); grid = -1; return; }
        int dev = 0, cus = 0, per_cu = 0;
        hipGetDevice(&dev); hipDeviceGetAttribute(&cus, hipDeviceAttributeMultiprocessorCount, dev);
        if (hipFuncSetAttribute((const void*)hybrid_fwd, hipFuncAttributeMaxDynamicSharedMemorySize, LDS_BYTES) != hipSuccess) { fprintf(stderr, "kernel_launch: hipFuncSetAttribute failed\n"); grid = -1; return; }
        hipOccupancyMaxActiveBlocksPerMultiprocessor(&per_cu, (const void*)hybrid_fwd, NTHREADS, LDS_BYTES);
        (void)hipGetLastError();
        if (per_cu < 1) per_cu = 1;
        grid = cus * 1;
        if (grid > 256) grid = 256;
    }
    if (grid < 0) return;
    Args a{};
    const float* const* f = (const float* const*)d_in;
    a.x = f[0]; a.mem = f[1]; a.pos = (const int*)d_in[2];
    a.ev_norm = f[3]; a.ev_w_in = f[4]; a.ev_pool_w = f[5]; a.ev_pool_scale = f[6]; a.ev_q_norm = f[7]; a.ev_w_q_up = f[8]; a.ev_kv_norm = f[9]; a.ev_w_kv_up = f[10]; a.ev_w_out = f[11];
    a.od_norm = f[12]; a.od_w_in = f[13]; a.od_conv_w = f[14]; a.od_conv_b = f[15]; a.od_w_rgate = f[16]; a.od_b_rgate = f[17]; a.od_w_igate = f[18]; a.od_b_igate = f[19]; a.od_lambda = f[20]; a.od_w_out = f[21];
    a.xa_norm_x = f[22]; a.xa_norm_mem = f[23]; a.xa_w_q = f[24]; a.xa_w_kv = f[25]; a.xa_w_o = f[26]; a.ffn_norm = f[27]; a.ffn_w_gate_up = f[28]; a.ffn_w_down = f[29]; a.final_norm = f[30];
    a.out = (float*)d_out; a.ws = (unsigned char*)d_ws;
#if MK_N_LAUNCHES == 1
    if (hipMemsetAsync((unsigned char*)d_ws + WS_BAR, 0, 16384, stream) != hipSuccess) { fprintf(stderr, "kernel_launch: memset failed\n"); return; }
    a.ph_lo = 0; a.ph_hi = N_PHASES;
    void* args[] = {&a};
    hipError_t e = hipLaunchCooperativeKernel((const void*)hybrid_fwd, dim3(grid), dim3(NTHREADS), args, LDS_BYTES, stream);
    if (e != hipSuccess) fprintf(stderr, "kernel_launch: cooperative launch failed: %s (grid %d)\n", hipGetErrorString(e), grid);
#else
    for (int p = 0; p < N_PHASES; ++p) { a.ph_lo = p; a.ph_hi = p + 1; hipLaunchKernelGGL(hybrid_fwd, dim3(grid), dim3(NTHREADS), LDS_BYTES, stream, a); }
#endif
}
```

```cpp
#include <hip/hip_runtime.h>
#include <hip/hip_cooperative_groups.h>
#include <cstdio>
#include <cstdint>
namespace cg = cooperative_groups;

#define LAS __attribute__((address_space(3)))
typedef unsigned short bf16;
typedef short bf16x8 __attribute__((ext_vector_type(8)));
typedef short s16x4 __attribute__((ext_vector_type(4)));
typedef float f32x4 __attribute__((ext_vector_type(4)));
typedef float f32x2 __attribute__((ext_vector_type(2)));
typedef float f32x16 __attribute__((ext_vector_type(16)));
typedef unsigned u32x4 __attribute__((ext_vector_type(4)));
typedef unsigned u32x2 __attribute__((ext_vector_type(2)));

constexpr int SEQ = 16384, BATCH = 2, M = BATCH * SEQ, D = 1024;
constexpr int DFF = 2816;
constexpr float RMS_EPS = 1e-6f;
constexpr float LOG2E = 1.4426950408889634f;
constexpr int NTHREADS = 512, NWAVES = 8;
constexpr int RING_BYTES = 131072, LDS_BYTES = 147456, EPI_OFF = RING_BYTES;

typedef __bf16 bf16x2_t __attribute__((ext_vector_type(2)));
__device__ __forceinline__ unsigned pk2(float lo, float hi) { f32x2 v = {lo, hi}; bf16x2_t b = __builtin_convertvector(v, bf16x2_t); return __builtin_bit_cast(unsigned, b); }
__device__ __forceinline__ float bflo(unsigned w) { return __uint_as_float(w << 16); }
__device__ __forceinline__ float bfhi(unsigned w) { return __uint_as_float(w & 0xffff0000u); }
__device__ __forceinline__ float ex2(float x) { return __builtin_amdgcn_exp2f(x); }
__device__ __forceinline__ float rcp(float x) { return __builtin_amdgcn_rcpf(x); }
__device__ __forceinline__ float sigmoidf_(float x) { return rcp(1.0f + ex2(-x * LOG2E)); }
__device__ __forceinline__ float gelu_tanh(float x) { const float u = 0.7978845608028654f * (x + 0.044715f * x * x * x); return x * sigmoidf_(2.0f * u); }
__device__ __forceinline__ float wave_sum(float v) {
#pragma unroll
    for (int o = 1; o < 64; o <<= 1) v += __shfl_xor(v, o);
    return v;
}
#define LDS_WAIT() asm volatile("s_waitcnt lgkmcnt(0)" ::: "memory")

namespace pg8 {
constexpr int BM = 256, BK = 64, HALF = 128, HTB = HALF * BK * 2, NXCD = 8, WGM = 4;
__host__ __device__ __forceinline__ int lds_byte(int r, int c) { const int st = (r >> 4) * 2 + (c >> 5), rr = r & 15, cc = c & 31, ob = rr * 64 + cc * 2; return st * 1024 + (ob ^ (((ob >> 9) & 1) << 5)); }
__host__ __device__ __forceinline__ void stage_rc(int b, int& R, int& C) { const int st = b / 1024, sb = b % 1024, swz = sb ^ (((sb >> 9) & 1) << 5); R = (st >> 1) * 16 + swz / 64; C = (st & 1) * 32 + (swz % 64) / 2; }
struct Unit { int pm, pn; };
struct Gemm { const bf16* A; const bf16* Bt; int Mr, N, K, lda, ldb; long a_pm_off, a_pn_off; int a_pn_shift; long b_pn_off; int b_pm_div; long b_pm_off; };
__device__ __forceinline__ Gemm mk(const bf16* A, const bf16* Bt, int Mr, int N, int K) {
    Gemm g; g.A = A; g.Bt = Bt; g.Mr = Mr; g.N = N; g.K = K; g.lda = K; g.ldb = K; g.a_pm_off = 256L * K; g.a_pn_off = 0; g.a_pn_shift = 0; g.b_pn_off = 256L * K; g.b_pm_div = 1 << 30; g.b_pm_off = 0; return g; }
struct StaticOrder {
    int nM, nN, nwg, G, c;
    __device__ void init(int Mr, int N, int G_, int c_) { nM = Mr / BM; nN = N / BM; nwg = nM * nN; G = G_; c = c_; }
    __device__ bool next(int i, Unit& u) const {
        const long L = (long)i * G + c; if (L >= nwg) return false;
        int wgid = (int)L; { const int q = nwg / NXCD, r = nwg % NXCD, xcd = wgid % NXCD, off = wgid / NXCD; wgid = (xcd < r ? xcd * (q + 1) : r * (q + 1) + (xcd - r) * q) + off; }
        const int nig = WGM * nN, gid = wgid / nig, fm = gid * WGM, gsz = (nM - fm) < WGM ? (nM - fm) : WGM;
        u.pm = fm + ((wgid % nig) % gsz); u.pn = (wgid % nig) / gsz; return true;
    }
};

enum { E_PLAIN = 0, E_EVIN, E_QROPE, E_POOL, E_RES, E_SOFTMAX, E_SWIGLU, E_ODIN, E_GATE, E_VT };
struct Epi {
    int mode;
    bf16* O; int ldc; float scale;
    bf16 *O2, *O3, *O4;
    const float* base; float* out;
    const float *cosT, *sinT;
    const float *vec0, *vec1, *vec2;
    const int* pos;
    const bf16* xb; float* aout;
};
__device__ __forceinline__ void st8(bf16* p, f32x4 v0, f32x4 v1) { u32x4 w; w.x = pk2(v0[0], v0[1]); w.y = pk2(v0[2], v0[3]); w.z = pk2(v1[0], v1[1]); w.w = pk2(v1[2], v1[3]); *(u32x4*)p = w; }
__device__ __forceinline__ void st4(bf16* p, f32x4 v) { u32x2 w; w.x = pk2(v[0], v[1]); w.y = pk2(v[2], v[3]); *(u32x2*)p = w; }

__device__ __forceinline__ void run_epi(const Epi& E, f32x4 (&acc)[2][2][4][2], const Unit& u, int wr, int wc, int fr, int fq, LAS unsigned char* lds) {
    const int rowb = u.pm * BM + wr * 64 + fr, colb = u.pn * BM + wc * 32 + 4 * fq;
    const int colp = u.pn * BM + wc * 32 + 8 * fq;
    switch (E.mode) {
    case E_PLAIN: {
#pragma unroll
        for (int ai = 0; ai < 2; ++ai)
#pragma unroll
            for (int m = 0; m < 4; ++m) { const size_t row = (size_t)(rowb + ai * HALF + m * 16); bf16* rp = E.O + row * E.ldc + colp;
                float sc = E.scale; if (E.vec0) sc *= rsqrtf(E.vec0[row] * (1.f / D) + RMS_EPS);
#pragma unroll
                for (int bj = 0; bj < 2; ++bj) st8(rp + bj * HALF, acc[ai][bj][m][0] * sc, acc[ai][bj][m][1] * sc); }
    } break;
    case E_EVIN: {
        const int pn = u.pn;
#pragma unroll
        for (int ai = 0; ai < 2; ++ai)
#pragma unroll
            for (int m = 0; m < 4; ++m) { const size_t row = (size_t)(rowb + ai * HALF + m * 16);
                if (pn < 2) { bf16* rp = E.O + row * 512 + colb;
#pragma unroll
                    for (int bj = 0; bj < 2; ++bj)
#pragma unroll
                        for (int n = 0; n < 2; ++n) st4(rp + bj * HALF + n * 16, acc[ai][bj][m][n]);
                } else if (pn == 2) { bf16* rp = E.O2 + row * 256 + (colb - 512);
#pragma unroll
                    for (int bj = 0; bj < 2; ++bj)
#pragma unroll
                        for (int n = 0; n < 2; ++n) st4(rp + bj * HALF + n * 16, acc[ai][bj][m][n]);
                } else { bf16* rp = E.O3 + row * 128 + (colb - 768);
#pragma unroll
                    for (int n = 0; n < 2; ++n) st4(rp + n * 16, acc[ai][0][m][n]);
                    if (wc == 0) { const f32x4 c = *(const f32x4*)(E.cosT + row * 16 + 4 * fq), s = *(const f32x4*)(E.sinT + row * 16 + 4 * fq);
                        const f32x4 v0 = acc[ai][1][m][0], v1 = acc[ai][1][m][1];
                        st4(E.O4 + row * 32 + 4 * fq, v0 * c - v1 * s); st4(E.O4 + row * 32 + 16 + 4 * fq, v1 * c + v0 * s); }
                } }
    } break;
    case E_QROPE: {
#pragma unroll
        for (int bj = 0; bj < 2; ++bj) { const int cb = u.pn * BM + bj * HALF + wc * 32; const bool rope = (cb % 96) == 64;
#pragma unroll
            for (int ai = 0; ai < 2; ++ai)
#pragma unroll
                for (int m = 0; m < 4; ++m) { const size_t row = (size_t)(rowb + ai * HALF + m * 16); bf16* rp = E.O + row * 768 + cb + 4 * fq;
                    f32x4 v0 = acc[ai][bj][m][0] * E.scale, v1 = acc[ai][bj][m][1] * E.scale;
                    if (rope) { const f32x4 c = *(const f32x4*)(E.cosT + row * 16 + 4 * fq), s = *(const f32x4*)(E.sinT + row * 16 + 4 * fq);
                        const f32x4 o0 = v0 * c - v1 * s, o1 = v1 * c + v0 * s; v0 = o0; v1 = o1; }
                    st4(rp, v0); st4(rp + 16, v1); } }
    } break;
    case E_POOL: {
#pragma unroll
        for (int bj = 0; bj < 2; ++bj) { const int col = colp + bj * HALF; const f32x4 s0 = *(const f32x4*)(E.vec0 + col), s1 = *(const f32x4*)(E.vec0 + col + 4);
#pragma unroll
            for (int ai = 0; ai < 2; ++ai)
#pragma unroll
                for (int m = 0; m < 4; ++m) st8(E.O + (size_t)(rowb + ai * HALF + m * 16) * E.ldc + col, acc[ai][bj][m][0] * s0, acc[ai][bj][m][1] * s1); }
    } break;
    case E_RES: {
#pragma unroll
        for (int ai = 0; ai < 2; ++ai) {
            f32x4 bs[4][2][2];
#pragma unroll
            for (int m = 0; m < 4; ++m) { const size_t off = (size_t)(rowb + ai * HALF + m * 16) * D + colp;
#pragma unroll
                for (int bj = 0; bj < 2; ++bj)
#pragma unroll
                    for (int n = 0; n < 2; ++n) bs[m][bj][n] = *(const f32x4*)(E.base + off + bj * HALF + n * 4); }
#pragma unroll
            for (int m = 0; m < 4; ++m) { const size_t row = (size_t)(rowb + ai * HALF + m * 16); const size_t off = row * D + colp; float q = 0.f;
#pragma unroll
                for (int bj = 0; bj < 2; ++bj) { const f32x4 o0 = bs[m][bj][0] + acc[ai][bj][m][0], o1 = bs[m][bj][1] + acc[ai][bj][m][1];
                    *(f32x4*)(E.out + off + bj * HALF) = o0; *(f32x4*)(E.out + off + bj * HALF + 4) = o1;
                    if (E.O) st8(E.O + off + bj * HALF, o0, o1);
                    q += (o0[0] * o0[0] + o0[1] * o0[1]) + (o0[2] * o0[2] + o0[3] * o0[3]) + (o1[0] * o1[0] + o1[1] * o1[1]) + (o1[2] * o1[2] + o1[3] * o1[3]); }
                q += __shfl_xor(q, 16); q += __shfl_xor(q, 32);
                if (fq == 0) atomicAdd(E.aout + row, q); }
            asm volatile("" ::: "memory"); }
    } break;
    case E_SOFTMAX: {
        LAS float* RM = (LAS float*)(lds + EPI_OFF);
        LAS float* RS = (LAS float*)(lds + EPI_OFF + 4096);
#pragma unroll
        for (int ai = 0; ai < 2; ++ai)
#pragma unroll
            for (int m = 0; m < 4; ++m) { float mx = -3.0e38f;
#pragma unroll
                for (int bj = 0; bj < 2; ++bj)
#pragma unroll
                    for (int n = 0; n < 2; ++n) { const f32x4 x = acc[ai][bj][m][n]; mx = fmaxf(mx, fmaxf(fmaxf(x[0], x[1]), fmaxf(x[2], x[3]))); }
                mx = fmaxf(mx, __shfl_xor(mx, 16)); mx = fmaxf(mx, __shfl_xor(mx, 32));
                if (fq == 0) RM[(ai * HALF + wr * 64 + m * 16 + fr) * 4 + wc] = mx; }
        LDS_WAIT(); __builtin_amdgcn_s_barrier(); asm volatile("" ::: "memory");
#pragma unroll
        for (int ai = 0; ai < 2; ++ai)
#pragma unroll
            for (int m = 0; m < 4; ++m) { const int rl = ai * HALF + wr * 64 + m * 16 + fr; const f32x4 mm = *(LAS f32x4*)(RM + rl * 4);
                const float mx = fmaxf(fmaxf(mm[0], mm[1]), fmaxf(mm[2], mm[3])); float s = 0.f;
#pragma unroll
                for (int bj = 0; bj < 2; ++bj)
#pragma unroll
                    for (int n = 0; n < 2; ++n) { f32x4 x = acc[ai][bj][m][n]; x[0] = ex2(x[0] - mx); x[1] = ex2(x[1] - mx); x[2] = ex2(x[2] - mx); x[3] = ex2(x[3] - mx); acc[ai][bj][m][n] = x; s += (x[0] + x[1]) + (x[2] + x[3]); }
                s += __shfl_xor(s, 16); s += __shfl_xor(s, 32);
                if (fq == 0) RS[rl * 4 + wc] = s; }
        LDS_WAIT(); __builtin_amdgcn_s_barrier(); asm volatile("" ::: "memory");
#pragma unroll
        for (int ai = 0; ai < 2; ++ai)
#pragma unroll
            for (int m = 0; m < 4; ++m) { const int rl = ai * HALF + wr * 64 + m * 16 + fr; const f32x4 ss = *(LAS f32x4*)(RS + rl * 4);
                const float inv = rcp((ss[0] + ss[1]) + (ss[2] + ss[3])); bf16* rp = E.O + (size_t)(u.pm * BM + rl) * E.ldc + colp;
#pragma unroll
                for (int bj = 0; bj < 2; ++bj) st8(rp + bj * HALF, acc[ai][bj][m][0] * inv, acc[ai][bj][m][1] * inv); }
    } break;
    case E_SWIGLU: {
        const int colh = u.pn * HALF + wc * 32 + 8 * fq;
#pragma unroll
        for (int ai = 0; ai < 2; ++ai)
#pragma unroll
            for (int m = 0; m < 4; ++m) { const size_t row = (size_t)(rowb + ai * HALF + m * 16); const float rs = rsqrtf(E.vec0[row] * (1.f / D) + RMS_EPS); f32x4 o[2];
#pragma unroll
                for (int n = 0; n < 2; ++n) { const f32x4 g = acc[ai][0][m][n] * rs, uu = acc[ai][1][m][n] * rs;
#pragma unroll
                    for (int e = 0; e < 4; ++e) o[n][e] = g[e] * sigmoidf_(g[e]) * uu[e]; }
                st8(E.O + row * DFF + colh, o[0], o[1]); }
    } break;
    case E_ODIN: {
        const bool isg = u.pn < 4;
#pragma unroll
        for (int ai = 0; ai < 2; ++ai)
#pragma unroll
            for (int m = 0; m < 4; ++m) { const size_t row = (size_t)(rowb + ai * HALF + m * 16); const float rs = rsqrtf(E.vec0[row] * (1.f / D) + RMS_EPS);
                bf16* rp = (isg ? E.O + row * D + colp : E.O2 + row * D + (colp - D));
#pragma unroll
                for (int bj = 0; bj < 2; ++bj) { f32x4 v0 = acc[ai][bj][m][0] * rs, v1 = acc[ai][bj][m][1] * rs;
                    if (isg) {
#pragma unroll
                        for (int e = 0; e < 4; ++e) { v0[e] = gelu_tanh(v0[e]); v1[e] = gelu_tanh(v1[e]); } }
                    st8(rp + bj * HALF, v0, v1); } }
    } break;
    case E_GATE: {
        const int c = (u.pn >> 1) * 256 + (u.pn & 1) * HALF + wc * 32 + 8 * fq;
        f32x4 br[2], bi[2], sp[2];
#pragma unroll
        for (int n = 0; n < 2; ++n) { br[n] = *(const f32x4*)(E.vec0 + c + 4 * n); bi[n] = *(const f32x4*)(E.vec1 + c + 4 * n); sp[n] = *(const f32x4*)(E.vec2 + c + 4 * n); }
#pragma unroll
        for (int ai = 0; ai < 2; ++ai)
#pragma unroll
            for (int m = 0; m < 4; ++m) { const size_t row = (size_t)(rowb + ai * HALF + m * 16); const bool rst = E.pos[row] == 0;
                const u32x4 xw = *(const u32x4*)(E.xb + row * D + c); const float xv[8] = {bflo(xw.x), bfhi(xw.x), bflo(xw.y), bfhi(xw.y), bflo(xw.z), bfhi(xw.z), bflo(xw.w), bfhi(xw.w)};
                f32x4 av[2], bv[2];
#pragma unroll
                for (int n = 0; n < 2; ++n) { const f32x4 pr = acc[ai][0][m][n] + br[n], pi = acc[ai][1][m][n] + bi[n];
#pragma unroll
                    for (int e = 0; e < 4; ++e) { const float r = sigmoidf_(pr[e]), ig = sigmoidf_(pi[e]); const float la = -sp[n][e] * r; float a = ex2(la * LOG2E);
                        const float x2 = 2.0f * la; const float om = (x2 > -0.01f) ? -(x2 + x2 * x2 * (0.5f + x2 * (1.0f / 6.0f))) : 1.0f - ex2(x2 * LOG2E);
                        float mult = sqrtf(fmaxf(om, 0.f)); if (rst) { a = 0.f; mult = 1.f; }
                        av[n][e] = a; bv[n][e] = mult * (ig * xv[4 * n + e]); } }
                *(f32x4*)(E.aout + row * D + c) = av[0]; *(f32x4*)(E.aout + row * D + c + 4) = av[1]; st8(E.O + row * D + c, bv[0], bv[1]); }
    } break;
    case E_VT: {
#pragma unroll
        for (int ai = 0; ai < 2; ++ai)
#pragma unroll
            for (int m = 0; m < 4; ++m) { const size_t row = (size_t)(rowb + ai * HALF + m * 16);
#pragma unroll
                for (int bj = 0; bj < 2; ++bj) { const int col = colp + bj * HALF, b16 = col & ~15, hf = (col >> 3) & 1; bf16* rp = E.O + row * E.ldc + b16 + 4 * hf;
                    st4(rp, acc[ai][bj][m][0]); st4(rp + 8, acc[ai][bj][m][1]); } }
    } break;
    default: break;
    }
}

__device__ __forceinline__ void gemm_phase(LAS unsigned char* lds, const Gemm g, const StaticOrder& S, const Epi& E, const int tid) {
    const int wid = __builtin_amdgcn_readfirstlane(tid >> 6), lane = tid & 63, wr = wid >> 2, wc = wid & 3, fr = lane & 15, fq = lane >> 4;
    const int K = g.K, nt = K / BK;
    unsigned voffA, voffB;
    { int R, C; stage_rc(tid * 16, R, C); const bool perm = (E.mode != E_EVIN) && (E.mode != E_QROPE);
      const int rho = R & 31, Rb = perm ? ((R & ~31) + 8 * ((rho & 15) >> 2) + 4 * (rho >> 4) + (rho & 3)) : R;
      voffA = (unsigned)(R * g.lda + C) * 2u; voffB = (unsigned)(Rb * g.ldb + C) * 2u; }
    const size_t q64A = (size_t)64 * g.lda * 2, q64B = (size_t)64 * g.ldb * 2;
    const size_t kstep = (size_t)(BK * 2);
    const size_t hstepA = (size_t)HALF * g.lda * 2, hstepB = (size_t)HALF * g.ldb * 2;
    const unsigned ldsw = (unsigned)wid * 1024u;
    const int aoff = lds_byte(wr * 64 + fr, fq * 8), boff = lds_byte(wc * 32 + fr, fq * 8);
#define PG8_ABASE(u) ((const char*)g.A + ((size_t)(u).pm * g.a_pm_off + (size_t)((u).pn >> g.a_pn_shift) * g.a_pn_off) * 2)
#define PG8_BBASE(u) ((const char*)g.Bt + ((size_t)(u).pn * g.b_pn_off + (size_t)((u).pm / g.b_pm_div) * g.b_pm_off) * 2)
#define PG8_SA(b, h) (((b) * 2 + (h)) * HTB)
#define PG8_SB(b, h) ((4 + (b) * 2 + (h)) * HTB)
#define PG8_Q64(v) PG8_Q64_##v
#define PG8_Q64_voffA q64A
#define PG8_Q64_voffB q64B
#define PG8_STAGE(bufoff, gbase, voff) do { \
        __builtin_amdgcn_global_load_lds((const unsigned*)((const char*)(gbase) + (voff)), (LAS unsigned*)(lds + (bufoff) + ldsw), 16, 0, 0); \
        __builtin_amdgcn_global_load_lds((const unsigned*)((const char*)(gbase) + PG8_Q64(voff) + (voff)), (LAS unsigned*)(lds + (bufoff) + ldsw + 8192), 16, 0, 0); } while (0)
#define PG8_LDA(dst, b, h) do { _Pragma("unroll") for (int m = 0; m < 4; ++m) _Pragma("unroll") for (int k = 0; k < 2; ++k) dst[m][k] = *(const LAS bf16x8*)(lds + PG8_SA(b, h) + aoff + m * 2048 + k * 1024); } while (0)
#define PG8_LDB(dst, b, h) do { _Pragma("unroll") for (int n = 0; n < 2; ++n) _Pragma("unroll") for (int k = 0; k < 2; ++k) dst[n][k] = *(const LAS bf16x8*)(lds + PG8_SB(b, h) + boff + n * 2048 + k * 1024); } while (0)
#define PG8_MMA(ai, bj, At, Bt) do { __builtin_amdgcn_s_setprio(1); _Pragma("unroll") for (int m = 0; m < 4; ++m) _Pragma("unroll") for (int n = 0; n < 2; ++n) _Pragma("unroll") for (int k = 0; k < 2; ++k) \
        acc[ai][bj][m][n] = __builtin_amdgcn_mfma_f32_16x16x32_bf16(Bt[n][k], At[m][k], acc[ai][bj][m][n], 0, 0, 0); __builtin_amdgcn_s_setprio(0); } while (0)
#define PG8_WAIT_V(n) asm volatile("s_waitcnt vmcnt(" #n ")" ::: "memory")
#define PG8_WAIT_L(n) asm volatile("s_waitcnt lgkmcnt(" #n ")" ::: "memory")
#define PG8_BAR __builtin_amdgcn_s_barrier()
#define PG8_SCHED __builtin_amdgcn_sched_barrier(0)
    Unit cur, nxt; int ui = 0;
    if (!S.next(0, cur)) return;
    f32x4 acc[2][2][4][2];
#pragma unroll
    for (int a = 0; a < 2; ++a)
#pragma unroll
        for (int b = 0; b < 2; ++b)
#pragma unroll
            for (int m = 0; m < 4; ++m)
#pragma unroll
                for (int n = 0; n < 2; ++n) acc[a][b][m][n] = (f32x4){0.f, 0.f, 0.f, 0.f};
    bf16x8 At[4][2], B0[2][2], B1[2][2];
    const char* cA = PG8_ABASE(cur); const char* cB = PG8_BBASE(cur);
    PG8_STAGE(PG8_SB(0, 0), cB, voffB); PG8_STAGE(PG8_SB(0, 1), cB + hstepB, voffB); PG8_STAGE(PG8_SA(0, 0), cA, voffA); PG8_STAGE(PG8_SA(0, 1), cA + hstepA, voffA);
    if (wr == 1) PG8_BAR;
    PG8_WAIT_V(2); PG8_BAR;
    PG8_STAGE(PG8_SB(1, 0), cB + kstep, voffB); PG8_STAGE(PG8_SA(1, 0), cA + kstep, voffA); PG8_STAGE(PG8_SB(1, 1), cB + hstepB + kstep, voffB);
    PG8_WAIT_V(6); PG8_BAR;
    for (;;) {
        const bool has_next = S.next(ui + 1, nxt);
        const char* nA = has_next ? PG8_ABASE(nxt) : cA; const char* nB = has_next ? PG8_BBASE(nxt) : cB;
        for (int t = 0; t < nt; t += 2) {
            const bool last = (t == nt - 2);
            const char* a1 = cA + (size_t)(t + 1) * kstep;
            const char* a2 = last ? nA : cA + (size_t)(t + 2) * kstep; const char* b2 = last ? nB : cB + (size_t)(t + 2) * kstep;
            const char* a3 = a2 + kstep; const char* b3 = b2 + kstep;
            PG8_LDB(B0, 0, 0); PG8_LDB(B1, 0, 1); PG8_SCHED; PG8_LDA(At, 0, 0); PG8_STAGE(PG8_SA(1, 1), a1 + hstepA, voffA);
            PG8_WAIT_V(8); PG8_WAIT_L(0); PG8_BAR; PG8_MMA(0, 0, At, B0); PG8_MMA(0, 1, At, B1); PG8_BAR; PG8_SCHED;
            PG8_LDA(At, 0, 1); PG8_STAGE(PG8_SB(0, 0), b2, voffB); PG8_STAGE(PG8_SB(0, 1), b2 + hstepB, voffB); PG8_STAGE(PG8_SA(0, 0), a2, voffA);
            PG8_WAIT_V(8); PG8_WAIT_L(0); PG8_BAR; PG8_MMA(1, 0, At, B0); PG8_MMA(1, 1, At, B1); PG8_BAR; PG8_SCHED;
            PG8_LDB(B0, 1, 0); PG8_LDB(B1, 1, 1); PG8_SCHED; PG8_LDA(At, 1, 0); PG8_STAGE(PG8_SA(0, 1), a2 + hstepA, voffA);
            PG8_WAIT_V(8); PG8_WAIT_L(0); PG8_BAR; PG8_MMA(0, 0, At, B0); PG8_MMA(0, 1, At, B1); PG8_BAR; PG8_SCHED;
            PG8_LDA(At, 1, 1); PG8_STAGE(PG8_SB(1, 0), b3, voffB); PG8_STAGE(PG8_SB(1, 1), b3 + hstepB, voffB); PG8_STAGE(PG8_SA(1, 0), a3, voffA);
            PG8_WAIT_V(8); PG8_WAIT_L(0); PG8_BAR; PG8_MMA(1, 0, At, B0); PG8_MMA(1, 1, At, B1); PG8_BAR; PG8_SCHED;
        }
        if (wr == 0) PG8_BAR;
        run_epi(E, acc, cur, wr, wc, fr, fq, lds);
        if (!has_next) break;
#pragma unroll
        for (int a = 0; a < 2; ++a)
#pragma unroll
            for (int b = 0; b < 2; ++b)
#pragma unroll
                for (int m = 0; m < 4; ++m)
#pragma unroll
                    for (int n = 0; n < 2; ++n) acc[a][b][m][n] = (f32x4){0.f, 0.f, 0.f, 0.f};
        cur = nxt; cA = nA; cB = nB; ++ui;
        if (wr == 1) PG8_BAR;
    }
    PG8_WAIT_V(0);
    PG8_BAR;
#undef PG8_ABASE
#undef PG8_BBASE
#undef PG8_SA
#undef PG8_SB
#undef PG8_STAGE
#undef PG8_Q64
#undef PG8_Q64_voffA
#undef PG8_Q64_voffB
#undef PG8_LDA
#undef PG8_LDB
#undef PG8_MMA
#undef PG8_WAIT_V
#undef PG8_WAIT_L
#undef PG8_BAR
#undef PG8_SCHED
}
}

namespace att {
#define ATT_BAR() do { asm volatile("s_waitcnt lgkmcnt(0)" ::: "memory"); __builtin_amdgcn_s_barrier(); asm volatile("" ::: "memory"); } while (0)
constexpr int KST_B = 208  , VST_B = 144  ;
constexpr int KBYTES = 64 * KST_B, VBYTES = 64 * VST_B, BUFB = KBYTES + VBYTES;
__device__ __forceinline__ int crow(int r, int hi) { return (r & 3) + 8 * (r >> 2) + 4 * hi; }
constexpr int NSLOT = 4, NPIECE = 22;
__device__ __forceinline__ void attn_unit(int b, int h, int qb, const bf16* Q, const bf16* KN, const bf16* KR, const bf16* VT, bf16* OUT, LAS unsigned char* lds, const int tid) {
    const int lane = tid & 63, r32 = lane & 31, hi = lane >> 5, wid = __builtin_amdgcn_readfirstlane(tid >> 6);
    const size_t rowbase = (size_t)b * SEQ; const int q0 = qb * 256; const int qrow = q0 + wid * 32 + r32;
    const int NT = (q0 + 256) / 64;
    const char* gp[3]; unsigned ginc[3];
#pragma unroll
    for (int i = 0; i < 3; ++i) { const int p = wid + 8 * i;
        if (p < 13) { const int c = p * 64 + lane, row = c / 13, c16 = c % 13;
            if (c16 >= 8 && c16 < 12) { gp[i] = (const char*)(KR + (rowbase + row) * 32 + (c16 - 8) * 8); ginc[i] = 64 * 32 * 2; }
            else { gp[i] = (const char*)(KN + (rowbase + row) * 512 + h * 64 + (c16 < 8 ? c16 : 0) * 8); ginc[i] = 64 * 512 * 2; } }
        else { const int c = ((p < NPIECE ? p : 13) - 13) * 64 + lane, d = c / 9, c16 = c % 9;
            gp[i] = (const char*)(VT + (size_t)(h * 64 + d) * M + rowbase + (c16 < 8 ? c16 : 0) * 8); ginc[i] = 64 * 2; } }
#define ATT_DMA(t) do { LAS unsigned char* sl_ = lds + ((t) & (NSLOT - 1)) * BUFB + wid * 1024; \
        __builtin_amdgcn_global_load_lds((const unsigned*)(gp[0] + (size_t)(t) * ginc[0]), (LAS unsigned*)(sl_), 16, 0, 0); \
        __builtin_amdgcn_global_load_lds((const unsigned*)(gp[1] + (size_t)(t) * ginc[1]), (LAS unsigned*)(sl_ + 8192), 16, 0, 0); \
        if (wid < NPIECE - 16) __builtin_amdgcn_global_load_lds((const unsigned*)(gp[2] + (size_t)(t) * ginc[2]), (LAS unsigned*)(sl_ + 16384), 16, 0, 0); } while (0)
    bf16x8 qr[6];
    { const bf16* qp = Q + (rowbase + qrow) * 768 + h * 96 + hi * 8;
#pragma unroll
      for (int ks = 0; ks < 6; ++ks) qr[ks] = *(const bf16x8*)(qp + ks * 16); }
    asm volatile("s_waitcnt vmcnt(0)" ::: "memory");
    ATT_DMA(0); ATT_DMA(1); ATT_DMA(2);
    f32x16 o0, o1;
#pragma unroll
    for (int r = 0; r < 16; ++r) { o0[r] = 0.f; o1[r] = 0.f; }
    float mrun = 0.f, lrun = 0.f;
    f32x16 negm;
#pragma unroll
    for (int r = 0; r < 16; ++r) negm[r] = 0.f;
    const int qmin = q0 + wid * 32;
    asm volatile("s_waitcnt vmcnt(4)" ::: "memory");
    ATT_BAR();
    if (wid >= 4) ATT_BAR();
#pragma unroll 1
    for (int t = 0; t < NT; ++t) {
        if (t + 3 < NT) ATT_DMA(t + 3);
        const int kv0 = t * 64;
        const bool active = kv0 <= qmin + 31;
        bf16x8 vf0[4], vf1[4]; f32x16 p0, p1;
        if (active) {
            const LAS unsigned char* buf = lds + (t & (NSLOT - 1)) * BUFB;
            const LAS unsigned char* kb = buf + r32 * KST_B + hi * 16;
            const LAS unsigned char* vb = buf + KBYTES + r32 * VST_B + hi * 16;
#pragma unroll
            for (int s = 0; s < 4; ++s) { vf0[s] = *(const LAS bf16x8*)(vb + s * 32); vf1[s] = *(const LAS bf16x8*)(vb + 32 * VST_B + s * 32); }
            __builtin_amdgcn_sched_barrier(0);
#pragma unroll
            for (int ks = 0; ks < 6; ++ks) { const bf16x8 a0 = *(const LAS bf16x8*)(kb + ks * 32), a1 = *(const LAS bf16x8*)(kb + 32 * KST_B + ks * 32);
                if (ks == 0) { p0 = __builtin_amdgcn_mfma_f32_32x32x16_bf16(a0, qr[0], negm, 0, 0, 0); p1 = __builtin_amdgcn_mfma_f32_32x32x16_bf16(a1, qr[0], negm, 0, 0, 0); }
                else { p0 = __builtin_amdgcn_mfma_f32_32x32x16_bf16(a0, qr[ks], p0, 0, 0, 0); p1 = __builtin_amdgcn_mfma_f32_32x32x16_bf16(a1, qr[ks], p1, 0, 0, 0); } }
        }
        if (t + 3 < NT) asm volatile("s_waitcnt vmcnt(4)" ::: "memory");
        else asm volatile("s_waitcnt vmcnt(0)" ::: "memory");
        ATT_BAR();
        if (active) {
            if (kv0 + 63 > qmin) {
#pragma unroll
                for (int r = 0; r < 16; ++r) { const int kv = kv0 + crow(r, hi); if (kv > qrow) p0[r] = -1e30f; if (kv + 32 > qrow) p1[r] = -1e30f; }
            }
            float mx = __builtin_amdgcn_fmed3f(p0[0], p1[0], __builtin_inff());
#pragma unroll
            for (int r = 1; r < 16; ++r) { mx = __builtin_amdgcn_fmed3f(mx, p0[r], __builtin_inff()); mx = __builtin_amdgcn_fmed3f(mx, p1[r], __builtin_inff()); }
            { auto rr = __builtin_amdgcn_permlane32_swap(__float_as_uint(mx), __float_as_uint(mx), false, false); mx = fmaxf(__uint_as_float(rr[0]), __uint_as_float(rr[1])); }
            const bool first = (t == 0);
            if (first || __builtin_amdgcn_ballot_w64(mx > 0.f) != 0ull) {
                const float d = first ? mx : fmaxf(mx, 0.f); mrun += d;
                if (!first) { const float alpha = ex2(-d); lrun *= alpha;
#pragma unroll
                    for (int r = 0; r < 16; ++r) { o0[r] *= alpha; o1[r] *= alpha; } }
#pragma unroll
                for (int r = 0; r < 16; ++r) { p0[r] -= d; p1[r] -= d; negm[r] = -mrun; }
            }
            float rs0 = 0.f, rs1 = 0.f;
#pragma unroll
            for (int r = 0; r < 16; ++r) { p0[r] = ex2(p0[r]); p1[r] = ex2(p1[r]); rs0 += p0[r]; asm volatile("" : "+v"(rs0)); rs1 += p1[r]; asm volatile("" : "+v"(rs1)); }
            lrun += rs0 + rs1;
            u32x4 pw[4];
#pragma unroll
            for (int j = 0; j < 4; ++j) { pw[0][j] = pk2(p0[2 * j], p0[2 * j + 1]); pw[1][j] = pk2(p0[8 + 2 * j], p0[8 + 2 * j + 1]); pw[2][j] = pk2(p1[2 * j], p1[2 * j + 1]); pw[3][j] = pk2(p1[8 + 2 * j], p1[8 + 2 * j + 1]); }
#pragma unroll
            for (int s = 0; s < 4; ++s) { const bf16x8 pf = __builtin_bit_cast(bf16x8, pw[s]);
                o0 = __builtin_amdgcn_mfma_f32_32x32x16_bf16(vf0[s], pf, o0, 0, 0, 0); o1 = __builtin_amdgcn_mfma_f32_32x32x16_bf16(vf1[s], pf, o1, 0, 0, 0); }
        }
        ATT_BAR();
    }
    if (wid < 4) ATT_BAR();
#undef ATT_DMA
    float ltot; { auto rr = __builtin_amdgcn_permlane32_swap(__float_as_uint(lrun), __float_as_uint(lrun), false, false); ltot = __uint_as_float(rr[0]) + __uint_as_float(rr[1]); }
    const float inv = rcp(ltot);
    bf16* op = OUT + (rowbase + qrow) * 1024 + h * 64 + 4 * hi;
#pragma unroll
    for (int g = 0; g < 4; ++g) {
        u32x2 w0, w1; w0.x = pk2(o0[4 * g] * inv, o0[4 * g + 1] * inv); w0.y = pk2(o0[4 * g + 2] * inv, o0[4 * g + 3] * inv);
        w1.x = pk2(o1[4 * g] * inv, o1[4 * g + 1] * inv); w1.y = pk2(o1[4 * g + 2] * inv, o1[4 * g + 3] * inv);
        *(u32x2*)(op + 8 * g) = w0; *(u32x2*)(op + 32 + 8 * g) = w1; }
    asm volatile("s_waitcnt vmcnt(0)" ::: "memory");
}
}

constexpr size_t MiB = 1u << 20;
constexpr size_t WS_BAR = 32 * 1024;
constexpr size_t WS_SP8 = 0;
constexpr size_t WS_CA = 64 * 1024, WS_CB = WS_CA + 256 * 1024 * 4;
constexpr size_t WS_SSQ = 2 * MiB + 128 * 1024;
constexpr size_t WS_COS = 3 * MiB, WS_SIN = 5 * MiB;
constexpr size_t WS_MN = 7 * MiB;
constexpr size_t WS_MK = 9 * MiB;
constexpr size_t WS_MVT = 11 * MiB;
constexpr size_t WS_W = 13 * MiB;
constexpr size_t W_EVIN = WS_W, W_POOL = W_EVIN + 2 * MiB, W_QUP = W_POOL + MiB, W_KN = W_QUP + MiB, W_V = W_KN + MiB / 4, W_EVOUT = W_KN + MiB;
constexpr size_t W_ODIN = W_EVOUT + 2 * MiB, W_GATE = W_ODIN + 4 * MiB, W_ODOUT = W_GATE + MiB, W_XAQ = W_ODOUT + 2 * MiB  , W_XAKV = W_XAQ + 4 * MiB  ;
constexpr size_t W_XAO = W_XAKV + 8 * MiB  , W_FFN1 = W_XAO + 4 * MiB  , W_FFN2 = W_FFN1 + 22 * MiB  , W_END = W_FFN2 + 11 * MiB;
static_assert(W_END <= 80 * MiB, "weights");
constexpr size_t WS_XN = 80 * MiB;
constexpr size_t WS_MIX = 144 * MiB;
constexpr size_t WS_H = 208 * MiB;
constexpr size_t WS_U = 208 * MiB, WS_CQ = 240 * MiB, WS_CKV = 256 * MiB, WS_KR = 264 * MiB, WS_POOLED = 266 * MiB, WS_CQN = 298 * MiB, WS_CKVN = 314 * MiB, WS_Q = 322 * MiB;
constexpr size_t WS_KN = 384 * MiB, WS_VT = 416 * MiB;
constexpr size_t WS_XQ = 208 * MiB, WS_P = 272 * MiB;
constexpr size_t WS_GB = 208 * MiB, WS_XBP = 272 * MiB, WS_B = 272 * MiB, WS_A = 336 * MiB;
constexpr size_t WS_WPP = 470 * MiB;
constexpr size_t WS_NEED = 480 * MiB;

struct Args {
    const float* x; const float* mem; const int* pos;
    const float *ev_norm, *ev_w_in, *ev_pool_w, *ev_pool_scale, *ev_q_norm, *ev_w_q_up, *ev_kv_norm, *ev_w_kv_up, *ev_w_out;
    const float *od_norm, *od_w_in, *od_conv_w, *od_conv_b, *od_w_rgate, *od_b_rgate, *od_w_igate, *od_b_igate, *od_lambda, *od_w_out;
    const float *xa_norm_x, *xa_norm_mem, *xa_w_q, *xa_w_kv, *xa_w_o, *ffn_norm, *ffn_w_gate_up, *ffn_w_down, *final_norm;
    float* out; unsigned char* ws; int ph_lo, ph_hi;
};

__device__ __forceinline__ void tr_item(const float* W, int ldw, int k0, int n0, bf16* dst, int ldd, LAS float* scr, int lane, const float* kg) {
#pragma unroll
    for (int i = 0; i < 32; ++i) { const int kk = 2 * i + (lane >> 5); float w = W[(size_t)(k0 + kk) * ldw + n0 + (lane & 31)]; if (kg) w *= kg[k0 + kk]; scr[kk * 33 + (lane & 31)] = w; }
    LDS_WAIT(); asm volatile("" ::: "memory");
    const int c = lane & 7;
#pragma unroll
    for (int j = 0; j < 4; ++j) { const int n = (lane >> 3) + 8 * j; const LAS float* s = scr + (8 * c) * 33 + n;
        u32x4 o; o.x = pk2(s[0 * 33], s[1 * 33]); o.y = pk2(s[2 * 33], s[3 * 33]); o.z = pk2(s[4 * 33], s[5 * 33]); o.w = pk2(s[6 * 33], s[7 * 33]);
        *(u32x4*)(dst + (size_t)n * ldd + k0 + 8 * c) = o; }
    LDS_WAIT(); asm volatile("" ::: "memory");
}
template <class RM> __device__ __forceinline__ void tr_matrix(const float* W, int K, int N, int ldd, RM rowptr, LAS float* scr, int gw, int NGW, int lane, int& rot, const float* kg = nullptr) {
    const int nblk = N / 32, nit = (K / 64) * nblk;
    int start = (gw - (rot % NGW) + NGW) % NGW;
    for (int it = start; it < nit; it += NGW) { const int kb = it / nblk, nb = it % nblk; tr_item(W, N, 64 * kb, 32 * nb, rowptr(32 * nb), ldd, scr, lane, kg); }
    rot += nit;
}
__device__ __forceinline__ void rms_row_bf16(const float* xrow, const float* g, bf16* orow, int lane) {
    const f32x4* xr = (const f32x4*)xrow + lane; const f32x4* gr = (const f32x4*)g + lane;
    f32x4 v[4]; float s = 0.f;
#pragma unroll
    for (int j = 0; j < 4; ++j) { v[j] = xr[64 * j]; s += (v[j][0] * v[j][0] + v[j][1] * v[j][1]) + (v[j][2] * v[j][2] + v[j][3] * v[j][3]); }
    const float rstd = rsqrtf(wave_sum(s) * (1.f / D) + RMS_EPS);
#pragma unroll
    for (int j = 0; j < 4; ++j) { const f32x4 o = v[j] * rstd * gr[64 * j]; u32x2 w; w.x = pk2(o[0], o[1]); w.y = pk2(o[2], o[3]); *(u32x2*)(orow + 4 * lane + 256 * j) = w; }
}
__device__ __forceinline__ void norm_pass(const float* X, const float* g, bf16* XN, int gw, int NGW, int lane) {
    for (int m = gw; m < M; m += NGW) rms_row_bf16(X + (size_t)m * D, g, XN + (size_t)m * D, lane);
}

__device__ __forceinline__ int fresh_tid(int wave) { int l; asm volatile("v_mbcnt_lo_u32_b32 %0, -1, 0\n\tv_mbcnt_hi_u32_b32 %0, -1, %0" : "=v"(l)); return wave * 64 + l; }
#define XB_TMO      128
#define XB_XCNT(j)  (256  + 64 * (j))
#define XB_XSUB(j)  (1280 + 64 * (j))
#define XB_XGEN(j)  (2304 + 64 * (j))
#define XB_TOP      3328
#define XB_TOPGEN   3392
#define XCD_BAR_WORDS 3456
#define XB_SPIN_CAP (1u << 18)
__device__ __forceinline__ unsigned xb_ld(unsigned* p)              { return __hip_atomic_load(p, __ATOMIC_RELAXED, __HIP_MEMORY_SCOPE_AGENT); }
__device__ __forceinline__ unsigned xb_add(unsigned* p, unsigned v) { return __hip_atomic_fetch_add(p, v, __ATOMIC_RELAXED, __HIP_MEMORY_SCOPE_AGENT); }
__device__ __forceinline__ unsigned xb_xcc_id() { return (unsigned)__builtin_amdgcn_s_getreg((3 << 11) | 20) & 0xFu; }
#define XB_SPIN(cond, bar) do { unsigned _sp = 0; while (cond) { __builtin_amdgcn_s_sleep(1); \
    if ((++_sp & 255u) == 0u) { if (xb_ld(&(bar)[XB_TMO])) break; if (_sp > XB_SPIN_CAP) { atomicAdd(&(bar)[XB_TMO], 1u); break; } } } } while (0)
__device__ __forceinline__ void xcd_barrier_complete(unsigned* bar, unsigned x, unsigned G, unsigned& nloc, unsigned& nx) {
    unsigned sum, cnt, mine, sp = 0u;
    for (;;) {
        sum = 0u; cnt = 0u; mine = 0u;
#pragma unroll
        for (unsigned j = 0; j < 16; ++j) { const unsigned c = xb_ld(&bar[XB_XCNT(j)]); sum += c; cnt += (c > 0u) ? 1u : 0u; mine = (j == x) ? c : mine; }
        if (sum == G) break;
        __builtin_amdgcn_s_sleep(1);
        if ((++sp & 255u) == 0u) { if (xb_ld(&bar[XB_TMO])) break; if (sp > XB_SPIN_CAP) { atomicAdd(&bar[XB_TMO], 1u); break; } }
    }
    nloc = mine > 0u ? mine : 1u; nx = cnt > 0u ? cnt : 1u;
}
__device__ __forceinline__ void xcd_barrier(unsigned* bar, unsigned x, volatile LAS unsigned* st, unsigned G, int tid) {
    asm volatile("s_waitcnt vmcnt(0)" ::: "memory");
    __syncthreads();
    if (tid == 0) {
        __builtin_amdgcn_s_waitcnt(0);
        unsigned nloc = st[0], nx = st[1];
        if (nloc == 0u) { xcd_barrier_complete(bar, x, G, nloc, nx); st[0] = nloc; st[1] = nx; }
        const unsigned old = xb_add(&bar[XB_XSUB(x)], 1u);
        const unsigned gen = old / nloc;
        if (old + 1u == (gen + 1u) * nloc) {
            __builtin_amdgcn_fence(__ATOMIC_RELEASE, "agent");
            asm volatile("s_waitcnt vmcnt(0)" ::: "memory");
            const unsigned og = xb_add(&bar[XB_TOP], 1u);
            const unsigned tg = og / nx;
            if (og + 1u == (tg + 1u) * nx) xb_add(&bar[XB_TOPGEN], 1u);
            else XB_SPIN(xb_ld(&bar[XB_TOPGEN]) == tg, bar);
            __builtin_amdgcn_fence(__ATOMIC_ACQUIRE, "agent");
            xb_add(&bar[XB_XGEN(x)], 1u);
            asm volatile("s_waitcnt vmcnt(0)" ::: "memory");
        } else {
            XB_SPIN(xb_ld(&bar[XB_XGEN(x)]) == gen, bar);
            __builtin_amdgcn_fence(__ATOMIC_ACQUIRE, "agent");
            asm volatile("s_waitcnt vmcnt(0)" ::: "memory");
        }
    }
    __syncthreads();
}

typedef const __attribute__((address_space(4))) Args* KArgs;
__global__ void __launch_bounds__(NTHREADS, 2) hybrid_fwd(Args a_) {
    extern __shared__ __attribute__((aligned(16))) unsigned char lds_raw[];
    LAS unsigned char* lds = (LAS unsigned char*)lds_raw;
    cg::grid_group grid = cg::this_grid();
    const int wave = __builtin_amdgcn_readfirstlane(threadIdx.x >> 6);
    const int G = gridDim.x, bx = blockIdx.x;
    volatile LAS unsigned* const xst = (volatile LAS unsigned*)(lds + EPI_OFF + 16000);
    if (threadIdx.x == 0) { xst[0] = 0u; xst[1] = 0u; }
    if (threadIdx.x == 0) (void)xb_add((unsigned*)(a_.ws + WS_BAR) + XB_XCNT(xb_xcc_id()), 1u);
    __syncthreads();
    if (a_.ph_hi < 0) grid.sync();
    const int vcu = (G % 8 == 0) ? (bx % 8) * (G / 8) + bx / 8 : bx;
    const int gw = vcu * NWAVES + wave, NGW = G * NWAVES;
#ifndef PREFIX_K
#define PREFIX_K 0
#endif
#pragma unroll 1
    for (int pass = (PREFIX_K > 0 ? 0 : 1); pass < 2; ++pass) {
    const int lo = a_.ph_lo, hi = (pass == 0) ? PREFIX_K : a_.ph_hi;
    int ph = 0;
#define a (*ap)
#ifndef PROBE_MASK
#define PROBE_MASK (0ull)
#endif
#define PHASE_BEGIN if (lo <= ph && ph < hi) for (int rep_ = ((PROBE_MASK >> ph) & 1ull) ? 2 : 1; rep_ > 0; --rep_) { KArgs ap = (KArgs)__builtin_amdgcn_kernarg_segment_ptr(); asm volatile("" : "+s"(ap)); int lane; asm volatile("v_mbcnt_lo_u32_b32 %0, -1, 0\n\tv_mbcnt_hi_u32_b32 %0, -1, %0" : "=v"(lane)); const int tid = wave * 64 + lane; (void)tid; unsigned char* const ws = a.ws; float* const outp = a.out; \
    bf16* const XN = WSP(bf16, WS_XN); bf16* const MIX = WSP(bf16, WS_MIX); const float* cosT = WSP(float, WS_COS); const float* sinT = WSP(float, WS_SIN); (void)XN; (void)MIX; (void)cosT; (void)sinT; (void)outp;
#define PHASE_END   if (rep_ == 1 && (ph + 1 < hi || pass == 0)) { xcd_barrier((unsigned*)(ws + WS_BAR), xb_xcc_id(), (volatile LAS unsigned*)(lds + EPI_OFF + 16000), (unsigned)G, tid); } } ++ph;
#define WSP(T, off) ((T*)(ws + (off)))
    using pg8::Gemm; using pg8::Epi; using pg8::StaticOrder;

    PHASE_BEGIN
    {
        LAS float* scr = (LAS float*)(lds + wave * 16384);
        int rot = 0;
        tr_matrix(a.ev_w_in, 1024, 928, 1024, [&](int n0) { return WSP(bf16, W_EVIN) + (size_t)n0 * 1024; }, scr, gw, NGW, lane, rot);
        tr_matrix(a.ev_w_q_up, 256, 768, 256, [&](int n0) { return WSP(bf16, W_QUP) + (size_t)n0 * 256; }, scr, gw, NGW, lane, rot);
        tr_matrix(a.ev_w_kv_up, 128, 1024, 128, [&](int n0) { const int h = n0 >> 7, j0 = n0 & 127; return (j0 < 64 ? WSP(bf16, W_KN) : WSP(bf16, W_V)) + (size_t)(h * 64 + (j0 & 63)) * 128; }, scr, gw, NGW, lane, rot);
        tr_matrix(a.ev_w_out, 1024, 1024, 1024, [&](int n0) { return WSP(bf16, W_EVOUT) + (size_t)n0 * 1024; }, scr, gw, NGW, lane, rot);
        tr_matrix(a.od_w_in, 1024, 2048, 1024, [&](int n0) { return WSP(bf16, W_ODIN) + (size_t)n0 * 1024; }, scr, gw, NGW, lane, rot, a.od_norm);
        for (int h = 0; h < 4; ++h) {
            tr_matrix(a.od_w_rgate + (size_t)h * 65536, 256, 256, 256, [&](int n0) { return WSP(bf16, W_GATE) + (size_t)(256 * (2 * h + (n0 >> 7)) + (n0 & 127)) * 256; }, scr, gw, NGW, lane, rot);
            tr_matrix(a.od_w_igate + (size_t)h * 65536, 256, 256, 256, [&](int n0) { return WSP(bf16, W_GATE) + (size_t)(256 * (2 * h + (n0 >> 7)) + 128 + (n0 & 127)) * 256; }, scr, gw, NGW, lane, rot);
        }
        tr_matrix(a.od_w_out, 1024, 1024, 1024, [&](int n0) { return WSP(bf16, W_ODOUT) + (size_t)n0 * 1024; }, scr, gw, NGW, lane, rot);
        for (int l = 0; l < 2; ++l) {
            tr_matrix(a.xa_w_q + (size_t)l * 1048576, 1024, 1024, 1024, [&](int n0) { return WSP(bf16, W_XAQ + l * 2 * MiB) + (size_t)n0 * 1024; }, scr, gw, NGW, lane, rot, a.xa_norm_x + l * D);
            tr_matrix(a.xa_w_kv + (size_t)l * 2097152, 1024, 2048, 1024, [&](int n0) { return WSP(bf16, W_XAKV + l * 4 * MiB) + (size_t)n0 * 1024; }, scr, gw, NGW, lane, rot);
            tr_matrix(a.xa_w_o + (size_t)l * 1048576, 1024, 1024, 1024, [&](int n0) { return WSP(bf16, W_XAO + l * 2 * MiB) + (size_t)n0 * 1024; }, scr, gw, NGW, lane, rot);
            tr_matrix(a.ffn_w_gate_up + (size_t)l * 1024 * 5632, 1024, 5632, 1024, [&](int n0) { const int isu = n0 >= DFF, nn = isu ? n0 - DFF : n0; return WSP(bf16, W_FFN1 + l * 11 * MiB) + (size_t)(256 * (nn >> 7) + 128 * isu + (nn & 127)) * 1024; }, scr, gw, NGW, lane, rot, a.ffn_norm + l * D);
            tr_matrix(a.ffn_w_down + (size_t)l * DFF * 1024, DFF, 1024, DFF, [&](int n0) { return WSP(bf16, W_FFN2) + (size_t)l * (1024 * DFF) + (size_t)n0 * DFF; }, scr, gw, NGW, lane, rot);
        }
        const int gt = vcu * NTHREADS + tid, NGT = G * NTHREADS;
        for (int i = gt; i < 512 * 256; i += NGT) { const int n = i >> 8, kk = i & 255, g = n >> 7; float v = 0.f; if ((kk >> 7) == (g & 1)) v = a.ev_pool_w[(size_t)g * 16384 + (size_t)(kk & 127) * 128 + (n & 127)];
            WSP(bf16, W_POOL)[i] = (bf16)(pk2(v, 0.f) & 0xffffu); }
        for (int i = gt; i < M * 16; i += NGT) { const int row = i >> 4, j = i & 15; const int f = j & 3, e = j >> 2;
            const float fa = f == 0 ? 1.0f : (f == 1 ? 0.5623413251903491f : (f == 2 ? 0.31622776601683794f : 0.1778279410038923f));
            const float fb = e == 0 ? 1.0f : (e == 1 ? 0.1f : (e == 2 ? 0.01f : 0.001f));
            const float inv_freq = fa * fb; const float ang = (float)a.pos[row] * inv_freq;
            const double t = (double)ang * 0.15915494309189535; const float fr = (float)(t - __builtin_floor(t));
            WSP(float, WS_COS)[i] = __builtin_amdgcn_cosf(fr); WSP(float, WS_SIN)[i] = __builtin_amdgcn_sinf(fr); }
        for (int i = gt; i < 6 * M; i += NGT) WSP(float, WS_SSQ)[i] = 0.f;
        for (int i = gt; i < 1024; i += NGT) { const float l = a.od_lambda[i]; const float y = ex2(-l * LOG2E);
            const float sp = (y < 0.03f) ? y * (1.0f - y * (0.5f - y * (1.0f / 3.0f - 0.25f * y))) : 0.6931471805599453f * __builtin_amdgcn_logf(1.0f + y);
            WSP(float, WS_SP8)[i] = 8.0f * sp; }
        for (int r = gw; r < 1024; r += NGW) { const int l = r >> 9, mr = r & 511; rms_row_bf16(a.mem + (size_t)mr * D, a.xa_norm_mem + l * D, WSP(bf16, WS_MN) + (size_t)r * D, lane); }
        norm_pass(a.x, a.ev_norm, XN, gw, NGW, lane);
    }
    PHASE_END

    PHASE_BEGIN
    {
        { Gemm g = pg8::mk(XN, WSP(bf16, W_EVIN), M, 1024, 1024); StaticOrder S; S.init(M, 1024, G, bx);
          Epi E{}; E.mode = pg8::E_EVIN; E.O = WSP(bf16, WS_U); E.O2 = WSP(bf16, WS_CQ); E.O3 = WSP(bf16, WS_CKV); E.O4 = WSP(bf16, WS_KR); E.cosT = cosT; E.sinT = sinT;
          pg8::gemm_phase(lds, g, S, E, fresh_tid(wave)); }
    }
    PHASE_END

    PHASE_BEGIN
    {
        const int NMEMWG = (G >= 64) ? 32 : 0;
        if (bx < NMEMWG) {
            const int l = bx >> 4, isv = (bx >> 3) & 1;
            if (!isv) { Gemm g = pg8::mk(WSP(bf16, WS_MN) + (size_t)l * 512 * D, WSP(bf16, W_XAKV + l * 4 * MiB), 512, 1024, 1024); StaticOrder S; S.init(512, 1024, G, bx & 7);
              Epi E{}; E.mode = pg8::E_PLAIN; E.O = WSP(bf16, WS_MK) + (size_t)l * 512 * D; E.ldc = 1024; E.scale = 1.f; pg8::gemm_phase(lds, g, S, E, fresh_tid(wave)); }
            else { Gemm g = pg8::mk(WSP(bf16, WS_MN) + (size_t)l * 512 * D, WSP(bf16, W_XAKV + l * 4 * MiB) + (size_t)1024 * 1024, 512, 1024, 1024); StaticOrder S; S.init(512, 1024, G, bx & 7);
              Epi E{}; E.mode = pg8::E_PLAIN; E.O = WSP(bf16, WS_MVT) + (size_t)l * 512 * D; E.ldc = 1024; E.scale = 1.f; pg8::gemm_phase(lds, g, S, E, fresh_tid(wave)); }
        } else {
        const int gw = (bx - NMEMWG) * NWAVES + wave, NGW = (G - NMEMWG) * NWAVES;
        const bf16* U = WSP(bf16, WS_U); const bf16* CQ = WSP(bf16, WS_CQ); const bf16* CKV = WSP(bf16, WS_CKV);
        bf16* PO = WSP(bf16, WS_POOLED); bf16* CQN = WSP(bf16, WS_CQN); bf16* CKVN = WSP(bf16, WS_CKVN);
        const int w = 2 << (lane >> 4);
        const f32x4 gq = *(const f32x4*)(a.ev_q_norm + 4 * lane); const f32x2 gk = *(const f32x2*)(a.ev_kv_norm + 2 * lane);
        for (int row = gw; row < M; row += NGW) {
            const int s = row & (SEQ - 1); const int cnt = (s + 1 < w) ? s + 1 : w;
            float sum[8]; float self[8];
            { const u32x4 v = *(const u32x4*)(U + (size_t)row * 512 + 8 * lane);
              self[0] = bflo(v.x); self[1] = bfhi(v.x); self[2] = bflo(v.y); self[3] = bfhi(v.y); self[4] = bflo(v.z); self[5] = bfhi(v.z); self[6] = bflo(v.w); self[7] = bfhi(v.w);
#pragma unroll
              for (int e = 0; e < 8; ++e) sum[e] = self[e]; }
            for (int tt = 1; tt < cnt; ++tt) { const u32x4 v = *(const u32x4*)(U + (size_t)(row - tt) * 512 + 8 * lane);
                sum[0] += bflo(v.x); sum[1] += bfhi(v.x); sum[2] += bflo(v.y); sum[3] += bfhi(v.y); sum[4] += bflo(v.z); sum[5] += bfhi(v.z); sum[6] += bflo(v.w); sum[7] += bfhi(v.w); }
            const float ic = 1.0f / (float)cnt;
            u32x4 o; o.x = pk2(sum[0] * ic - self[0], sum[1] * ic - self[1]); o.y = pk2(sum[2] * ic - self[2], sum[3] * ic - self[3]);
            o.z = pk2(sum[4] * ic - self[4], sum[5] * ic - self[5]); o.w = pk2(sum[6] * ic - self[6], sum[7] * ic - self[7]);
            *(u32x4*)(PO + (size_t)row * 512 + 8 * lane) = o;
            { const u32x2 v = *(const u32x2*)(CQ + (size_t)row * 256 + 4 * lane); const float x0 = bflo(v.x), x1 = bfhi(v.x), x2 = bflo(v.y), x3 = bfhi(v.y);
              const float rstd = rsqrtf(wave_sum((x0 * x0 + x1 * x1) + (x2 * x2 + x3 * x3)) * (1.f / 256.f) + RMS_EPS);
              u32x2 q; q.x = pk2(x0 * rstd * gq[0], x1 * rstd * gq[1]); q.y = pk2(x2 * rstd * gq[2], x3 * rstd * gq[3]); *(u32x2*)(CQN + (size_t)row * 256 + 4 * lane) = q; }
            { const unsigned v = *(const unsigned*)(CKV + (size_t)row * 128 + 2 * lane); const float x0 = bflo(v), x1 = bfhi(v);
              const float rstd = rsqrtf(wave_sum(x0 * x0 + x1 * x1) * (1.f / 128.f) + RMS_EPS);
              *(unsigned*)(CKVN + (size_t)row * 128 + 2 * lane) = pk2(x0 * rstd * gk[0], x1 * rstd * gk[1]); }
        }
        }
    }
    PHASE_END

    PHASE_BEGIN
    {
        { Gemm g = pg8::mk(WSP(bf16, WS_CQN), WSP(bf16, W_QUP), M, 768, 256); StaticOrder S; S.init(M, 768, G, bx);
          Epi E{}; E.mode = pg8::E_QROPE; E.O = WSP(bf16, WS_Q); E.scale = 0.10206207261596577f * LOG2E; E.cosT = cosT; E.sinT = sinT; pg8::gemm_phase(lds, g, S, E, fresh_tid(wave)); }
        { Gemm g = pg8::mk(WSP(bf16, WS_CKVN), WSP(bf16, W_KN), M, 512, 128); StaticOrder S; S.init(M, 512, G, bx);
          Epi E{}; E.mode = pg8::E_PLAIN; E.O = WSP(bf16, WS_KN); E.ldc = 512; E.scale = 1.f; pg8::gemm_phase(lds, g, S, E, fresh_tid(wave)); }
        { Gemm g = pg8::mk(WSP(bf16, W_V), WSP(bf16, WS_CKVN), 512, M, 128); StaticOrder S; S.init(512, M, G, bx);
          Epi E{}; E.mode = pg8::E_VT; E.O = WSP(bf16, WS_VT); E.ldc = M; pg8::gemm_phase(lds, g, S, E, fresh_tid(wave)); }
        { Gemm g = pg8::mk(WSP(bf16, WS_POOLED), WSP(bf16, W_POOL), M, 512, 256); g.lda = 512; g.a_pm_off = 256L * 512; g.a_pn_off = 256; StaticOrder S; S.init(M, 512, G, bx);
          Epi E{}; E.mode = pg8::E_POOL; E.O = MIX; E.ldc = 1024; E.vec0 = a.ev_pool_scale; pg8::gemm_phase(lds, g, S, E, fresh_tid(wave)); }
        { const int idx = bx >> 2;
          if (idx < 16) { const int l = idx >> 3, b = (idx >> 2) & 1, h = idx & 3;
            Gemm g = pg8::mk(WSP(bf16, W_XAO + l * 2 * MiB) + h * 256, WSP(bf16, WS_MVT) + (size_t)l * 512 * D + (size_t)b * 256 * D + h * 256, 1024, 256, 256); g.lda = 1024; g.a_pm_off = 256L * 1024; g.ldb = 1024;
            StaticOrder S; S.init(1024, 256, G, bx & 3);
            Epi E{}; E.mode = pg8::E_PLAIN; E.O = WSP(bf16, WS_WPP) + (size_t)(l * 2 + b) * 1024 * 1024 + h * 256; E.ldc = 1024; E.scale = 1.f; pg8::gemm_phase(lds, g, S, E, fresh_tid(wave)); } }
    }
    PHASE_END

    PHASE_BEGIN
    {
        for (int vw = vcu; vw < 256; vw += G) { const int bh = vw >> 4, s = vw & 15;
#pragma unroll 1
            for (int i = 0; i < 4; ++i) { const int qb = (i == 0) ? 63 - s : (i == 1) ? s : (i == 2) ? 32 + s : 31 - s;
                size_t z0 = 0; asm volatile("" : "+s"(z0)); unsigned char* w2 = ws + z0;
                att::attn_unit(bh >> 3, bh & 7, qb, (const bf16*)(w2 + WS_Q), (const bf16*)(w2 + WS_KN), (const bf16*)(w2 + WS_KR), (const bf16*)(w2 + WS_VT), (bf16*)(w2 + WS_MIX) + 512, lds, fresh_tid(wave)); } }
    }
    PHASE_END

    PHASE_BEGIN
    { Gemm g = pg8::mk(MIX, WSP(bf16, W_EVOUT), M, 1024, 1024); StaticOrder S; S.init(M, 1024, G, bx);
      Epi E{}; E.mode = pg8::E_RES; E.base = a.x; E.out = outp; E.O = XN; E.aout = WSP(float, WS_SSQ); pg8::gemm_phase(lds, g, S, E, fresh_tid(wave)); }
    PHASE_END

#pragma unroll 1
    for (int l = 0; l < 2; ++l) {
        if (l == 1) {
            PHASE_BEGIN
            { Gemm g = pg8::mk(XN, WSP(bf16, W_ODIN), M, 2048, 1024); StaticOrder S; S.init(M, 2048, G, bx);
              Epi E{}; E.mode = pg8::E_ODIN; E.O = WSP(bf16, WS_GB); E.O2 = WSP(bf16, WS_XBP); E.vec0 = WSP(float, WS_SSQ) + 2 * (size_t)M; pg8::gemm_phase(lds, g, S, E, fresh_tid(wave)); }
            PHASE_END
            PHASE_BEGIN
            {
                const bf16* XBP = WSP(bf16, WS_XBP); bf16* XB = XN;
                const int half = gw & 1; const int c0 = half * 512 + 8 * lane;
                float wv[4][8], bias[8];
#pragma unroll
                for (int j = 0; j < 4; ++j)
#pragma unroll
                    for (int e = 0; e < 8; ++e) wv[j][e] = a.od_conv_w[j * 1024 + c0 + e];
#pragma unroll
                for (int e = 0; e < 8; ++e) bias[e] = a.od_conv_b[c0 + e];
                for (int row = gw >> 1; row < M; row += NGW >> 1) { const int s = row & (SEQ - 1); float acc[8];
#pragma unroll
                    for (int e = 0; e < 8; ++e) acc[e] = bias[e];
#pragma unroll
                    for (int j = 0; j < 4; ++j) { if (s - 3 + j >= 0) { const u32x4 v = *(const u32x4*)(XBP + (size_t)(row - 3 + j) * D + c0);
                        acc[0] += wv[j][0] * bflo(v.x); acc[1] += wv[j][1] * bfhi(v.x); acc[2] += wv[j][2] * bflo(v.y); acc[3] += wv[j][3] * bfhi(v.y);
                        acc[4] += wv[j][4] * bflo(v.z); acc[5] += wv[j][5] * bfhi(v.z); acc[6] += wv[j][6] * bflo(v.w); acc[7] += wv[j][7] * bfhi(v.w); } }
                    u32x4 o; o.x = pk2(acc[0], acc[1]); o.y = pk2(acc[2], acc[3]); o.z = pk2(acc[4], acc[5]); o.w = pk2(acc[6], acc[7]);
                    *(u32x4*)(XB + (size_t)row * D + c0) = o; }
            }
            PHASE_END
            PHASE_BEGIN
            { Gemm g = pg8::mk(XN, WSP(bf16, W_GATE), M, 2048, 256); g.lda = 1024; g.a_pm_off = 256L * 1024; g.a_pn_off = 256; g.a_pn_shift = 1; StaticOrder S; S.init(M, 2048, G, bx);
              Epi E{}; E.mode = pg8::E_GATE; E.O = WSP(bf16, WS_B); E.aout = WSP(float, WS_A); E.vec0 = a.od_b_rgate; E.vec1 = a.od_b_igate; E.vec2 = WSP(float, WS_SP8); E.pos = a.pos; E.xb = XN;
              pg8::gemm_phase(lds, g, S, E, fresh_tid(wave)); }
            PHASE_END
            PHASE_BEGIN
            {
                const float* A_ = WSP(float, WS_A); const bf16* B_ = WSP(bf16, WS_B);
                for (int it = vcu; it < 256; it += G) { const size_t r0 = (size_t)it * 128; const int c = 2 * tid;
                    float A0 = 1.f, A1 = 1.f, B0 = 0.f, B1 = 0.f;
#pragma unroll 8
                    for (int t = 0; t < 128; ++t) { const f32x2 av = *(const f32x2*)(A_ + (r0 + t) * D + c); const unsigned bw = *(const unsigned*)(B_ + (r0 + t) * D + c);
                        B0 = av[0] * B0 + bflo(bw); B1 = av[1] * B1 + bfhi(bw); A0 *= av[0]; A1 *= av[1]; }
                    *(f32x2*)(WSP(float, WS_CA) + (size_t)it * D + c) = (f32x2){A0, A1}; *(f32x2*)(WSP(float, WS_CB) + (size_t)it * D + c) = (f32x2){B0, B1}; }
            }
            PHASE_END
            PHASE_BEGIN
            {
                const float* A_ = WSP(float, WS_A); const bf16* B_ = WSP(bf16, WS_B); const bf16* GB = WSP(bf16, WS_GB);
                for (int it = vcu; it < 256; it += G) { const size_t r0 = (size_t)it * 128; const int c = 2 * tid; const int j = it & 127, it0 = it - j;
                    float h0 = 0.f, h1 = 0.f;
#pragma unroll 8
                    for (int jj = 0; jj < j; ++jj) { const f32x2 ca = *(const f32x2*)(WSP(float, WS_CA) + (size_t)(it0 + jj) * D + c), cb = *(const f32x2*)(WSP(float, WS_CB) + (size_t)(it0 + jj) * D + c);
                        h0 = ca[0] * h0 + cb[0]; h1 = ca[1] * h1 + cb[1]; }
#pragma unroll 8
                    for (int t = 0; t < 128; ++t) { const f32x2 av = *(const f32x2*)(A_ + (r0 + t) * D + c); const unsigned bw = *(const unsigned*)(B_ + (r0 + t) * D + c); const unsigned gv = *(const unsigned*)(GB + (r0 + t) * D + c);
                        h0 = av[0] * h0 + bflo(bw); h1 = av[1] * h1 + bfhi(bw);
                        *(unsigned*)(MIX + (r0 + t) * D + c) = pk2(bflo(gv) * h0, bfhi(gv) * h1); }
                }
            }
            PHASE_END
            PHASE_BEGIN
            { Gemm g = pg8::mk(MIX, WSP(bf16, W_ODOUT), M, 1024, 1024); StaticOrder S; S.init(M, 1024, G, bx);
              Epi E{}; E.mode = pg8::E_RES; E.base = outp; E.out = outp; E.O = XN; E.aout = WSP(float, WS_SSQ) + 3 * (size_t)M; pg8::gemm_phase(lds, g, S, E, fresh_tid(wave)); }
            PHASE_END
        }
        PHASE_BEGIN
        { Gemm g = pg8::mk(XN, WSP(bf16, W_XAQ + l * 2 * MiB), M, 1024, 1024); StaticOrder S; S.init(M, 1024, G, bx);
          Epi E{}; E.mode = pg8::E_PLAIN; E.O = WSP(bf16, WS_XQ); E.ldc = 1024; E.scale = 0.0625f * LOG2E; E.vec0 = WSP(float, WS_SSQ) + (size_t)(3 * l) * M; pg8::gemm_phase(lds, g, S, E, fresh_tid(wave)); }
        PHASE_END
        PHASE_BEGIN
        { Gemm g = pg8::mk(WSP(bf16, WS_XQ), WSP(bf16, WS_MK) + (size_t)l * 512 * D, M, 1024, 256); g.lda = 1024; g.a_pm_off = 256L * 1024; g.a_pn_off = 256;
          g.ldb = 1024; g.b_pn_off = 256; g.b_pm_div = 64; g.b_pm_off = 256L * 1024; StaticOrder S; S.init(M, 1024, G, bx);
          Epi E{}; E.mode = pg8::E_SOFTMAX; E.O = WSP(bf16, WS_P); E.ldc = 1024; pg8::gemm_phase(lds, g, S, E, fresh_tid(wave)); }
        PHASE_END
        PHASE_BEGIN
        { Gemm g = pg8::mk(WSP(bf16, WS_P), WSP(bf16, WS_WPP) + (size_t)l * 2 * 1024 * 1024, M, 1024, 1024); g.b_pm_div = 64; g.b_pm_off = 1024L * 1024; StaticOrder S; S.init(M, 1024, G, bx);
          Epi E{}; E.mode = pg8::E_RES; E.base = outp; E.out = outp; E.O = XN; E.aout = WSP(float, WS_SSQ) + (size_t)(3 * l + 1) * M; pg8::gemm_phase(lds, g, S, E, fresh_tid(wave)); }
        PHASE_END
        PHASE_BEGIN
        { Gemm g = pg8::mk(XN, WSP(bf16, W_FFN1 + l * 11 * MiB), M, 2 * DFF, 1024); StaticOrder S; S.init(M, 2 * DFF, G, bx);
          Epi E{}; E.mode = pg8::E_SWIGLU; E.O = WSP(bf16, WS_H); E.vec0 = WSP(float, WS_SSQ) + (size_t)(3 * l + 1) * M; pg8::gemm_phase(lds, g, S, E, fresh_tid(wave)); }
        PHASE_END
        PHASE_BEGIN
        { Gemm g = pg8::mk(WSP(bf16, WS_H), WSP(bf16, W_FFN2) + (size_t)l * (1024 * DFF), M, 1024, DFF); StaticOrder S; S.init(M, 1024, G, bx);
          Epi E{}; E.mode = pg8::E_RES; E.base = outp; E.out = outp; E.O = (l == 0) ? XN : nullptr; E.aout = WSP(float, WS_SSQ) + (size_t)(l == 0 ? 2 : 5) * M; pg8::gemm_phase(lds, g, S, E, fresh_tid(wave)); }
        PHASE_END
    }

    PHASE_BEGIN
    {
        const f32x4* gr = (const f32x4*)a.final_norm + lane; const float* ssq = WSP(float, WS_SSQ) + 5 * (size_t)M;
        for (int m = gw; m < M; m += NGW) { f32x4* xr = (f32x4*)(outp + (size_t)m * D) + lane; const float rstd = rsqrtf(ssq[m] * (1.f / D) + RMS_EPS);
#pragma unroll
            for (int j = 0; j < 4; ++j) xr[64 * j] = xr[64 * j] * rstd * gr[64 * j]; }
    }
    PHASE_END
    }
}
#undef a
constexpr int N_PHASES = 6 + 6 + 10 + 1;

#ifndef MK_N_LAUNCHES
#define MK_N_LAUNCHES 1
#endif
extern "C" void kernel_launch(void* const* d_in, const int* in_sizes, int n_in, void* d_out, int out_size, void* d_ws, size_t ws_size, hipStream_t stream) {
    static int grid = 0;
    if (grid == 0) {
        if (n_in != 31 || ws_size < WS_NEED) { fprintf(stderr, "kernel_launch: unexpected n_in %d or ws_size %zu\n", n_in, ws_size); grid = -1; return; }
        int dev = 0, cus = 0, per_cu = 0;
        hipGetDevice(&dev); hipDeviceGetAttribute(&cus, hipDeviceAttributeMultiprocessorCount, dev);
        if (hipFuncSetAttribute((const void*)hybrid_fwd, hipFuncAttributeMaxDynamicSharedMemorySize, LDS_BYTES) != hipSuccess) { fprintf(stderr, "kernel_launch: hipFuncSetAttribute failed\n"); grid = -1; return; }
        hipOccupancyMaxActiveBlocksPerMultiprocessor(&per_cu, (const void*)hybrid_fwd, NTHREADS, LDS_BYTES);
        (void)hipGetLastError();
        if (per_cu < 1) per_cu = 1;
        grid = cus * 1;
        if (grid > 256) grid = 256;
    }
    if (grid < 0) return;
    Args a{};
    const float* const* f = (const float* const*)d_in;
    a.x = f[0]; a.mem = f[1]; a.pos = (const int*)d_in[2];
    a.ev_norm = f[3]; a.ev_w_in = f[4]; a.ev_pool_w = f[5]; a.ev_pool_scale = f[6]; a.ev_q_norm = f[7]; a.ev_w_q_up = f[8]; a.ev_kv_norm = f[9]; a.ev_w_kv_up = f[10]; a.ev_w_out = f[11];
    a.od_norm = f[12]; a.od_w_in = f[13]; a.od_conv_w = f[14]; a.od_conv_b = f[15]; a.od_w_rgate = f[16]; a.od_b_rgate = f[17]; a.od_w_igate = f[18]; a.od_b_igate = f[19]; a.od_lambda = f[20]; a.od_w_out = f[21];
    a.xa_norm_x = f[22]; a.xa_norm_mem = f[23]; a.xa_w_q = f[24]; a.xa_w_kv = f[25]; a.xa_w_o = f[26]; a.ffn_norm = f[27]; a.ffn_w_gate_up = f[28]; a.ffn_w_down = f[29]; a.final_norm = f[30];
    a.out = (float*)d_out; a.ws = (unsigned char*)d_ws;
#if MK_N_LAUNCHES == 1
    if (hipMemsetAsync((unsigned char*)d_ws + WS_BAR, 0, 16384, stream) != hipSuccess) { fprintf(stderr, "kernel_launch: memset failed\n"); return; }
    a.ph_lo = 0; a.ph_hi = N_PHASES;
    void* args[] = {&a};
    hipError_t e = hipLaunchCooperativeKernel((const void*)hybrid_fwd, dim3(grid), dim3(NTHREADS), args, LDS_BYTES, stream);
    if (e != hipSuccess) fprintf(stderr, "kernel_launch: cooperative launch failed: %s (grid %d)\n", hipGetErrorString(e), grid);
#else
    for (int p = 0; p < N_PHASES; ++p) { a.ph_lo = p; a.ph_hi = p + 1; hipLaunchKernelGGL(hybrid_fwd, dim3(grid), dim3(NTHREADS), LDS_BYTES, stream, a); }
#endif
}
```

```cpp
#include <hip/hip_runtime.h>
#include <hip/hip_cooperative_groups.h>
#include <cstdio>
#include <cstdint>
namespace cg = cooperative_groups;

#define LAS __attribute__((address_space(3)))
typedef unsigned short bf16;
typedef short bf16x8 __attribute__((ext_vector_type(8)));
typedef short s16x4 __attribute__((ext_vector_type(4)));
typedef float f32x4 __attribute__((ext_vector_type(4)));
typedef float f32x2 __attribute__((ext_vector_type(2)));
typedef float f32x16 __attribute__((ext_vector_type(16)));
typedef unsigned u32x4 __attribute__((ext_vector_type(4)));
typedef unsigned u32x2 __attribute__((ext_vector_type(2)));

constexpr int SEQ = 16384, BATCH = 2, M = BATCH * SEQ, D = 1024;
constexpr int DFF = 2816;
constexpr float RMS_EPS = 1e-6f;
constexpr float LOG2E = 1.4426950408889634f;
constexpr int NTHREADS = 512, NWAVES = 8;
constexpr int RING_BYTES = 131072, LDS_BYTES = 147456, EPI_OFF = RING_BYTES;

typedef __bf16 bf16x2_t __attribute__((ext_vector_type(2)));
__device__ __forceinline__ unsigned pk2(float lo, float hi) { f32x2 v = {lo, hi}; bf16x2_t b = __builtin_convertvector(v, bf16x2_t); return __builtin_bit_cast(unsigned, b); }
__device__ __forceinline__ float bflo(unsigned w) { return __uint_as_float(w << 16); }
__device__ __forceinline__ float bfhi(unsigned w) { return __uint_as_float(w & 0xffff0000u); }
__device__ __forceinline__ float ex2(float x) { return __builtin_amdgcn_exp2f(x); }
__device__ __forceinline__ float rcp(float x) { return __builtin_amdgcn_rcpf(x); }
__device__ __forceinline__ float sigmoidf_(float x) { return rcp(1.0f + ex2(-x * LOG2E)); }
__device__ __forceinline__ float gelu_tanh(float x) { const float u = 0.7978845608028654f * (x + 0.044715f * x * x * x); return x * sigmoidf_(2.0f * u); }
__device__ __forceinline__ float wave_sum(float v) {
#pragma unroll
    for (int o = 1; o < 64; o <<= 1) v += __shfl_xor(v, o);
    return v;
}
#define LDS_WAIT() asm volatile("s_waitcnt lgkmcnt(0)" ::: "memory")

namespace pg8 {
constexpr int BM = 256, BK = 64, HALF = 128, HTB = HALF * BK * 2, NXCD = 8, WGM = 4;
__host__ __device__ __forceinline__ int lds_byte(int r, int c) { const int st = (r >> 4) * 2 + (c >> 5), rr = r & 15, cc = c & 31, ob = rr * 64 + cc * 2; return st * 1024 + (ob ^ (((ob >> 9) & 1) << 5)); }
__host__ __device__ __forceinline__ void stage_rc(int b, int& R, int& C) { const int st = b / 1024, sb = b % 1024, swz = sb ^ (((sb >> 9) & 1) << 5); R = (st >> 1) * 16 + swz / 64; C = (st & 1) * 32 + (swz % 64) / 2; }
struct Unit { int pm, pn; };
struct Gemm { const bf16* A; const bf16* Bt; int Mr, N, K, lda, ldb; long a_pm_off, a_pn_off; int a_pn_shift; long b_pn_off; int b_pm_div; long b_pm_off; };
__device__ __forceinline__ Gemm mk(const bf16* A, const bf16* Bt, int Mr, int N, int K) {
    Gemm g; g.A = A; g.Bt = Bt; g.Mr = Mr; g.N = N; g.K = K; g.lda = K; g.ldb = K; g.a_pm_off = 256L * K; g.a_pn_off = 0; g.a_pn_shift = 0; g.b_pn_off = 256L * K; g.b_pm_div = 1 << 30; g.b_pm_off = 0; return g; }
struct StaticOrder {
    int nM, nN, nwg, G, c;
    __device__ void init(int Mr, int N, int G_, int c_) { nM = Mr / BM; nN = N / BM; nwg = nM * nN; G = G_; c = c_; }
    __device__ bool next(int i, Unit& u) const {
        const long L = (long)i * G + c; if (L >= nwg) return false;
        int wgid = (int)L; { const int q = nwg / NXCD, r = nwg % NXCD, xcd = wgid % NXCD, off = wgid / NXCD; wgid = (xcd < r ? xcd * (q + 1) : r * (q + 1) + (xcd - r) * q) + off; }
        const int nig = WGM * nN, gid = wgid / nig, fm = gid * WGM, gsz = (nM - fm) < WGM ? (nM - fm) : WGM;
        u.pm = fm + ((wgid % nig) % gsz); u.pn = (wgid % nig) / gsz; return true;
    }
};

enum { E_PLAIN = 0, E_EVIN, E_QROPE, E_POOL, E_RES, E_SOFTMAX, E_SWIGLU, E_ODIN, E_GATE, E_VT };
struct Epi {
    int mode;
    bf16* O; int ldc; float scale;
    bf16 *O2, *O3, *O4;
    const float* base; float* out;
    const float *cosT, *sinT;
    const float *vec0, *vec1, *vec2;
    const int* pos;
    const bf16* xb; float* aout;
};
__device__ __forceinline__ void st8(bf16* p, f32x4 v0, f32x4 v1) { u32x4 w; w.x = pk2(v0[0], v0[1]); w.y = pk2(v0[2], v0[3]); w.z = pk2(v1[0], v1[1]); w.w = pk2(v1[2], v1[3]); *(u32x4*)p = w; }
__device__ __forceinline__ void st4(bf16* p, f32x4 v) { u32x2 w; w.x = pk2(v[0], v[1]); w.y = pk2(v[2], v[3]); *(u32x2*)p = w; }

__device__ __forceinline__ void run_epi(const Epi& E, f32x4 (&acc)[2][2][4][2], const Unit& u, int wr, int wc, int fr, int fq, LAS unsigned char* lds) {
    const int rowb = u.pm * BM + wr * 64 + fr, colb = u.pn * BM + wc * 32 + 4 * fq;
    const int colp = u.pn * BM + wc * 32 + 8 * fq;
    switch (E.mode) {
    case E_PLAIN: {
#pragma unroll
        for (int ai = 0; ai < 2; ++ai)
#pragma unroll
            for (int m = 0; m < 4; ++m) { const size_t row = (size_t)(rowb + ai * HALF + m * 16); bf16* rp = E.O + row * E.ldc + colp;
                float sc = E.scale; if (E.vec0) sc *= rsqrtf(E.vec0[row] * (1.f / D) + RMS_EPS);
#pragma unroll
                for (int bj = 0; bj < 2; ++bj) st8(rp + bj * HALF, acc[ai][bj][m][0] * sc, acc[ai][bj][m][1] * sc); }
    } break;
    case E_EVIN: {
        const int pn = u.pn;
#pragma unroll
        for (int ai = 0; ai < 2; ++ai)
#pragma unroll
            for (int m = 0; m < 4; ++m) { const size_t row = (size_t)(rowb + ai * HALF + m * 16);
                if (pn < 2) { bf16* rp = E.O + row * 512 + colb;
#pragma unroll
                    for (int bj = 0; bj < 2; ++bj)
#pragma unroll
                        for (int n = 0; n < 2; ++n) st4(rp + bj * HALF + n * 16, acc[ai][bj][m][n]);
                } else if (pn == 2) { bf16* rp = E.O2 + row * 256 + (colb - 512);
#pragma unroll
                    for (int bj = 0; bj < 2; ++bj)
#pragma unroll
                        for (int n = 0; n < 2; ++n) st4(rp + bj * HALF + n * 16, acc[ai][bj][m][n]);
                } else { bf16* rp = E.O3 + row * 128 + (colb - 768);
#pragma unroll
                    for (int n = 0; n < 2; ++n) st4(rp + n * 16, acc[ai][0][m][n]);
                    if (wc == 0) { const f32x4 c = *(const f32x4*)(E.cosT + row * 16 + 4 * fq), s = *(const f32x4*)(E.sinT + row * 16 + 4 * fq);
                        const f32x4 v0 = acc[ai][1][m][0], v1 = acc[ai][1][m][1];
                        st4(E.O4 + row * 32 + 4 * fq, v0 * c - v1 * s); st4(E.O4 + row * 32 + 16 + 4 * fq, v1 * c + v0 * s); }
                } }
    } break;
    case E_QROPE: {
#pragma unroll
        for (int bj = 0; bj < 2; ++bj) { const int cb = u.pn * BM + bj * HALF + wc * 32; const bool rope = (cb % 96) == 64;
#pragma unroll
            for (int ai = 0; ai < 2; ++ai)
#pragma unroll
                for (int m = 0; m < 4; ++m) { const size_t row = (size_t)(rowb + ai * HALF + m * 16); bf16* rp = E.O + row * 768 + cb + 4 * fq;
                    f32x4 v0 = acc[ai][bj][m][0] * E.scale, v1 = acc[ai][bj][m][1] * E.scale;
                    if (rope) { const f32x4 c = *(const f32x4*)(E.cosT + row * 16 + 4 * fq), s = *(const f32x4*)(E.sinT + row * 16 + 4 * fq);
                        const f32x4 o0 = v0 * c - v1 * s, o1 = v1 * c + v0 * s; v0 = o0; v1 = o1; }
                    st4(rp, v0); st4(rp + 16, v1); } }
    } break;
    case E_POOL: {
#pragma unroll
        for (int bj = 0; bj < 2; ++bj) { const int col = colp + bj * HALF; const f32x4 s0 = *(const f32x4*)(E.vec0 + col), s1 = *(const f32x4*)(E.vec0 + col + 4);
#pragma unroll
            for (int ai = 0; ai < 2; ++ai)
#pragma unroll
                for (int m = 0; m < 4; ++m) st8(E.O + (size_t)(rowb + ai * HALF + m * 16) * E.ldc + col, acc[ai][bj][m][0] * s0, acc[ai][bj][m][1] * s1); }
    } break;
    case E_RES: {
#pragma unroll
        for (int ai = 0; ai < 2; ++ai) {
            f32x4 bs[4][2][2];
#pragma unroll
            for (int m = 0; m < 4; ++m) { const size_t off = (size_t)(rowb + ai * HALF + m * 16) * D + colp;
#pragma unroll
                for (int bj = 0; bj < 2; ++bj)
#pragma unroll
                    for (int n = 0; n < 2; ++n) bs[m][bj][n] = *(const f32x4*)(E.base + off + bj * HALF + n * 4); }
#pragma unroll
            for (int m = 0; m < 4; ++m) { const size_t row = (size_t)(rowb + ai * HALF + m * 16); const size_t off = row * D + colp; float q = 0.f;
#pragma unroll
                for (int bj = 0; bj < 2; ++bj) { const f32x4 o0 = bs[m][bj][0] + acc[ai][bj][m][0], o1 = bs[m][bj][1] + acc[ai][bj][m][1];
                    *(f32x4*)(E.out + off + bj * HALF) = o0; *(f32x4*)(E.out + off + bj * HALF + 4) = o1;
                    if (E.O) st8(E.O + off + bj * HALF, o0, o1);
                    q += (o0[0] * o0[0] + o0[1] * o0[1]) + (o0[2] * o0[2] + o0[3] * o0[3]) + (o1[0] * o1[0] + o1[1] * o1[1]) + (o1[2] * o1[2] + o1[3] * o1[3]); }
                q += __shfl_xor(q, 16); q += __shfl_xor(q, 32);
                if (fq == 0) atomicAdd(E.aout + row, q); }
            asm volatile("" ::: "memory"); }
    } break;
    case E_SOFTMAX: {
        LAS float* RM = (LAS float*)(lds + EPI_OFF);
        LAS float* RS = (LAS float*)(lds + EPI_OFF + 4096);
#pragma unroll
        for (int ai = 0; ai < 2; ++ai)
#pragma unroll
            for (int m = 0; m < 4; ++m) { float mx = -3.0e38f;
                float sc = E.scale; if (E.vec0) sc *= rsqrtf(E.vec0[(size_t)(rowb + ai * HALF + m * 16)] * (1.f / D) + RMS_EPS);
#pragma unroll
                for (int bj = 0; bj < 2; ++bj)
#pragma unroll
                    for (int n = 0; n < 2; ++n) { const f32x4 x = acc[ai][bj][m][n] * sc; acc[ai][bj][m][n] = x; mx = fmaxf(mx, fmaxf(fmaxf(x[0], x[1]), fmaxf(x[2], x[3]))); }
                mx = fmaxf(mx, __shfl_xor(mx, 16)); mx = fmaxf(mx, __shfl_xor(mx, 32));
                if (fq == 0) RM[(ai * HALF + wr * 64 + m * 16 + fr) * 4 + wc] = mx; }
        LDS_WAIT(); __builtin_amdgcn_s_barrier(); asm volatile("" ::: "memory");
#pragma unroll
        for (int ai = 0; ai < 2; ++ai)
#pragma unroll
            for (int m = 0; m < 4; ++m) { const int rl = ai * HALF + wr * 64 + m * 16 + fr; const f32x4 mm = *(LAS f32x4*)(RM + rl * 4);
                const float mx = fmaxf(fmaxf(mm[0], mm[1]), fmaxf(mm[2], mm[3])); float s = 0.f;
#pragma unroll
                for (int bj = 0; bj < 2; ++bj)
#pragma unroll
                    for (int n = 0; n < 2; ++n) { f32x4 x = acc[ai][bj][m][n]; x[0] = ex2(x[0] - mx); x[1] = ex2(x[1] - mx); x[2] = ex2(x[2] - mx); x[3] = ex2(x[3] - mx); acc[ai][bj][m][n] = x; s += (x[0] + x[1]) + (x[2] + x[3]); }
                s += __shfl_xor(s, 16); s += __shfl_xor(s, 32);
                if (fq == 0) RS[rl * 4 + wc] = s; }
        LDS_WAIT(); __builtin_amdgcn_s_barrier(); asm volatile("" ::: "memory");
#pragma unroll
        for (int ai = 0; ai < 2; ++ai)
#pragma unroll
            for (int m = 0; m < 4; ++m) { const int rl = ai * HALF + wr * 64 + m * 16 + fr; const f32x4 ss = *(LAS f32x4*)(RS + rl * 4);
                const float inv = rcp((ss[0] + ss[1]) + (ss[2] + ss[3])); bf16* rp = E.O + (size_t)(u.pm * BM + rl) * E.ldc + colp;
#pragma unroll
                for (int bj = 0; bj < 2; ++bj) st8(rp + bj * HALF, acc[ai][bj][m][0] * inv, acc[ai][bj][m][1] * inv); }
    } break;
    case E_SWIGLU: {
        const int colh = u.pn * HALF + wc * 32 + 8 * fq;
#pragma unroll
        for (int ai = 0; ai < 2; ++ai)
#pragma unroll
            for (int m = 0; m < 4; ++m) { const size_t row = (size_t)(rowb + ai * HALF + m * 16); const float rs = rsqrtf(E.vec0[row] * (1.f / D) + RMS_EPS); f32x4 o[2];
#pragma unroll
                for (int n = 0; n < 2; ++n) { const f32x4 g = acc[ai][0][m][n] * rs, uu = acc[ai][1][m][n] * rs;
#pragma unroll
                    for (int e = 0; e < 4; ++e) o[n][e] = g[e] * sigmoidf_(g[e]) * uu[e]; }
                st8(E.O + row * DFF + colh, o[0], o[1]); }
    } break;
    case E_ODIN: {
        const bool isg = u.pn < 4;
#pragma unroll
        for (int ai = 0; ai < 2; ++ai)
#pragma unroll
            for (int m = 0; m < 4; ++m) { const size_t row = (size_t)(rowb + ai * HALF + m * 16); const float rs = rsqrtf(E.vec0[row] * (1.f / D) + RMS_EPS);
                bf16* rp = (isg ? E.O + row * D + colp : E.O2 + row * D + (colp - D));
#pragma unroll
                for (int bj = 0; bj < 2; ++bj) { f32x4 v0 = acc[ai][bj][m][0] * rs, v1 = acc[ai][bj][m][1] * rs;
                    if (isg) {
#pragma unroll
                        for (int e = 0; e < 4; ++e) { v0[e] = gelu_tanh(v0[e]); v1[e] = gelu_tanh(v1[e]); } }
                    st8(rp + bj * HALF, v0, v1); } }
    } break;
    case E_GATE: {
        const int c = (u.pn >> 1) * 256 + (u.pn & 1) * HALF + wc * 32 + 8 * fq;
        f32x4 br[2], bi[2], sp[2];
#pragma unroll
        for (int n = 0; n < 2; ++n) { br[n] = *(const f32x4*)(E.vec0 + c + 4 * n); bi[n] = *(const f32x4*)(E.vec1 + c + 4 * n); sp[n] = *(const f32x4*)(E.vec2 + c + 4 * n); }
#pragma unroll
        for (int ai = 0; ai < 2; ++ai)
#pragma unroll
            for (int m = 0; m < 4; ++m) { const size_t row = (size_t)(rowb + ai * HALF + m * 16); const bool rst = E.pos[row] == 0;
                const u32x4 xw = *(const u32x4*)(E.xb + row * D + c); const float xv[8] = {bflo(xw.x), bfhi(xw.x), bflo(xw.y), bfhi(xw.y), bflo(xw.z), bfhi(xw.z), bflo(xw.w), bfhi(xw.w)};
                f32x4 av[2], bv[2];
#pragma unroll
                for (int n = 0; n < 2; ++n) { const f32x4 pr = acc[ai][0][m][n] + br[n], pi = acc[ai][1][m][n] + bi[n];
#pragma unroll
                    for (int e = 0; e < 4; ++e) { const float r = sigmoidf_(pr[e]), ig = sigmoidf_(pi[e]); const float la = -sp[n][e] * r; float a = ex2(la * LOG2E);
                        const float x2 = 2.0f * la; const float om = (x2 > -0.01f) ? -(x2 + x2 * x2 * (0.5f + x2 * (1.0f / 6.0f))) : 1.0f - ex2(x2 * LOG2E);
                        float mult = sqrtf(fmaxf(om, 0.f)); if (rst) { a = 0.f; mult = 1.f; }
                        av[n][e] = a; bv[n][e] = mult * (ig * xv[4 * n + e]); } }
                *(f32x4*)(E.aout + row * D + c) = av[0]; *(f32x4*)(E.aout + row * D + c + 4) = av[1]; st8(E.O + row * D + c, bv[0], bv[1]); }
    } break;
    case E_VT: {
#pragma unroll
        for (int ai = 0; ai < 2; ++ai)
#pragma unroll
            for (int m = 0; m < 4; ++m) { const size_t row = (size_t)(rowb + ai * HALF + m * 16);
#pragma unroll
                for (int bj = 0; bj < 2; ++bj) { const int col = colp + bj * HALF, b16 = col & ~15, hf = (col >> 3) & 1; bf16* rp = E.O + row * E.ldc + b16 + 4 * hf;
                    st4(rp, acc[ai][bj][m][0]); st4(rp + 8, acc[ai][bj][m][1]); } }
    } break;
    default: break;
    }
}

__device__ __forceinline__ void gemm_phase(LAS unsigned char* lds, const Gemm g, const StaticOrder& S, const Epi& E, const int tid) {
    const int wid = __builtin_amdgcn_readfirstlane(tid >> 6), lane = tid & 63, wr = wid >> 2, wc = wid & 3, fr = lane & 15, fq = lane >> 4;
    const int K = g.K, nt = K / BK;
    unsigned voffA, voffB;
    { int R, C; stage_rc(tid * 16, R, C); const bool perm = (E.mode != E_EVIN) && (E.mode != E_QROPE);
      const int rho = R & 31, Rb = perm ? ((R & ~31) + 8 * ((rho & 15) >> 2) + 4 * (rho >> 4) + (rho & 3)) : R;
      voffA = (unsigned)(R * g.lda + C) * 2u; voffB = (unsigned)(Rb * g.ldb + C) * 2u; }
    const size_t q64A = (size_t)64 * g.lda * 2, q64B = (size_t)64 * g.ldb * 2;
    const size_t kstep = (size_t)(BK * 2);
    const size_t hstepA = (size_t)HALF * g.lda * 2, hstepB = (size_t)HALF * g.ldb * 2;
    const unsigned ldsw = (unsigned)wid * 1024u;
    const int aoff = lds_byte(wr * 64 + fr, fq * 8), boff = lds_byte(wc * 32 + fr, fq * 8);
#define PG8_ABASE(u) ((const char*)g.A + ((size_t)(u).pm * g.a_pm_off + (size_t)((u).pn >> g.a_pn_shift) * g.a_pn_off) * 2)
#define PG8_BBASE(u) ((const char*)g.Bt + ((size_t)(u).pn * g.b_pn_off + (size_t)((u).pm / g.b_pm_div) * g.b_pm_off) * 2)
#define PG8_SA(b, h) (((b) * 2 + (h)) * HTB)
#define PG8_SB(b, h) ((4 + (b) * 2 + (h)) * HTB)
#define PG8_Q64(v) PG8_Q64_##v
#define PG8_Q64_voffA q64A
#define PG8_Q64_voffB q64B
#define PG8_STAGE(bufoff, gbase, voff) do { \
        __builtin_amdgcn_global_load_lds((const unsigned*)((const char*)(gbase) + (voff)), (LAS unsigned*)(lds + (bufoff) + ldsw), 16, 0, 0); \
        __builtin_amdgcn_global_load_lds((const unsigned*)((const char*)(gbase) + PG8_Q64(voff) + (voff)), (LAS unsigned*)(lds + (bufoff) + ldsw + 8192), 16, 0, 0); } while (0)
#define PG8_LDA(dst, b, h) do { _Pragma("unroll") for (int m = 0; m < 4; ++m) _Pragma("unroll") for (int k = 0; k < 2; ++k) dst[m][k] = *(const LAS bf16x8*)(lds + PG8_SA(b, h) + aoff + m * 2048 + k * 1024); } while (0)
#define PG8_LDB(dst, b, h) do { _Pragma("unroll") for (int n = 0; n < 2; ++n) _Pragma("unroll") for (int k = 0; k < 2; ++k) dst[n][k] = *(const LAS bf16x8*)(lds + PG8_SB(b, h) + boff + n * 2048 + k * 1024); } while (0)
#define PG8_MMA(ai, bj, At, Bt) do { __builtin_amdgcn_s_setprio(1); _Pragma("unroll") for (int m = 0; m < 4; ++m) _Pragma("unroll") for (int n = 0; n < 2; ++n) _Pragma("unroll") for (int k = 0; k < 2; ++k) \
        acc[ai][bj][m][n] = __builtin_amdgcn_mfma_f32_16x16x32_bf16(Bt[n][k], At[m][k], acc[ai][bj][m][n], 0, 0, 0); __builtin_amdgcn_s_setprio(0); } while (0)
#define PG8_WAIT_V(n) asm volatile("s_waitcnt vmcnt(" #n ")" ::: "memory")
#define PG8_WAIT_L(n) asm volatile("s_waitcnt lgkmcnt(" #n ")" ::: "memory")
#define PG8_BAR __builtin_amdgcn_s_barrier()
#define PG8_SCHED __builtin_amdgcn_sched_barrier(0)
    Unit cur, nxt; int ui = 0;
    if (!S.next(0, cur)) return;
    f32x4 acc[2][2][4][2];
#pragma unroll
    for (int a = 0; a < 2; ++a)
#pragma unroll
        for (int b = 0; b < 2; ++b)
#pragma unroll
            for (int m = 0; m < 4; ++m)
#pragma unroll
                for (int n = 0; n < 2; ++n) acc[a][b][m][n] = (f32x4){0.f, 0.f, 0.f, 0.f};
    bf16x8 At[4][2], B0[2][2], B1[2][2];
    const char* cA = PG8_ABASE(cur); const char* cB = PG8_BBASE(cur);
    PG8_STAGE(PG8_SB(0, 0), cB, voffB); PG8_STAGE(PG8_SB(0, 1), cB + hstepB, voffB); PG8_STAGE(PG8_SA(0, 0), cA, voffA); PG8_STAGE(PG8_SA(0, 1), cA + hstepA, voffA);
    if (wr == 1) PG8_BAR;
    PG8_WAIT_V(2); PG8_BAR;
    PG8_STAGE(PG8_SB(1, 0), cB + kstep, voffB); PG8_STAGE(PG8_SA(1, 0), cA + kstep, voffA); PG8_STAGE(PG8_SB(1, 1), cB + hstepB + kstep, voffB);
    PG8_WAIT_V(6); PG8_BAR;
    for (;;) {
        const bool has_next = S.next(ui + 1, nxt);
        const char* nA = has_next ? PG8_ABASE(nxt) : cA; const char* nB = has_next ? PG8_BBASE(nxt) : cB;
        for (int t = 0; t < nt; t += 2) {
            const bool last = (t == nt - 2);
            const char* a1 = cA + (size_t)(t + 1) * kstep;
            const char* a2 = last ? nA : cA + (size_t)(t + 2) * kstep; const char* b2 = last ? nB : cB + (size_t)(t + 2) * kstep;
            const char* a3 = a2 + kstep; const char* b3 = b2 + kstep;
            PG8_LDB(B0, 0, 0); PG8_LDB(B1, 0, 1); PG8_SCHED; PG8_LDA(At, 0, 0); PG8_STAGE(PG8_SA(1, 1), a1 + hstepA, voffA);
            PG8_WAIT_V(8); PG8_WAIT_L(0); PG8_BAR; PG8_MMA(0, 0, At, B0); PG8_MMA(0, 1, At, B1); PG8_BAR; PG8_SCHED;
            PG8_LDA(At, 0, 1); PG8_STAGE(PG8_SB(0, 0), b2, voffB); PG8_STAGE(PG8_SB(0, 1), b2 + hstepB, voffB); PG8_STAGE(PG8_SA(0, 0), a2, voffA);
            PG8_WAIT_V(8); PG8_WAIT_L(0); PG8_BAR; PG8_MMA(1, 0, At, B0); PG8_MMA(1, 1, At, B1); PG8_BAR; PG8_SCHED;
            PG8_LDB(B0, 1, 0); PG8_LDB(B1, 1, 1); PG8_SCHED; PG8_LDA(At, 1, 0); PG8_STAGE(PG8_SA(0, 1), a2 + hstepA, voffA);
            PG8_WAIT_V(8); PG8_WAIT_L(0); PG8_BAR; PG8_MMA(0, 0, At, B0); PG8_MMA(0, 1, At, B1); PG8_BAR; PG8_SCHED;
            PG8_LDA(At, 1, 1); PG8_STAGE(PG8_SB(1, 0), b3, voffB); PG8_STAGE(PG8_SB(1, 1), b3 + hstepB, voffB); PG8_STAGE(PG8_SA(1, 0), a3, voffA);
            PG8_WAIT_V(8); PG8_WAIT_L(0); PG8_BAR; PG8_MMA(1, 0, At, B0); PG8_MMA(1, 1, At, B1); PG8_BAR; PG8_SCHED;
        }
        if (wr == 0) PG8_BAR;
        run_epi(E, acc, cur, wr, wc, fr, fq, lds);
        if (!has_next) break;
#pragma unroll
        for (int a = 0; a < 2; ++a)
#pragma unroll
            for (int b = 0; b < 2; ++b)
#pragma unroll
                for (int m = 0; m < 4; ++m)
#pragma unroll
                    for (int n = 0; n < 2; ++n) acc[a][b][m][n] = (f32x4){0.f, 0.f, 0.f, 0.f};
        cur = nxt; cA = nA; cB = nB; ++ui;
        if (wr == 1) PG8_BAR;
    }
    PG8_WAIT_V(0);
    PG8_BAR;
#undef PG8_ABASE
#undef PG8_BBASE
#undef PG8_SA
#undef PG8_SB
#undef PG8_STAGE
#undef PG8_Q64
#undef PG8_Q64_voffA
#undef PG8_Q64_voffB
#undef PG8_LDA
#undef PG8_LDB
#undef PG8_MMA
#undef PG8_WAIT_V
#undef PG8_WAIT_L
#undef PG8_BAR
#undef PG8_SCHED
}
}

namespace att {
#define ATT_BAR() do { asm volatile("s_waitcnt lgkmcnt(0)" ::: "memory"); __builtin_amdgcn_s_barrier(); asm volatile("" ::: "memory"); } while (0)
constexpr int KST_B = 208  , VST_B = 144  ;
constexpr int KBYTES = 64 * KST_B, VBYTES = 64 * VST_B, BUFB = KBYTES + VBYTES;
__device__ __forceinline__ int crow(int r, int hi) { return (r & 3) + 8 * (r >> 2) + 4 * hi; }
constexpr int NSLOT = 4, NPIECE = 22;
__device__ __forceinline__ void attn_unit(int b, int h, int qb, const bf16* Q, const bf16* KN, const bf16* KR, const bf16* VT, bf16* OUT, LAS unsigned char* lds, const int tid) {
    const int lane = tid & 63, r32 = lane & 31, hi = lane >> 5, wid = __builtin_amdgcn_readfirstlane(tid >> 6);
    const size_t rowbase = (size_t)b * SEQ; const int q0 = qb * 256; const int qrow = q0 + wid * 32 + r32;
    const int NT = (q0 + 256) / 64;
    const char* gp[3]; unsigned ginc[3];
#pragma unroll
    for (int i = 0; i < 3; ++i) { const int p = wid + 8 * i;
        if (p < 13) { const int c = p * 64 + lane, row = c / 13, c16 = c % 13;
            if (c16 >= 8 && c16 < 12) { gp[i] = (const char*)(KR + (rowbase + row) * 32 + (c16 - 8) * 8); ginc[i] = 64 * 32 * 2; }
            else { gp[i] = (const char*)(KN + (rowbase + row) * 512 + h * 64 + (c16 < 8 ? c16 : 0) * 8); ginc[i] = 64 * 512 * 2; } }
        else { const int c = ((p < NPIECE ? p : 13) - 13) * 64 + lane, d = c / 9, c16 = c % 9;
            gp[i] = (const char*)(VT + (size_t)(h * 64 + d) * M + rowbase + (c16 < 8 ? c16 : 0) * 8); ginc[i] = 64 * 2; } }
#define ATT_DMA(t) do { LAS unsigned char* sl_ = lds + ((t) & (NSLOT - 1)) * BUFB + wid * 1024; \
        __builtin_amdgcn_global_load_lds((const unsigned*)(gp[0] + (size_t)(t) * ginc[0]), (LAS unsigned*)(sl_), 16, 0, 0); \
        __builtin_amdgcn_global_load_lds((const unsigned*)(gp[1] + (size_t)(t) * ginc[1]), (LAS unsigned*)(sl_ + 8192), 16, 0, 0); \
        if (wid < NPIECE - 16) __builtin_amdgcn_global_load_lds((const unsigned*)(gp[2] + (size_t)(t) * ginc[2]), (LAS unsigned*)(sl_ + 16384), 16, 0, 0); } while (0)
    bf16x8 qr[6];
    { const bf16* qp = Q + (rowbase + qrow) * 768 + h * 96 + hi * 8;
#pragma unroll
      for (int ks = 0; ks < 6; ++ks) qr[ks] = *(const bf16x8*)(qp + ks * 16); }
    asm volatile("s_waitcnt vmcnt(0)" ::: "memory");
    ATT_DMA(0); ATT_DMA(1); ATT_DMA(2);
    f32x16 o0, o1;
#pragma unroll
    for (int r = 0; r < 16; ++r) { o0[r] = 0.f; o1[r] = 0.f; }
    float mrun = 0.f, lrun = 0.f;
    f32x16 negm;
#pragma unroll
    for (int r = 0; r < 16; ++r) negm[r] = 0.f;
    const int qmin = q0 + wid * 32;
    asm volatile("s_waitcnt vmcnt(4)" ::: "memory");
    ATT_BAR();
    if (wid >= 4) ATT_BAR();
#pragma unroll 1
    for (int t = 0; t < NT; ++t) {
        if (t + 3 < NT) ATT_DMA(t + 3);
        const int kv0 = t * 64;
        const bool active = kv0 <= qmin + 31;
        bf16x8 vf0[4], vf1[4]; f32x16 p0, p1;
        if (active) {
            const LAS unsigned char* buf = lds + (t & (NSLOT - 1)) * BUFB;
            const LAS unsigned char* kb = buf + r32 * KST_B + hi * 16;
            const LAS unsigned char* vb = buf + KBYTES + r32 * VST_B + hi * 16;
#pragma unroll
            for (int s = 0; s < 4; ++s) { vf0[s] = *(const LAS bf16x8*)(vb + s * 32); vf1[s] = *(const LAS bf16x8*)(vb + 32 * VST_B + s * 32); }
            __builtin_amdgcn_sched_barrier(0);
#pragma unroll
            for (int ks = 0; ks < 6; ++ks) { const bf16x8 a0 = *(const LAS bf16x8*)(kb + ks * 32), a1 = *(const LAS bf16x8*)(kb + 32 * KST_B + ks * 32);
                if (ks == 0) { p0 = __builtin_amdgcn_mfma_f32_32x32x16_bf16(a0, qr[0], negm, 0, 0, 0); p1 = __builtin_amdgcn_mfma_f32_32x32x16_bf16(a1, qr[0], negm, 0, 0, 0); }
                else { p0 = __builtin_amdgcn_mfma_f32_32x32x16_bf16(a0, qr[ks], p0, 0, 0, 0); p1 = __builtin_amdgcn_mfma_f32_32x32x16_bf16(a1, qr[ks], p1, 0, 0, 0); } }
        }
        if (t + 3 < NT) asm volatile("s_waitcnt vmcnt(4)" ::: "memory");
        else asm volatile("s_waitcnt vmcnt(0)" ::: "memory");
        ATT_BAR();
        if (active) {
            if (kv0 + 63 > qmin) {
#pragma unroll
                for (int r = 0; r < 16; ++r) { const int kv = kv0 + crow(r, hi); if (kv > qrow) p0[r] = -1e30f; if (kv + 32 > qrow) p1[r] = -1e30f; }
            }
            float mx = __builtin_amdgcn_fmed3f(p0[0], p1[0], __builtin_inff());
#pragma unroll
            for (int r = 1; r < 16; ++r) { mx = __builtin_amdgcn_fmed3f(mx, p0[r], __builtin_inff()); mx = __builtin_amdgcn_fmed3f(mx, p1[r], __builtin_inff()); }
            { auto rr = __builtin_amdgcn_permlane32_swap(__float_as_uint(mx), __float_as_uint(mx), false, false); mx = fmaxf(__uint_as_float(rr[0]), __uint_as_float(rr[1])); }
            const bool first = (t == 0);
            if (first || __builtin_amdgcn_ballot_w64(mx > 0.f) != 0ull) {
                const float d = first ? mx : fmaxf(mx, 0.f); mrun += d;
                if (!first) { const float alpha = ex2(-d); lrun *= alpha;
#pragma unroll
                    for (int r = 0; r < 16; ++r) { o0[r] *= alpha; o1[r] *= alpha; } }
#pragma unroll
                for (int r = 0; r < 16; ++r) { p0[r] -= d; p1[r] -= d; negm[r] = -mrun; }
            }
            float rs0 = 0.f, rs1 = 0.f;
#pragma unroll
            for (int r = 0; r < 16; ++r) { p0[r] = ex2(p0[r]); p1[r] = ex2(p1[r]); rs0 += p0[r]; asm volatile("" : "+v"(rs0)); rs1 += p1[r]; asm volatile("" : "+v"(rs1)); }
            lrun += rs0 + rs1;
            u32x4 pw[4];
#pragma unroll
            for (int j = 0; j < 4; ++j) { pw[0][j] = pk2(p0[2 * j], p0[2 * j + 1]); pw[1][j] = pk2(p0[8 + 2 * j], p0[8 + 2 * j + 1]); pw[2][j] = pk2(p1[2 * j], p1[2 * j + 1]); pw[3][j] = pk2(p1[8 + 2 * j], p1[8 + 2 * j + 1]); }
#pragma unroll
            for (int s = 0; s < 4; ++s) { const bf16x8 pf = __builtin_bit_cast(bf16x8, pw[s]);
                o0 = __builtin_amdgcn_mfma_f32_32x32x16_bf16(vf0[s], pf, o0, 0, 0, 0); o1 = __builtin_amdgcn_mfma_f32_32x32x16_bf16(vf1[s], pf, o1, 0, 0, 0); }
        }
        ATT_BAR();
    }
    if (wid < 4) ATT_BAR();
#undef ATT_DMA
    float ltot; { auto rr = __builtin_amdgcn_permlane32_swap(__float_as_uint(lrun), __float_as_uint(lrun), false, false); ltot = __uint_as_float(rr[0]) + __uint_as_float(rr[1]); }
    const float inv = rcp(ltot);
    bf16* op = OUT + (rowbase + qrow) * 1024 + h * 64 + 4 * hi;
#pragma unroll
    for (int g = 0; g < 4; ++g) {
        u32x2 w0, w1; w0.x = pk2(o0[4 * g] * inv, o0[4 * g + 1] * inv); w0.y = pk2(o0[4 * g + 2] * inv, o0[4 * g + 3] * inv);
        w1.x = pk2(o1[4 * g] * inv, o1[4 * g + 1] * inv); w1.y = pk2(o1[4 * g + 2] * inv, o1[4 * g + 3] * inv);
        *(u32x2*)(op + 8 * g) = w0; *(u32x2*)(op + 32 + 8 * g) = w1; }
    asm volatile("s_waitcnt vmcnt(0)" ::: "memory");
}
}

constexpr size_t MiB = 1u << 20;
constexpr size_t WS_BAR = 32 * 1024;
constexpr size_t WS_SP8 = 0;
constexpr size_t WS_CA = 64 * 1024, WS_CB = WS_CA + 256 * 1024 * 4;
constexpr size_t WS_SSQ = 2 * MiB + 128 * 1024;
constexpr size_t WS_COS = 3 * MiB, WS_SIN = 5 * MiB;
constexpr size_t WS_MN = 7 * MiB;
constexpr size_t WS_MK = 9 * MiB;
constexpr size_t WS_MVT = 11 * MiB;
constexpr size_t WS_W = 13 * MiB;
constexpr size_t W_EVIN = WS_W, W_POOL = W_EVIN + 2 * MiB, W_QUP = W_POOL + MiB, W_KN = W_QUP + MiB, W_V = W_KN + MiB / 4, W_EVOUT = W_KN + MiB;
constexpr size_t W_ODIN = W_EVOUT + 2 * MiB, W_GATE = W_ODIN + 4 * MiB, W_ODOUT = W_GATE + MiB, W_XAQ = W_ODOUT + 2 * MiB  , W_XAKV = W_XAQ + 4 * MiB  ;
constexpr size_t W_XAO = W_XAKV + 8 * MiB  , W_FFN1 = W_XAO + 4 * MiB  , W_FFN2 = W_FFN1 + 22 * MiB  , W_END = W_FFN2 + 11 * MiB;
static_assert(W_END <= 80 * MiB, "weights");
constexpr size_t WS_XN = 80 * MiB;
constexpr size_t WS_MIX = 144 * MiB;
constexpr size_t WS_H = 208 * MiB;
constexpr size_t WS_U = 208 * MiB, WS_CQ = 240 * MiB, WS_CKV = 256 * MiB, WS_KR = 264 * MiB, WS_POOLED = 266 * MiB, WS_CQN = 298 * MiB, WS_CKVN = 314 * MiB, WS_Q = 322 * MiB;
constexpr size_t WS_KN = 384 * MiB, WS_VT = 416 * MiB;
constexpr size_t WS_XQ = 208 * MiB, WS_P = 272 * MiB;
constexpr size_t WS_GB = 208 * MiB, WS_XBP = 272 * MiB, WS_B = 272 * MiB, WS_A = 336 * MiB;
constexpr size_t WS_WPP = 470 * MiB;
constexpr size_t WS_WQK = 478 * MiB;
constexpr size_t WS_NEED = 488 * MiB;

struct Args {
    const float* x; const float* mem; const int* pos;
    const float *ev_norm, *ev_w_in, *ev_pool_w, *ev_pool_scale, *ev_q_norm, *ev_w_q_up, *ev_kv_norm, *ev_w_kv_up, *ev_w_out;
    const float *od_norm, *od_w_in, *od_conv_w, *od_conv_b, *od_w_rgate, *od_b_rgate, *od_w_igate, *od_b_igate, *od_lambda, *od_w_out;
    const float *xa_norm_x, *xa_norm_mem, *xa_w_q, *xa_w_kv, *xa_w_o, *ffn_norm, *ffn_w_gate_up, *ffn_w_down, *final_norm;
    float* out; unsigned char* ws; int ph_lo, ph_hi;
};

__device__ __forceinline__ void tr_item(const float* W, int ldw, int k0, int n0, bf16* dst, int ldd, LAS float* scr, int lane, const float* kg) {
#pragma unroll
    for (int i = 0; i < 32; ++i) { const int kk = 2 * i + (lane >> 5); float w = W[(size_t)(k0 + kk) * ldw + n0 + (lane & 31)]; if (kg) w *= kg[k0 + kk]; scr[kk * 33 + (lane & 31)] = w; }
    LDS_WAIT(); asm volatile("" ::: "memory");
    const int c = lane & 7;
#pragma unroll
    for (int j = 0; j < 4; ++j) { const int n = (lane >> 3) + 8 * j; const LAS float* s = scr + (8 * c) * 33 + n;
        u32x4 o; o.x = pk2(s[0 * 33], s[1 * 33]); o.y = pk2(s[2 * 33], s[3 * 33]); o.z = pk2(s[4 * 33], s[5 * 33]); o.w = pk2(s[6 * 33], s[7 * 33]);
        *(u32x4*)(dst + (size_t)n * ldd + k0 + 8 * c) = o; }
    LDS_WAIT(); asm volatile("" ::: "memory");
}
template <class RM> __device__ __forceinline__ void tr_matrix(const float* W, int K, int N, int ldd, RM rowptr, LAS float* scr, int gw, int NGW, int lane, int& rot, const float* kg = nullptr) {
    const int nblk = N / 32, nit = (K / 64) * nblk;
    int start = (gw - (rot % NGW) + NGW) % NGW;
    for (int it = start; it < nit; it += NGW) { const int kb = it / nblk, nb = it % nblk; tr_item(W, N, 64 * kb, 32 * nb, rowptr(32 * nb), ldd, scr, lane, kg); }
    rot += nit;
}
__device__ __forceinline__ void rms_row_bf16(const float* xrow, const float* g, bf16* orow, int lane) {
    const f32x4* xr = (const f32x4*)xrow + lane; const f32x4* gr = (const f32x4*)g + lane;
    f32x4 v[4]; float s = 0.f;
#pragma unroll
    for (int j = 0; j < 4; ++j) { v[j] = xr[64 * j]; s += (v[j][0] * v[j][0] + v[j][1] * v[j][1]) + (v[j][2] * v[j][2] + v[j][3] * v[j][3]); }
    const float rstd = rsqrtf(wave_sum(s) * (1.f / D) + RMS_EPS);
#pragma unroll
    for (int j = 0; j < 4; ++j) { const f32x4 o = v[j] * rstd * gr[64 * j]; u32x2 w; w.x = pk2(o[0], o[1]); w.y = pk2(o[2], o[3]); *(u32x2*)(orow + 4 * lane + 256 * j) = w; }
}
__device__ __forceinline__ void norm_pass(const float* X, const float* g, bf16* XN, int gw, int NGW, int lane) {
    for (int m = gw; m < M; m += NGW) rms_row_bf16(X + (size_t)m * D, g, XN + (size_t)m * D, lane);
}

__device__ __forceinline__ int fresh_tid(int wave) { int l; asm volatile("v_mbcnt_lo_u32_b32 %0, -1, 0\n\tv_mbcnt_hi_u32_b32 %0, -1, %0" : "=v"(l)); return wave * 64 + l; }
#define XB_TMO      128
#define XB_XCNT(j)  (256  + 64 * (j))
#define XB_XSUB(j)  (1280 + 64 * (j))
#define XB_XGEN(j)  (2304 + 64 * (j))
#define XB_TOP      3328
#define XB_TOPGEN   3392
#define XCD_BAR_WORDS 3456
#define XB_SPIN_CAP (1u << 18)
__device__ __forceinline__ unsigned xb_ld(unsigned* p)              { return __hip_atomic_load(p, __ATOMIC_RELAXED, __HIP_MEMORY_SCOPE_AGENT); }
__device__ __forceinline__ unsigned xb_add(unsigned* p, unsigned v) { return __hip_atomic_fetch_add(p, v, __ATOMIC_RELAXED, __HIP_MEMORY_SCOPE_AGENT); }
__device__ __forceinline__ unsigned xb_xcc_id() { return (unsigned)__builtin_amdgcn_s_getreg((3 << 11) | 20) & 0xFu; }
#define XB_SPIN(cond, bar) do { unsigned _sp = 0; while (cond) { __builtin_amdgcn_s_sleep(1); \
    if ((++_sp & 255u) == 0u) { if (xb_ld(&(bar)[XB_TMO])) break; if (_sp > XB_SPIN_CAP) { atomicAdd(&(bar)[XB_TMO], 1u); break; } } } } while (0)
__device__ __forceinline__ void xcd_barrier_complete(unsigned* bar, unsigned x, unsigned G, unsigned& nloc, unsigned& nx) {
    unsigned sum, cnt, mine, sp = 0u;
    for (;;) {
        sum = 0u; cnt = 0u; mine = 0u;
#pragma unroll
        for (unsigned j = 0; j < 16; ++j) { const unsigned c = xb_ld(&bar[XB_XCNT(j)]); sum += c; cnt += (c > 0u) ? 1u : 0u; mine = (j == x) ? c : mine; }
        if (sum == G) break;
        __builtin_amdgcn_s_sleep(1);
        if ((++sp & 255u) == 0u) { if (xb_ld(&bar[XB_TMO])) break; if (sp > XB_SPIN_CAP) { atomicAdd(&bar[XB_TMO], 1u); break; } }
    }
    nloc = mine > 0u ? mine : 1u; nx = cnt > 0u ? cnt : 1u;
}
__device__ __forceinline__ void xcd_barrier(unsigned* bar, unsigned x, volatile LAS unsigned* st, unsigned G, int tid) {
    asm volatile("s_waitcnt vmcnt(0)" ::: "memory");
    __syncthreads();
    if (tid == 0) {
        __builtin_amdgcn_s_waitcnt(0);
        unsigned nloc = st[0], nx = st[1];
        if (nloc == 0u) { xcd_barrier_complete(bar, x, G, nloc, nx); st[0] = nloc; st[1] = nx; }
        const unsigned old = xb_add(&bar[XB_XSUB(x)], 1u);
        const unsigned gen = old / nloc;
        if (old + 1u == (gen + 1u) * nloc) {
            __builtin_amdgcn_fence(__ATOMIC_RELEASE, "agent");
            asm volatile("s_waitcnt vmcnt(0)" ::: "memory");
            const unsigned og = xb_add(&bar[XB_TOP], 1u);
            const unsigned tg = og / nx;
            if (og + 1u == (tg + 1u) * nx) xb_add(&bar[XB_TOPGEN], 1u);
            else XB_SPIN(xb_ld(&bar[XB_TOPGEN]) == tg, bar);
            __builtin_amdgcn_fence(__ATOMIC_ACQUIRE, "agent");
            xb_add(&bar[XB_XGEN(x)], 1u);
            asm volatile("s_waitcnt vmcnt(0)" ::: "memory");
        } else {
            XB_SPIN(xb_ld(&bar[XB_XGEN(x)]) == gen, bar);
            __builtin_amdgcn_fence(__ATOMIC_ACQUIRE, "agent");
            asm volatile("s_waitcnt vmcnt(0)" ::: "memory");
        }
    }
    __syncthreads();
}

typedef const __attribute__((address_space(4))) Args* KArgs;
__global__ void __launch_bounds__(NTHREADS, 2) hybrid_fwd(Args a_) {
    extern __shared__ __attribute__((aligned(16))) unsigned char lds_raw[];
    LAS unsigned char* lds = (LAS unsigned char*)lds_raw;
    cg::grid_group grid = cg::this_grid();
    const int wave = __builtin_amdgcn_readfirstlane(threadIdx.x >> 6);
    const int G = gridDim.x, bx = blockIdx.x;
    volatile LAS unsigned* const xst = (volatile LAS unsigned*)(lds + EPI_OFF + 16000);
    if (threadIdx.x == 0) { xst[0] = 0u; xst[1] = 0u; }
    if (threadIdx.x == 0) (void)xb_add((unsigned*)(a_.ws + WS_BAR) + XB_XCNT(xb_xcc_id()), 1u);
    __syncthreads();
    if (a_.ph_hi < 0) grid.sync();
    const int vcu = (G % 8 == 0) ? (bx % 8) * (G / 8) + bx / 8 : bx;
    const int gw = vcu * NWAVES + wave, NGW = G * NWAVES;
#ifndef PREFIX_K
#define PREFIX_K 0
#endif
#pragma unroll 1
    for (int pass = (PREFIX_K > 0 ? 0 : 1); pass < 2; ++pass) {
    const int lo = a_.ph_lo, hi = (pass == 0) ? PREFIX_K : a_.ph_hi;
    int ph = 0;
#define a (*ap)
#ifndef PROBE_MASK
#define PROBE_MASK (0ull)
#endif
#define PHASE_BEGIN if (lo <= ph && ph < hi) for (int rep_ = ((PROBE_MASK >> ph) & 1ull) ? 2 : 1; rep_ > 0; --rep_) { KArgs ap = (KArgs)__builtin_amdgcn_kernarg_segment_ptr(); asm volatile("" : "+s"(ap)); int lane; asm volatile("v_mbcnt_lo_u32_b32 %0, -1, 0\n\tv_mbcnt_hi_u32_b32 %0, -1, %0" : "=v"(lane)); const int tid = wave * 64 + lane; (void)tid; unsigned char* const ws = a.ws; float* const outp = a.out; \
    bf16* const XN = WSP(bf16, WS_XN); bf16* const MIX = WSP(bf16, WS_MIX); const float* cosT = WSP(float, WS_COS); const float* sinT = WSP(float, WS_SIN); (void)XN; (void)MIX; (void)cosT; (void)sinT; (void)outp;
#define PHASE_END   if (rep_ == 1 && (ph + 1 < hi || pass == 0)) { xcd_barrier((unsigned*)(ws + WS_BAR), xb_xcc_id(), (volatile LAS unsigned*)(lds + EPI_OFF + 16000), (unsigned)G, tid); } } ++ph;
#define WSP(T, off) ((T*)(ws + (off)))
    using pg8::Gemm; using pg8::Epi; using pg8::StaticOrder;

    PHASE_BEGIN
    {
        LAS float* scr = (LAS float*)(lds + wave * 16384);
        int rot = 0;
        tr_matrix(a.ev_w_in, 1024, 928, 1024, [&](int n0) { return WSP(bf16, W_EVIN) + (size_t)n0 * 1024; }, scr, gw, NGW, lane, rot);
        tr_matrix(a.ev_w_q_up, 256, 768, 256, [&](int n0) { return WSP(bf16, W_QUP) + (size_t)n0 * 256; }, scr, gw, NGW, lane, rot);
        tr_matrix(a.ev_w_kv_up, 128, 1024, 128, [&](int n0) { const int h = n0 >> 7, j0 = n0 & 127; return (j0 < 64 ? WSP(bf16, W_KN) : WSP(bf16, W_V)) + (size_t)(h * 64 + (j0 & 63)) * 128; }, scr, gw, NGW, lane, rot);
        tr_matrix(a.ev_w_out, 1024, 1024, 1024, [&](int n0) { return WSP(bf16, W_EVOUT) + (size_t)n0 * 1024; }, scr, gw, NGW, lane, rot);
        tr_matrix(a.od_w_in, 1024, 2048, 1024, [&](int n0) { return WSP(bf16, W_ODIN) + (size_t)n0 * 1024; }, scr, gw, NGW, lane, rot, a.od_norm);
        for (int h = 0; h < 4; ++h) {
            tr_matrix(a.od_w_rgate + (size_t)h * 65536, 256, 256, 256, [&](int n0) { return WSP(bf16, W_GATE) + (size_t)(256 * (2 * h + (n0 >> 7)) + (n0 & 127)) * 256; }, scr, gw, NGW, lane, rot);
            tr_matrix(a.od_w_igate + (size_t)h * 65536, 256, 256, 256, [&](int n0) { return WSP(bf16, W_GATE) + (size_t)(256 * (2 * h + (n0 >> 7)) + 128 + (n0 & 127)) * 256; }, scr, gw, NGW, lane, rot);
        }
        tr_matrix(a.od_w_out, 1024, 1024, 1024, [&](int n0) { return WSP(bf16, W_ODOUT) + (size_t)n0 * 1024; }, scr, gw, NGW, lane, rot);
        for (int l = 0; l < 2; ++l) {
            tr_matrix(a.xa_w_kv + (size_t)l * 2097152, 1024, 2048, 1024, [&](int n0) { return WSP(bf16, W_XAKV + l * 4 * MiB) + (size_t)n0 * 1024; }, scr, gw, NGW, lane, rot);
            tr_matrix(a.xa_w_o + (size_t)l * 1048576, 1024, 1024, 1024, [&](int n0) { return WSP(bf16, W_XAO + l * 2 * MiB) + (size_t)n0 * 1024; }, scr, gw, NGW, lane, rot);
            tr_matrix(a.ffn_w_gate_up + (size_t)l * 1024 * 5632, 1024, 5632, 1024, [&](int n0) { const int isu = n0 >= DFF, nn = isu ? n0 - DFF : n0; return WSP(bf16, W_FFN1 + l * 11 * MiB) + (size_t)(256 * (nn >> 7) + 128 * isu + (nn & 127)) * 1024; }, scr, gw, NGW, lane, rot, a.ffn_norm + l * D);
            tr_matrix(a.ffn_w_down + (size_t)l * DFF * 1024, DFF, 1024, DFF, [&](int n0) { return WSP(bf16, W_FFN2) + (size_t)l * (1024 * DFF) + (size_t)n0 * DFF; }, scr, gw, NGW, lane, rot);
        }
        const int gt = vcu * NTHREADS + tid, NGT = G * NTHREADS;
        for (int i = gt; i < 512 * 256; i += NGT) { const int n = i >> 8, kk = i & 255, g = n >> 7; float v = 0.f; if ((kk >> 7) == (g & 1)) v = a.ev_pool_w[(size_t)g * 16384 + (size_t)(kk & 127) * 128 + (n & 127)];
            WSP(bf16, W_POOL)[i] = (bf16)(pk2(v, 0.f) & 0xffffu); }
        for (int i = gt; i < 2 * 1024 * 128; i += NGT) { const int l = i >> 17, r = (i >> 7) & 1023, c8 = (i & 127) * 8; const float g = a.xa_norm_x[l * D + r];
            const f32x4 v0 = *(const f32x4*)(a.xa_w_q + (size_t)l * 1048576 + (size_t)r * 1024 + c8), v1 = *(const f32x4*)(a.xa_w_q + (size_t)l * 1048576 + (size_t)r * 1024 + c8 + 4);
            u32x4 o; o.x = pk2(v0[0] * g, v0[1] * g); o.y = pk2(v0[2] * g, v0[3] * g); o.z = pk2(v1[0] * g, v1[1] * g); o.w = pk2(v1[2] * g, v1[3] * g);
            *(u32x4*)(WSP(bf16, W_XAQ + l * 2 * MiB) + (size_t)r * 1024 + c8) = o; }
        for (int i = gt; i < M * 16; i += NGT) { const int row = i >> 4, j = i & 15; const int f = j & 3, e = j >> 2;
            const float fa = f == 0 ? 1.0f : (f == 1 ? 0.5623413251903491f : (f == 2 ? 0.31622776601683794f : 0.1778279410038923f));
            const float fb = e == 0 ? 1.0f : (e == 1 ? 0.1f : (e == 2 ? 0.01f : 0.001f));
            const float inv_freq = fa * fb; const float ang = (float)a.pos[row] * inv_freq;
            const double t = (double)ang * 0.15915494309189535; const float fr = (float)(t - __builtin_floor(t));
            WSP(float, WS_COS)[i] = __builtin_amdgcn_cosf(fr); WSP(float, WS_SIN)[i] = __builtin_amdgcn_sinf(fr); }
        for (int i = gt; i < 6 * M; i += NGT) WSP(float, WS_SSQ)[i] = 0.f;
        for (int i = gt; i < 1024; i += NGT) { const float l = a.od_lambda[i]; const float y = ex2(-l * LOG2E);
            const float sp = (y < 0.03f) ? y * (1.0f - y * (0.5f - y * (1.0f / 3.0f - 0.25f * y))) : 0.6931471805599453f * __builtin_amdgcn_logf(1.0f + y);
            WSP(float, WS_SP8)[i] = 8.0f * sp; }
        for (int r = gw; r < 1024; r += NGW) { const int l = r >> 9, mr = r & 511; rms_row_bf16(a.mem + (size_t)mr * D, a.xa_norm_mem + l * D, WSP(bf16, WS_MN) + (size_t)r * D, lane); }
        norm_pass(a.x, a.ev_norm, XN, gw, NGW, lane);
    }
    PHASE_END

    PHASE_BEGIN
    {
        { Gemm g = pg8::mk(XN, WSP(bf16, W_EVIN), M, 1024, 1024); StaticOrder S; S.init(M, 1024, G, bx);
          Epi E{}; E.mode = pg8::E_EVIN; E.O = WSP(bf16, WS_U); E.O2 = WSP(bf16, WS_CQ); E.O3 = WSP(bf16, WS_CKV); E.O4 = WSP(bf16, WS_KR); E.cosT = cosT; E.sinT = sinT;
          pg8::gemm_phase(lds, g, S, E, fresh_tid(wave)); }
    }
    PHASE_END

    PHASE_BEGIN
    {
        const int NMEMWG = (G >= 64) ? 32 : 0;
        if (bx < NMEMWG) {
            const int l = bx >> 4, isv = (bx >> 3) & 1;
            if (!isv) { Gemm g = pg8::mk(WSP(bf16, WS_MN) + (size_t)l * 512 * D, WSP(bf16, W_XAKV + l * 4 * MiB), 512, 1024, 1024); StaticOrder S; S.init(512, 1024, G, bx & 7);
              Epi E{}; E.mode = pg8::E_PLAIN; E.O = WSP(bf16, WS_MK) + (size_t)l * 512 * D; E.ldc = 1024; E.scale = 1.f; pg8::gemm_phase(lds, g, S, E, fresh_tid(wave)); }
            else { Gemm g = pg8::mk(WSP(bf16, WS_MN) + (size_t)l * 512 * D, WSP(bf16, W_XAKV + l * 4 * MiB) + (size_t)1024 * 1024, 512, 1024, 1024); StaticOrder S; S.init(512, 1024, G, bx & 7);
              Epi E{}; E.mode = pg8::E_PLAIN; E.O = WSP(bf16, WS_MVT) + (size_t)l * 512 * D; E.ldc = 1024; E.scale = 1.f; pg8::gemm_phase(lds, g, S, E, fresh_tid(wave)); }
        } else {
        const int gw = (bx - NMEMWG) * NWAVES + wave, NGW = (G - NMEMWG) * NWAVES;
        const bf16* U = WSP(bf16, WS_U); const bf16* CQ = WSP(bf16, WS_CQ); const bf16* CKV = WSP(bf16, WS_CKV);
        bf16* PO = WSP(bf16, WS_POOLED); bf16* CQN = WSP(bf16, WS_CQN); bf16* CKVN = WSP(bf16, WS_CKVN);
        const int w = 2 << (lane >> 4);
        const f32x4 gq = *(const f32x4*)(a.ev_q_norm + 4 * lane); const f32x2 gk = *(const f32x2*)(a.ev_kv_norm + 2 * lane);
        for (int row = gw; row < M; row += NGW) {
            const int s = row & (SEQ - 1); const int cnt = (s + 1 < w) ? s + 1 : w;
            float sum[8]; float self[8];
            { const u32x4 v = *(const u32x4*)(U + (size_t)row * 512 + 8 * lane);
              self[0] = bflo(v.x); self[1] = bfhi(v.x); self[2] = bflo(v.y); self[3] = bfhi(v.y); self[4] = bflo(v.z); self[5] = bfhi(v.z); self[6] = bflo(v.w); self[7] = bfhi(v.w);
#pragma unroll
              for (int e = 0; e < 8; ++e) sum[e] = self[e]; }
            for (int tt = 1; tt < cnt; ++tt) { const u32x4 v = *(const u32x4*)(U + (size_t)(row - tt) * 512 + 8 * lane);
                sum[0] += bflo(v.x); sum[1] += bfhi(v.x); sum[2] += bflo(v.y); sum[3] += bfhi(v.y); sum[4] += bflo(v.z); sum[5] += bfhi(v.z); sum[6] += bflo(v.w); sum[7] += bfhi(v.w); }
            const float ic = 1.0f / (float)cnt;
            u32x4 o; o.x = pk2(sum[0] * ic - self[0], sum[1] * ic - self[1]); o.y = pk2(sum[2] * ic - self[2], sum[3] * ic - self[3]);
            o.z = pk2(sum[4] * ic - self[4], sum[5] * ic - self[5]); o.w = pk2(sum[6] * ic - self[6], sum[7] * ic - self[7]);
            *(u32x4*)(PO + (size_t)row * 512 + 8 * lane) = o;
            { const u32x2 v = *(const u32x2*)(CQ + (size_t)row * 256 + 4 * lane); const float x0 = bflo(v.x), x1 = bfhi(v.x), x2 = bflo(v.y), x3 = bfhi(v.y);
              const float rstd = rsqrtf(wave_sum((x0 * x0 + x1 * x1) + (x2 * x2 + x3 * x3)) * (1.f / 256.f) + RMS_EPS);
              u32x2 q; q.x = pk2(x0 * rstd * gq[0], x1 * rstd * gq[1]); q.y = pk2(x2 * rstd * gq[2], x3 * rstd * gq[3]); *(u32x2*)(CQN + (size_t)row * 256 + 4 * lane) = q; }
            { const unsigned v = *(const unsigned*)(CKV + (size_t)row * 128 + 2 * lane); const float x0 = bflo(v), x1 = bfhi(v);
              const float rstd = rsqrtf(wave_sum(x0 * x0 + x1 * x1) * (1.f / 128.f) + RMS_EPS);
              *(unsigned*)(CKVN + (size_t)row * 128 + 2 * lane) = pk2(x0 * rstd * gk[0], x1 * rstd * gk[1]); }
        }
        }
    }
    PHASE_END

    PHASE_BEGIN
    {
        { Gemm g = pg8::mk(WSP(bf16, WS_CQN), WSP(bf16, W_QUP), M, 768, 256); StaticOrder S; S.init(M, 768, G, bx);
          Epi E{}; E.mode = pg8::E_QROPE; E.O = WSP(bf16, WS_Q); E.scale = 0.10206207261596577f * LOG2E; E.cosT = cosT; E.sinT = sinT; pg8::gemm_phase(lds, g, S, E, fresh_tid(wave)); }
        { Gemm g = pg8::mk(WSP(bf16, WS_CKVN), WSP(bf16, W_KN), M, 512, 128); StaticOrder S; S.init(M, 512, G, bx);
          Epi E{}; E.mode = pg8::E_PLAIN; E.O = WSP(bf16, WS_KN); E.ldc = 512; E.scale = 1.f; pg8::gemm_phase(lds, g, S, E, fresh_tid(wave)); }
        { Gemm g = pg8::mk(WSP(bf16, W_V), WSP(bf16, WS_CKVN), 512, M, 128); StaticOrder S; S.init(512, M, G, bx);
          Epi E{}; E.mode = pg8::E_VT; E.O = WSP(bf16, WS_VT); E.ldc = M; pg8::gemm_phase(lds, g, S, E, fresh_tid(wave)); }
        { Gemm g = pg8::mk(WSP(bf16, WS_POOLED), WSP(bf16, W_POOL), M, 512, 256); g.lda = 512; g.a_pm_off = 256L * 512; g.a_pn_off = 256; StaticOrder S; S.init(M, 512, G, bx);
          Epi E{}; E.mode = pg8::E_POOL; E.O = MIX; E.ldc = 1024; E.vec0 = a.ev_pool_scale; pg8::gemm_phase(lds, g, S, E, fresh_tid(wave)); }
        { const int idx = bx >> 2;
          if (idx < 16) { const int l = idx >> 3, b = (idx >> 2) & 1, h = idx & 3;
            Gemm g = pg8::mk(WSP(bf16, W_XAO + l * 2 * MiB) + h * 256, WSP(bf16, WS_MVT) + (size_t)l * 512 * D + (size_t)b * 256 * D + h * 256, 1024, 256, 256); g.lda = 1024; g.a_pm_off = 256L * 1024; g.ldb = 1024;
            StaticOrder S; S.init(1024, 256, G, bx & 3);
            Epi E{}; E.mode = pg8::E_PLAIN; E.O = WSP(bf16, WS_WPP) + (size_t)(l * 2 + b) * 1024 * 1024 + h * 256; E.ldc = 1024; E.scale = 1.f; pg8::gemm_phase(lds, g, S, E, fresh_tid(wave)); }
          else if (idx < 32) { const int i2 = idx - 16, l = i2 >> 3, b = (i2 >> 2) & 1, h = i2 & 3;
            Gemm g = pg8::mk(WSP(bf16, WS_MK) + (size_t)l * 512 * D + (size_t)b * 256 * D + h * 256, WSP(bf16, W_XAQ + l * 2 * MiB) + h * 256, 256, 1024, 256); g.lda = 1024; g.ldb = 1024; g.b_pn_off = 256L * 1024;
            StaticOrder S; S.init(256, 1024, G, bx & 3);
            Epi E{}; E.mode = pg8::E_PLAIN; E.O = WSP(bf16, WS_WQK) + (size_t)(l * 2 + b) * 1024 * 1024 + (size_t)h * 256 * 1024; E.ldc = 1024; E.scale = 1.f; pg8::gemm_phase(lds, g, S, E, fresh_tid(wave)); } }
    }
    PHASE_END

    PHASE_BEGIN
    {
        for (int vw = vcu; vw < 256; vw += G) { const int bh = vw >> 4, s = vw & 15;
#pragma unroll 1
            for (int i = 0; i < 4; ++i) { const int qb = (i == 0) ? 63 - s : (i == 1) ? s : (i == 2) ? 32 + s : 31 - s;
                size_t z0 = 0; asm volatile("" : "+s"(z0)); unsigned char* w2 = ws + z0;
                att::attn_unit(bh >> 3, bh & 7, qb, (const bf16*)(w2 + WS_Q), (const bf16*)(w2 + WS_KN), (const bf16*)(w2 + WS_KR), (const bf16*)(w2 + WS_VT), (bf16*)(w2 + WS_MIX) + 512, lds, fresh_tid(wave)); } }
    }
    PHASE_END

    PHASE_BEGIN
    { Gemm g = pg8::mk(MIX, WSP(bf16, W_EVOUT), M, 1024, 1024); StaticOrder S; S.init(M, 1024, G, bx);
      Epi E{}; E.mode = pg8::E_RES; E.base = a.x; E.out = outp; E.O = XN; E.aout = WSP(float, WS_SSQ); pg8::gemm_phase(lds, g, S, E, fresh_tid(wave)); }
    PHASE_END

#pragma unroll 1
    for (int l = 0; l < 2; ++l) {
        if (l == 1) {
            PHASE_BEGIN
            { Gemm g = pg8::mk(XN, WSP(bf16, W_ODIN), M, 2048, 1024); StaticOrder S; S.init(M, 2048, G, bx);
              Epi E{}; E.mode = pg8::E_ODIN; E.O = WSP(bf16, WS_GB); E.O2 = WSP(bf16, WS_XBP); E.vec0 = WSP(float, WS_SSQ) + 2 * (size_t)M; pg8::gemm_phase(lds, g, S, E, fresh_tid(wave)); }
            PHASE_END
            PHASE_BEGIN
            {
                const bf16* XBP = WSP(bf16, WS_XBP); bf16* XB = XN;
                const int half = gw & 1; const int c0 = half * 512 + 8 * lane;
                float wv[4][8], bias[8];
#pragma unroll
                for (int j = 0; j < 4; ++j)
#pragma unroll
                    for (int e = 0; e < 8; ++e) wv[j][e] = a.od_conv_w[j * 1024 + c0 + e];
#pragma unroll
                for (int e = 0; e < 8; ++e) bias[e] = a.od_conv_b[c0 + e];
                for (int row = gw >> 1; row < M; row += NGW >> 1) { const int s = row & (SEQ - 1); float acc[8];
#pragma unroll
                    for (int e = 0; e < 8; ++e) acc[e] = bias[e];
#pragma unroll
                    for (int j = 0; j < 4; ++j) { if (s - 3 + j >= 0) { const u32x4 v = *(const u32x4*)(XBP + (size_t)(row - 3 + j) * D + c0);
                        acc[0] += wv[j][0] * bflo(v.x); acc[1] += wv[j][1] * bfhi(v.x); acc[2] += wv[j][2] * bflo(v.y); acc[3] += wv[j][3] * bfhi(v.y);
                        acc[4] += wv[j][4] * bflo(v.z); acc[5] += wv[j][5] * bfhi(v.z); acc[6] += wv[j][6] * bflo(v.w); acc[7] += wv[j][7] * bfhi(v.w); } }
                    u32x4 o; o.x = pk2(acc[0], acc[1]); o.y = pk2(acc[2], acc[3]); o.z = pk2(acc[4], acc[5]); o.w = pk2(acc[6], acc[7]);
                    *(u32x4*)(XB + (size_t)row * D + c0) = o; }
            }
            PHASE_END
            PHASE_BEGIN
            { Gemm g = pg8::mk(XN, WSP(bf16, W_GATE), M, 2048, 256); g.lda = 1024; g.a_pm_off = 256L * 1024; g.a_pn_off = 256; g.a_pn_shift = 1; StaticOrder S; S.init(M, 2048, G, bx);
              Epi E{}; E.mode = pg8::E_GATE; E.O = WSP(bf16, WS_B); E.aout = WSP(float, WS_A); E.vec0 = a.od_b_rgate; E.vec1 = a.od_b_igate; E.vec2 = WSP(float, WS_SP8); E.pos = a.pos; E.xb = XN;
              pg8::gemm_phase(lds, g, S, E, fresh_tid(wave)); }
            PHASE_END
            PHASE_BEGIN
            {
                const float* A_ = WSP(float, WS_A); const bf16* B_ = WSP(bf16, WS_B);
                for (int it = vcu; it < 256; it += G) { const size_t r0 = (size_t)it * 128; const int c = 2 * tid;
                    float A0 = 1.f, A1 = 1.f, B0 = 0.f, B1 = 0.f;
#pragma unroll 8
                    for (int t = 0; t < 128; ++t) { const f32x2 av = *(const f32x2*)(A_ + (r0 + t) * D + c); const unsigned bw = *(const unsigned*)(B_ + (r0 + t) * D + c);
                        B0 = av[0] * B0 + bflo(bw); B1 = av[1] * B1 + bfhi(bw); A0 *= av[0]; A1 *= av[1]; }
                    *(f32x2*)(WSP(float, WS_CA) + (size_t)it * D + c) = (f32x2){A0, A1}; *(f32x2*)(WSP(float, WS_CB) + (size_t)it * D + c) = (f32x2){B0, B1}; }
            }
            PHASE_END
            PHASE_BEGIN
            {
                const float* A_ = WSP(float, WS_A); const bf16* B_ = WSP(bf16, WS_B); const bf16* GB = WSP(bf16, WS_GB);
                for (int it = vcu; it < 256; it += G) { const size_t r0 = (size_t)it * 128; const int c = 2 * tid; const int j = it & 127, it0 = it - j;
                    float h0 = 0.f, h1 = 0.f;
#pragma unroll 8
                    for (int jj = 0; jj < j; ++jj) { const f32x2 ca = *(const f32x2*)(WSP(float, WS_CA) + (size_t)(it0 + jj) * D + c), cb = *(const f32x2*)(WSP(float, WS_CB) + (size_t)(it0 + jj) * D + c);
                        h0 = ca[0] * h0 + cb[0]; h1 = ca[1] * h1 + cb[1]; }
#pragma unroll 8
                    for (int t = 0; t < 128; ++t) { const f32x2 av = *(const f32x2*)(A_ + (r0 + t) * D + c); const unsigned bw = *(const unsigned*)(B_ + (r0 + t) * D + c); const unsigned gv = *(const unsigned*)(GB + (r0 + t) * D + c);
                        h0 = av[0] * h0 + bflo(bw); h1 = av[1] * h1 + bfhi(bw);
                        *(unsigned*)(MIX + (r0 + t) * D + c) = pk2(bflo(gv) * h0, bfhi(gv) * h1); }
                }
            }
            PHASE_END
            PHASE_BEGIN
            { Gemm g = pg8::mk(MIX, WSP(bf16, W_ODOUT), M, 1024, 1024); StaticOrder S; S.init(M, 1024, G, bx);
              Epi E{}; E.mode = pg8::E_RES; E.base = outp; E.out = outp; E.O = XN; E.aout = WSP(float, WS_SSQ) + 3 * (size_t)M; pg8::gemm_phase(lds, g, S, E, fresh_tid(wave)); }
            PHASE_END
        }
        PHASE_BEGIN
        { Gemm g = pg8::mk(XN, WSP(bf16, WS_WQK) + (size_t)l * 2 * 1024 * 1024, M, 1024, 1024); g.b_pm_div = 64; g.b_pm_off = 1024L * 1024; StaticOrder S; S.init(M, 1024, G, bx);
          Epi E{}; E.mode = pg8::E_SOFTMAX; E.O = WSP(bf16, WS_P); E.ldc = 1024; E.scale = 0.0625f * LOG2E; E.vec0 = WSP(float, WS_SSQ) + (size_t)(3 * l) * M; pg8::gemm_phase(lds, g, S, E, fresh_tid(wave)); }
        PHASE_END
        PHASE_BEGIN
        { Gemm g = pg8::mk(WSP(bf16, WS_P), WSP(bf16, WS_WPP) + (size_t)l * 2 * 1024 * 1024, M, 1024, 1024); g.b_pm_div = 64; g.b_pm_off = 1024L * 1024; StaticOrder S; S.init(M, 1024, G, bx);
          Epi E{}; E.mode = pg8::E_RES; E.base = outp; E.out = outp; E.O = XN; E.aout = WSP(float, WS_SSQ) + (size_t)(3 * l + 1) * M; pg8::gemm_phase(lds, g, S, E, fresh_tid(wave)); }
        PHASE_END
        PHASE_BEGIN
        { Gemm g = pg8::mk(XN, WSP(bf16, W_FFN1 + l * 11 * MiB), M, 2 * DFF, 1024); StaticOrder S; S.init(M, 2 * DFF, G, bx);
          Epi E{}; E.mode = pg8::E_SWIGLU; E.O = WSP(bf16, WS_H); E.vec0 = WSP(float, WS_SSQ) + (size_t)(3 * l + 1) * M; pg8::gemm_phase(lds, g, S, E, fresh_tid(wave)); }
        PHASE_END
        PHASE_BEGIN
        { Gemm g = pg8::mk(WSP(bf16, WS_H), WSP(bf16, W_FFN2) + (size_t)l * (1024 * DFF), M, 1024, DFF); StaticOrder S; S.init(M, 1024, G, bx);
          Epi E{}; E.mode = pg8::E_RES; E.base = outp; E.out = outp; E.O = (l == 0) ? XN : nullptr; E.aout = WSP(float, WS_SSQ) + (size_t)(l == 0 ? 2 : 5) * M; pg8::gemm_phase(lds, g, S, E, fresh_tid(wave)); }
        PHASE_END
    }

    PHASE_BEGIN
    {
        const f32x4* gr = (const f32x4*)a.final_norm + lane; const float* ssq = WSP(float, WS_SSQ) + 5 * (size_t)M;
        for (int m = gw; m < M; m += NGW) { f32x4* xr = (f32x4*)(outp + (size_t)m * D) + lane; const float rstd = rsqrtf(ssq[m] * (1.f / D) + RMS_EPS);
#pragma unroll
            for (int j = 0; j < 4; ++j) xr[64 * j] = xr[64 * j] * rstd * gr[64 * j]; }
    }
    PHASE_END
    }
}
#undef a
constexpr int N_PHASES = 6 + 6 + 8 + 1;

#ifndef MK_N_LAUNCHES
#define MK_N_LAUNCHES 1
#endif
extern "C" void kernel_launch(void* const* d_in, const int* in_sizes, int n_in, void* d_out, int out_size, void* d_ws, size_t ws_size, hipStream_t stream) {
    static int grid = 0;
    if (grid == 0) {
        if (n_in != 31 || ws_size < WS_NEED) { fprintf(stderr, "kernel_launch: unexpected n_in %d or ws_size %zu\n", n_in, ws_size); grid = -1; return; }
        int dev = 0, cus = 0, per_cu = 0;
        hipGetDevice(&dev); hipDeviceGetAttribute(&cus, hipDeviceAttributeMultiprocessorCount, dev);
        if (hipFuncSetAttribute((const void*)hybrid_fwd, hipFuncAttributeMaxDynamicSharedMemorySize, LDS_BYTES) != hipSuccess) { fprintf(stderr, "kernel_launch: hipFuncSetAttribute failed\n"); grid = -1; return; }
        hipOccupancyMaxActiveBlocksPerMultiprocessor(&per_cu, (const void*)hybrid_fwd, NTHREADS, LDS_BYTES);
        (void)hipGetLastError();
        if (per_cu < 1) per_cu = 1;
        grid = cus * 1;
        if (grid > 256) grid = 256;
    }
    if (grid < 0) return;
    Args a{};
    const float* const* f = (const float* const*)d_in;
    a.x = f[0]; a.mem = f[1]; a.pos = (const int*)d_in[2];
    a.ev_norm = f[3]; a.ev_w_in = f[4]; a.ev_pool_w = f[5]; a.ev_pool_scale = f[6]; a.ev_q_norm = f[7]; a.ev_w_q_up = f[8]; a.ev_kv_norm = f[9]; a.ev_w_kv_up = f[10]; a.ev_w_out = f[11];
    a.od_norm = f[12]; a.od_w_in = f[13]; a.od_conv_w = f[14]; a.od_conv_b = f[15]; a.od_w_rgate = f[16]; a.od_b_rgate = f[17]; a.od_w_igate = f[18]; a.od_b_igate = f[19]; a.od_lambda = f[20]; a.od_w_out = f[21];
    a.xa_norm_x = f[22]; a.xa_norm_mem = f[23]; a.xa_w_q = f[24]; a.xa_w_kv = f[25]; a.xa_w_o = f[26]; a.ffn_norm = f[27]; a.ffn_w_gate_up = f[28]; a.ffn_w_down = f[29]; a.final_norm = f[30];
    a.out = (float*)d_out; a.ws = (unsigned char*)d_ws;
#if MK_N_LAUNCHES == 1
    if (hipMemsetAsync((unsigned char*)d_ws + WS_BAR, 0, 16384, stream) != hipSuccess) { fprintf(stderr, "kernel_launch: memset failed\n"); return; }
    a.ph_lo = 0; a.ph_hi = N_PHASES;
    void* args[] = {&a};
    hipError_t e = hipLaunchCooperativeKernel((const void*)hybrid_fwd, dim3(grid), dim3(NTHREADS), args, LDS_BYTES, stream);
    if (e != hipSuccess) fprintf(stderr, "kernel_launch: cooperative launch failed: %s (grid %d)\n", hipGetErrorString(e), grid);
#else
    for (int p = 0; p < N_PHASES; ++p) { a.ph_lo = p; a.ph_hi = p + 1; hipLaunchKernelGGL(hybrid_fwd, dim3(grid), dim3(NTHREADS), LDS_BYTES, stream, a); }
#endif
}
```

```cpp
#include <hip/hip_runtime.h>
#include <hip/hip_cooperative_groups.h>
#include <cstdio>
#include <cstdint>
namespace cg = cooperative_groups;

#define LAS __attribute__((address_space(3)))
typedef unsigned short bf16;
typedef short bf16x8 __attribute__((ext_vector_type(8)));
typedef short s16x4 __attribute__((ext_vector_type(4)));
typedef float f32x4 __attribute__((ext_vector_type(4)));
typedef float f32x2 __attribute__((ext_vector_type(2)));
typedef float f32x16 __attribute__((ext_vector_type(16)));
typedef unsigned u32x4 __attribute__((ext_vector_type(4)));
typedef unsigned u32x2 __attribute__((ext_vector_type(2)));

constexpr int SEQ = 16384, BATCH = 2, M = BATCH * SEQ, D = 1024;
constexpr int DFF = 2816;
constexpr float RMS_EPS = 1e-6f;
constexpr float LOG2E = 1.4426950408889634f;
constexpr int NTHREADS = 512, NWAVES = 8;
constexpr int RING_BYTES = 131072, LDS_BYTES = 147456, EPI_OFF = RING_BYTES;

typedef __bf16 bf16x2_t __attribute__((ext_vector_type(2)));
__device__ __forceinline__ unsigned pk2(float lo, float hi) { f32x2 v = {lo, hi}; bf16x2_t b = __builtin_convertvector(v, bf16x2_t); return __builtin_bit_cast(unsigned, b); }
__device__ __forceinline__ float bflo(unsigned w) { return __uint_as_float(w << 16); }
__device__ __forceinline__ float bfhi(unsigned w) { return __uint_as_float(w & 0xffff0000u); }
__device__ __forceinline__ float ex2(float x) { return __builtin_amdgcn_exp2f(x); }
__device__ __forceinline__ float rcp(float x) { return __builtin_amdgcn_rcpf(x); }
__device__ __forceinline__ float sigmoidf_(float x) { return rcp(1.0f + ex2(-x * LOG2E)); }
__device__ __forceinline__ float gelu_tanh(float x) { const float u = 0.7978845608028654f * (x + 0.044715f * x * x * x); return x * sigmoidf_(2.0f * u); }
__device__ __forceinline__ float wave_sum(float v) {
#pragma unroll
    for (int o = 1; o < 64; o <<= 1) v += __shfl_xor(v, o);
    return v;
}
#define LDS_WAIT() asm volatile("s_waitcnt lgkmcnt(0)" ::: "memory")

namespace pg8 {
constexpr int BM = 256, BK = 64, HALF = 128, HTB = HALF * BK * 2, NXCD = 8, WGM = 4;
__host__ __device__ __forceinline__ int lds_byte(int r, int c) { const int st = (r >> 4) * 2 + (c >> 5), rr = r & 15, cc = c & 31, ob = rr * 64 + cc * 2; return st * 1024 + (ob ^ (((ob >> 9) & 1) << 5)); }
__host__ __device__ __forceinline__ void stage_rc(int b, int& R, int& C) { const int st = b / 1024, sb = b % 1024, swz = sb ^ (((sb >> 9) & 1) << 5); R = (st >> 1) * 16 + swz / 64; C = (st & 1) * 32 + (swz % 64) / 2; }
struct Unit { int pm, pn; };
struct Gemm { const bf16* A; const bf16* Bt; int Mr, N, K, lda, ldb; long a_pm_off, a_pn_off; int a_pn_shift; long b_pn_off; int b_pm_div; long b_pm_off; };
__device__ __forceinline__ Gemm mk(const bf16* A, const bf16* Bt, int Mr, int N, int K) {
    Gemm g; g.A = A; g.Bt = Bt; g.Mr = Mr; g.N = N; g.K = K; g.lda = K; g.ldb = K; g.a_pm_off = 256L * K; g.a_pn_off = 0; g.a_pn_shift = 0; g.b_pn_off = 256L * K; g.b_pm_div = 1 << 30; g.b_pm_off = 0; return g; }
struct StaticOrder {
    int nM, nN, nwg, G, c;
    __device__ void init(int Mr, int N, int G_, int c_) { nM = Mr / BM; nN = N / BM; nwg = nM * nN; G = G_; c = c_; }
    __device__ bool next(int i, Unit& u) const {
        const long L = (long)i * G + c; if (L >= nwg) return false;
        int wgid = (int)L; { const int q = nwg / NXCD, r = nwg % NXCD, xcd = wgid % NXCD, off = wgid / NXCD; wgid = (xcd < r ? xcd * (q + 1) : r * (q + 1) + (xcd - r) * q) + off; }
        const int nig = WGM * nN, gid = wgid / nig, fm = gid * WGM, gsz = (nM - fm) < WGM ? (nM - fm) : WGM;
        u.pm = fm + ((wgid % nig) % gsz); u.pn = (wgid % nig) / gsz; return true;
    }
};

enum { E_PLAIN = 0, E_EVIN, E_QROPE, E_POOL, E_RES, E_SOFTMAX, E_SWIGLU, E_ODIN, E_GATE, E_VT };
struct Epi {
    int mode;
    bf16* O; int ldc; float scale;
    bf16 *O2, *O3, *O4;
    const float* base; float* out;
    const float *cosT, *sinT;
    const float *vec0, *vec1, *vec2;
    const int* pos;
    const bf16* xb; float* aout;
};
__device__ __forceinline__ void st8(bf16* p, f32x4 v0, f32x4 v1) { u32x4 w; w.x = pk2(v0[0], v0[1]); w.y = pk2(v0[2], v0[3]); w.z = pk2(v1[0], v1[1]); w.w = pk2(v1[2], v1[3]); *(u32x4*)p = w; }
__device__ __forceinline__ void st4(bf16* p, f32x4 v) { u32x2 w; w.x = pk2(v[0], v[1]); w.y = pk2(v[2], v[3]); *(u32x2*)p = w; }

__device__ __forceinline__ void run_epi(const Epi& E, f32x4 (&acc)[2][2][4][2], const Unit& u, int wr, int wc, int fr, int fq, LAS unsigned char* lds) {
    const int rowb = u.pm * BM + wr * 64 + fr, colb = u.pn * BM + wc * 32 + 4 * fq;
    const int colp = u.pn * BM + wc * 32 + 8 * fq;
    switch (E.mode) {
    case E_PLAIN: {
#pragma unroll
        for (int ai = 0; ai < 2; ++ai)
#pragma unroll
            for (int m = 0; m < 4; ++m) { const size_t row = (size_t)(rowb + ai * HALF + m * 16); bf16* rp = E.O + row * E.ldc + colp;
                float sc = E.scale; if (E.vec0) sc *= rsqrtf(E.vec0[row] * (1.f / D) + RMS_EPS);
#pragma unroll
                for (int bj = 0; bj < 2; ++bj) st8(rp + bj * HALF, acc[ai][bj][m][0] * sc, acc[ai][bj][m][1] * sc); }
    } break;
    case E_EVIN: {
        const int pn = u.pn;
#pragma unroll
        for (int ai = 0; ai < 2; ++ai)
#pragma unroll
            for (int m = 0; m < 4; ++m) { const size_t row = (size_t)(rowb + ai * HALF + m * 16);
                if (pn < 2) { bf16* rp = E.O + row * 512 + colb;
#pragma unroll
                    for (int bj = 0; bj < 2; ++bj)
#pragma unroll
                        for (int n = 0; n < 2; ++n) st4(rp + bj * HALF + n * 16, acc[ai][bj][m][n]);
                } else if (pn == 2) { bf16* rp = E.O2 + row * 256 + (colb - 512);
#pragma unroll
                    for (int bj = 0; bj < 2; ++bj)
#pragma unroll
                        for (int n = 0; n < 2; ++n) st4(rp + bj * HALF + n * 16, acc[ai][bj][m][n]);
                } else { bf16* rp = E.O3 + row * 128 + (colb - 768);
#pragma unroll
                    for (int n = 0; n < 2; ++n) st4(rp + n * 16, acc[ai][0][m][n]);
                    if (wc == 0) { const f32x4 c = *(const f32x4*)(E.cosT + row * 16 + 4 * fq), s = *(const f32x4*)(E.sinT + row * 16 + 4 * fq);
                        const f32x4 v0 = acc[ai][1][m][0], v1 = acc[ai][1][m][1];
                        st4(E.O4 + row * 32 + 4 * fq, v0 * c - v1 * s); st4(E.O4 + row * 32 + 16 + 4 * fq, v1 * c + v0 * s); }
                } }
    } break;
    case E_QROPE: {
#pragma unroll
        for (int bj = 0; bj < 2; ++bj) { const int cb = u.pn * BM + bj * HALF + wc * 32; const bool rope = (cb % 96) == 64;
#pragma unroll
            for (int ai = 0; ai < 2; ++ai)
#pragma unroll
                for (int m = 0; m < 4; ++m) { const size_t row = (size_t)(rowb + ai * HALF + m * 16); bf16* rp = E.O + row * 768 + cb + 4 * fq;
                    f32x4 v0 = acc[ai][bj][m][0] * E.scale, v1 = acc[ai][bj][m][1] * E.scale;
                    if (rope) { const f32x4 c = *(const f32x4*)(E.cosT + row * 16 + 4 * fq), s = *(const f32x4*)(E.sinT + row * 16 + 4 * fq);
                        const f32x4 o0 = v0 * c - v1 * s, o1 = v1 * c + v0 * s; v0 = o0; v1 = o1; }
                    st4(rp, v0); st4(rp + 16, v1); } }
    } break;
    case E_POOL: {
#pragma unroll
        for (int bj = 0; bj < 2; ++bj) { const int col = colp + bj * HALF; const f32x4 s0 = *(const f32x4*)(E.vec0 + col), s1 = *(const f32x4*)(E.vec0 + col + 4);
#pragma unroll
            for (int ai = 0; ai < 2; ++ai)
#pragma unroll
                for (int m = 0; m < 4; ++m) st8(E.O + (size_t)(rowb + ai * HALF + m * 16) * E.ldc + col, acc[ai][bj][m][0] * s0, acc[ai][bj][m][1] * s1); }
    } break;
    case E_RES: {
        f32x4 bs[2][2][2][2];
#define RES_LOAD(ch) do { _Pragma("unroll") for (int g_ = 0; g_ < 2; ++g_) { const int ai_ = (ch) >> 1, m_ = 2 * ((ch) & 1) + g_; const size_t off_ = (size_t)(rowb + ai_ * HALF + m_ * 16) * D + colp; \
            _Pragma("unroll") for (int bj = 0; bj < 2; ++bj) _Pragma("unroll") for (int n = 0; n < 2; ++n) bs[(ch) & 1][g_][bj][n] = *(const f32x4*)(E.base + off_ + bj * HALF + n * 4); } } while (0)
        RES_LOAD(0);
#pragma unroll
        for (int ch = 0; ch < 4; ++ch) {
            if (ch < 3) RES_LOAD(ch + 1);
#pragma unroll
            for (int g_ = 0; g_ < 2; ++g_) { const int ai = ch >> 1, m = 2 * (ch & 1) + g_; const size_t row = (size_t)(rowb + ai * HALF + m * 16); const size_t off = row * D + colp; float q = 0.f;
#pragma unroll
                for (int bj = 0; bj < 2; ++bj) { const f32x4 o0 = bs[ch & 1][g_][bj][0] + acc[ai][bj][m][0], o1 = bs[ch & 1][g_][bj][1] + acc[ai][bj][m][1];
                    *(f32x4*)(E.out + off + bj * HALF) = o0; *(f32x4*)(E.out + off + bj * HALF + 4) = o1;
                    if (E.O) st8(E.O + off + bj * HALF, o0, o1);
                    q += (o0[0] * o0[0] + o0[1] * o0[1]) + (o0[2] * o0[2] + o0[3] * o0[3]) + (o1[0] * o1[0] + o1[1] * o1[1]) + (o1[2] * o1[2] + o1[3] * o1[3]); }
                q += __shfl_xor(q, 16); q += __shfl_xor(q, 32);
                if (fq == 0) atomicAdd(E.aout + row, q); }
            asm volatile("" ::: "memory"); }
#undef RES_LOAD
    } break;
    case E_SOFTMAX: {
        LAS float* RM = (LAS float*)(lds + EPI_OFF);
        LAS float* RS = (LAS float*)(lds + EPI_OFF + 4096);
#pragma unroll
        for (int ai = 0; ai < 2; ++ai)
#pragma unroll
            for (int m = 0; m < 4; ++m) { float mx = -3.0e38f;
                float sc = E.scale; if (E.vec0) sc *= rsqrtf(E.vec0[(size_t)(rowb + ai * HALF + m * 16)] * (1.f / D) + RMS_EPS);
#pragma unroll
                for (int bj = 0; bj < 2; ++bj)
#pragma unroll
                    for (int n = 0; n < 2; ++n) { const f32x4 x = acc[ai][bj][m][n] * sc; acc[ai][bj][m][n] = x; mx = fmaxf(mx, fmaxf(fmaxf(x[0], x[1]), fmaxf(x[2], x[3]))); }
                mx = fmaxf(mx, __shfl_xor(mx, 16)); mx = fmaxf(mx, __shfl_xor(mx, 32));
                if (fq == 0) RM[(ai * HALF + wr * 64 + m * 16 + fr) * 4 + wc] = mx; }
        LDS_WAIT(); __builtin_amdgcn_s_barrier(); asm volatile("" ::: "memory");
#pragma unroll
        for (int ai = 0; ai < 2; ++ai)
#pragma unroll
            for (int m = 0; m < 4; ++m) { const int rl = ai * HALF + wr * 64 + m * 16 + fr; const f32x4 mm = *(LAS f32x4*)(RM + rl * 4);
                const float mx = fmaxf(fmaxf(mm[0], mm[1]), fmaxf(mm[2], mm[3])); float s = 0.f;
#pragma unroll
                for (int bj = 0; bj < 2; ++bj)
#pragma unroll
                    for (int n = 0; n < 2; ++n) { f32x4 x = acc[ai][bj][m][n]; x[0] = ex2(x[0] - mx); x[1] = ex2(x[1] - mx); x[2] = ex2(x[2] - mx); x[3] = ex2(x[3] - mx); acc[ai][bj][m][n] = x; s += (x[0] + x[1]) + (x[2] + x[3]); }
                s += __shfl_xor(s, 16); s += __shfl_xor(s, 32);
                if (fq == 0) RS[rl * 4 + wc] = s; }
        LDS_WAIT(); __builtin_amdgcn_s_barrier(); asm volatile("" ::: "memory");
#pragma unroll
        for (int ai = 0; ai < 2; ++ai)
#pragma unroll
            for (int m = 0; m < 4; ++m) { const int rl = ai * HALF + wr * 64 + m * 16 + fr; const f32x4 ss = *(LAS f32x4*)(RS + rl * 4);
                const float inv = rcp((ss[0] + ss[1]) + (ss[2] + ss[3])); bf16* rp = E.O + (size_t)(u.pm * BM + rl) * E.ldc + colp;
#pragma unroll
                for (int bj = 0; bj < 2; ++bj) st8(rp + bj * HALF, acc[ai][bj][m][0] * inv, acc[ai][bj][m][1] * inv); }
    } break;
    case E_SWIGLU: {
        const int colh = u.pn * HALF + wc * 32 + 8 * fq;
#pragma unroll
        for (int ai = 0; ai < 2; ++ai)
#pragma unroll
            for (int m = 0; m < 4; ++m) { const size_t row = (size_t)(rowb + ai * HALF + m * 16); const float rs = rsqrtf(E.vec0[row] * (1.f / D) + RMS_EPS); f32x4 o[2];
#pragma unroll
                for (int n = 0; n < 2; ++n) { const f32x4 g = acc[ai][0][m][n] * rs, uu = acc[ai][1][m][n] * rs;
#pragma unroll
                    for (int e = 0; e < 4; ++e) o[n][e] = g[e] * sigmoidf_(g[e]) * uu[e]; }
                st8(E.O + row * DFF + colh, o[0], o[1]); }
    } break;
    case E_ODIN: {
        const bool isg = u.pn < 4;
#pragma unroll
        for (int ai = 0; ai < 2; ++ai)
#pragma unroll
            for (int m = 0; m < 4; ++m) { const size_t row = (size_t)(rowb + ai * HALF + m * 16); const float rs = rsqrtf(E.vec0[row] * (1.f / D) + RMS_EPS);
                bf16* rp = (isg ? E.O + row * D + colp : E.O2 + row * D + (colp - D));
#pragma unroll
                for (int bj = 0; bj < 2; ++bj) { f32x4 v0 = acc[ai][bj][m][0] * rs, v1 = acc[ai][bj][m][1] * rs;
                    if (isg) {
#pragma unroll
                        for (int e = 0; e < 4; ++e) { v0[e] = gelu_tanh(v0[e]); v1[e] = gelu_tanh(v1[e]); } }
                    st8(rp + bj * HALF, v0, v1); } }
    } break;
    case E_GATE: {
        const int c = (u.pn >> 1) * 256 + (u.pn & 1) * HALF + wc * 32 + 8 * fq;
        f32x4 br[2], bi[2], sp[2];
#pragma unroll
        for (int n = 0; n < 2; ++n) { br[n] = *(const f32x4*)(E.vec0 + c + 4 * n); bi[n] = *(const f32x4*)(E.vec1 + c + 4 * n); sp[n] = *(const f32x4*)(E.vec2 + c + 4 * n); }
#pragma unroll
        for (int ai = 0; ai < 2; ++ai)
#pragma unroll
            for (int m = 0; m < 4; ++m) { const size_t row = (size_t)(rowb + ai * HALF + m * 16); const bool rst = E.pos[row] == 0;
                const u32x4 xw = *(const u32x4*)(E.xb + row * D + c); const float xv[8] = {bflo(xw.x), bfhi(xw.x), bflo(xw.y), bfhi(xw.y), bflo(xw.z), bfhi(xw.z), bflo(xw.w), bfhi(xw.w)};
                f32x4 av[2], bv[2];
#pragma unroll
                for (int n = 0; n < 2; ++n) { const f32x4 pr = acc[ai][0][m][n] + br[n], pi = acc[ai][1][m][n] + bi[n];
#pragma unroll
                    for (int e = 0; e < 4; ++e) { const float r = sigmoidf_(pr[e]), ig = sigmoidf_(pi[e]); const float la = -sp[n][e] * r; float a = ex2(la * LOG2E);
                        const float x2 = 2.0f * la; const float om = (x2 > -0.01f) ? -(x2 + x2 * x2 * (0.5f + x2 * (1.0f / 6.0f))) : 1.0f - ex2(x2 * LOG2E);
                        float mult = sqrtf(fmaxf(om, 0.f)); if (rst) { a = 0.f; mult = 1.f; }
                        av[n][e] = a; bv[n][e] = mult * (ig * xv[4 * n + e]); } }
                *(f32x4*)(E.aout + row * D + c) = av[0]; *(f32x4*)(E.aout + row * D + c + 4) = av[1]; st8(E.O + row * D + c, bv[0], bv[1]); }
    } break;
    case E_VT: {
#pragma unroll
        for (int ai = 0; ai < 2; ++ai)
#pragma unroll
            for (int m = 0; m < 4; ++m) { const size_t row = (size_t)(rowb + ai * HALF + m * 16);
#pragma unroll
                for (int bj = 0; bj < 2; ++bj) { const int col = colp + bj * HALF, b16 = col & ~15, hf = (col >> 3) & 1; bf16* rp = E.O + row * E.ldc + b16 + 4 * hf;
                    st4(rp, acc[ai][bj][m][0]); st4(rp + 8, acc[ai][bj][m][1]); } }
    } break;
    default: break;
    }
}

__device__ __forceinline__ void gemm_phase(LAS unsigned char* lds, const Gemm g, const StaticOrder& S, const Epi& E, const int tid) {
    const int wid = __builtin_amdgcn_readfirstlane(tid >> 6), lane = tid & 63, wr = wid >> 2, wc = wid & 3, fr = lane & 15, fq = lane >> 4;
    const int K = g.K, nt = K / BK;
    unsigned voffA, voffB;
    { int R, C; stage_rc(tid * 16, R, C); const bool perm = (E.mode != E_EVIN) && (E.mode != E_QROPE);
      const int rho = R & 31, Rb = perm ? ((R & ~31) + 8 * ((rho & 15) >> 2) + 4 * (rho >> 4) + (rho & 3)) : R;
      voffA = (unsigned)(R * g.lda + C) * 2u; voffB = (unsigned)(Rb * g.ldb + C) * 2u; }
    const size_t q64A = (size_t)64 * g.lda * 2, q64B = (size_t)64 * g.ldb * 2;
    const size_t kstep = (size_t)(BK * 2);
    const size_t hstepA = (size_t)HALF * g.lda * 2, hstepB = (size_t)HALF * g.ldb * 2;
    const unsigned ldsw = (unsigned)wid * 1024u;
    const int aoff = lds_byte(wr * 64 + fr, fq * 8), boff = lds_byte(wc * 32 + fr, fq * 8);
#define PG8_ABASE(u) ((const char*)g.A + ((size_t)(u).pm * g.a_pm_off + (size_t)((u).pn >> g.a_pn_shift) * g.a_pn_off) * 2)
#define PG8_BBASE(u) ((const char*)g.Bt + ((size_t)(u).pn * g.b_pn_off + (size_t)((u).pm / g.b_pm_div) * g.b_pm_off) * 2)
#define PG8_SA(b, h) (((b) * 2 + (h)) * HTB)
#define PG8_SB(b, h) ((4 + (b) * 2 + (h)) * HTB)
#define PG8_Q64(v) PG8_Q64_##v
#define PG8_Q64_voffA q64A
#define PG8_Q64_voffB q64B
#define PG8_STAGE(bufoff, gbase, voff) do { \
        __builtin_amdgcn_global_load_lds((const unsigned*)((const char*)(gbase) + (voff)), (LAS unsigned*)(lds + (bufoff) + ldsw), 16, 0, 0); \
        __builtin_amdgcn_global_load_lds((const unsigned*)((const char*)(gbase) + PG8_Q64(voff) + (voff)), (LAS unsigned*)(lds + (bufoff) + ldsw + 8192), 16, 0, 0); } while (0)
#define PG8_LDA(dst, b, h) do { _Pragma("unroll") for (int m = 0; m < 4; ++m) _Pragma("unroll") for (int k = 0; k < 2; ++k) dst[m][k] = *(const LAS bf16x8*)(lds + PG8_SA(b, h) + aoff + m * 2048 + k * 1024); } while (0)
#define PG8_LDB(dst, b, h) do { _Pragma("unroll") for (int n = 0; n < 2; ++n) _Pragma("unroll") for (int k = 0; k < 2; ++k) dst[n][k] = *(const LAS bf16x8*)(lds + PG8_SB(b, h) + boff + n * 2048 + k * 1024); } while (0)
#define PG8_MMA(ai, bj, At, Bt) do { __builtin_amdgcn_s_setprio(1); _Pragma("unroll") for (int m = 0; m < 4; ++m) _Pragma("unroll") for (int n = 0; n < 2; ++n) _Pragma("unroll") for (int k = 0; k < 2; ++k) \
        acc[ai][bj][m][n] = __builtin_amdgcn_mfma_f32_16x16x32_bf16(Bt[n][k], At[m][k], acc[ai][bj][m][n], 0, 0, 0); __builtin_amdgcn_s_setprio(0); } while (0)
#define PG8_WAIT_V(n) asm volatile("s_waitcnt vmcnt(" #n ")" ::: "memory")
#define PG8_WAIT_L(n) asm volatile("s_waitcnt lgkmcnt(" #n ")" ::: "memory")
#define PG8_BAR __builtin_amdgcn_s_barrier()
#define PG8_SCHED __builtin_amdgcn_sched_barrier(0)
    Unit cur, nxt; int ui = 0;
    if (!S.next(0, cur)) return;
    f32x4 acc[2][2][4][2];
#pragma unroll
    for (int a = 0; a < 2; ++a)
#pragma unroll
        for (int b = 0; b < 2; ++b)
#pragma unroll
            for (int m = 0; m < 4; ++m)
#pragma unroll
                for (int n = 0; n < 2; ++n) acc[a][b][m][n] = (f32x4){0.f, 0.f, 0.f, 0.f};
    bf16x8 At[4][2], B0[2][2], B1[2][2];
    const char* cA = PG8_ABASE(cur); const char* cB = PG8_BBASE(cur);
    PG8_STAGE(PG8_SB(0, 0), cB, voffB); PG8_STAGE(PG8_SB(0, 1), cB + hstepB, voffB); PG8_STAGE(PG8_SA(0, 0), cA, voffA); PG8_STAGE(PG8_SA(0, 1), cA + hstepA, voffA);
    if (wr == 1) PG8_BAR;
    PG8_WAIT_V(2); PG8_BAR;
    PG8_STAGE(PG8_SB(1, 0), cB + kstep, voffB); PG8_STAGE(PG8_SA(1, 0), cA + kstep, voffA); PG8_STAGE(PG8_SB(1, 1), cB + hstepB + kstep, voffB);
    PG8_WAIT_V(6); PG8_BAR;
    for (;;) {
        const bool has_next = S.next(ui + 1, nxt);
        const char* nA = has_next ? PG8_ABASE(nxt) : cA; const char* nB = has_next ? PG8_BBASE(nxt) : cB;
        for (int t = 0; t < nt; t += 2) {
            const bool last = (t == nt - 2);
            const char* a1 = cA + (size_t)(t + 1) * kstep;
            const char* a2 = last ? nA : cA + (size_t)(t + 2) * kstep; const char* b2 = last ? nB : cB + (size_t)(t + 2) * kstep;
            const char* a3 = a2 + kstep; const char* b3 = b2 + kstep;
            PG8_LDB(B0, 0, 0); PG8_LDB(B1, 0, 1); PG8_SCHED; PG8_LDA(At, 0, 0); PG8_STAGE(PG8_SA(1, 1), a1 + hstepA, voffA);
            PG8_WAIT_V(8); PG8_WAIT_L(0); PG8_BAR; PG8_MMA(0, 0, At, B0); PG8_MMA(0, 1, At, B1); PG8_BAR; PG8_SCHED;
            PG8_LDA(At, 0, 1); PG8_STAGE(PG8_SB(0, 0), b2, voffB); PG8_STAGE(PG8_SB(0, 1), b2 + hstepB, voffB); PG8_STAGE(PG8_SA(0, 0), a2, voffA);
            PG8_WAIT_V(8); PG8_WAIT_L(0); PG8_BAR; PG8_MMA(1, 0, At, B0); PG8_MMA(1, 1, At, B1); PG8_BAR; PG8_SCHED;
            PG8_LDB(B0, 1, 0); PG8_LDB(B1, 1, 1); PG8_SCHED; PG8_LDA(At, 1, 0); PG8_STAGE(PG8_SA(0, 1), a2 + hstepA, voffA);
            PG8_WAIT_V(8); PG8_WAIT_L(0); PG8_BAR; PG8_MMA(0, 0, At, B0); PG8_MMA(0, 1, At, B1); PG8_BAR; PG8_SCHED;
            PG8_LDA(At, 1, 1); PG8_STAGE(PG8_SB(1, 0), b3, voffB); PG8_STAGE(PG8_SB(1, 1), b3 + hstepB, voffB); PG8_STAGE(PG8_SA(1, 0), a3, voffA);
            PG8_WAIT_V(8); PG8_WAIT_L(0); PG8_BAR; PG8_MMA(1, 0, At, B0); PG8_MMA(1, 1, At, B1); PG8_BAR; PG8_SCHED;
        }
        if (wr == 0) PG8_BAR;
        run_epi(E, acc, cur, wr, wc, fr, fq, lds);
        if (!has_next) break;
#pragma unroll
        for (int a = 0; a < 2; ++a)
#pragma unroll
            for (int b = 0; b < 2; ++b)
#pragma unroll
                for (int m = 0; m < 4; ++m)
#pragma unroll
                    for (int n = 0; n < 2; ++n) acc[a][b][m][n] = (f32x4){0.f, 0.f, 0.f, 0.f};
        cur = nxt; cA = nA; cB = nB; ++ui;
        if (wr == 1) PG8_BAR;
    }
    PG8_WAIT_V(0);
    PG8_BAR;
#undef PG8_ABASE
#undef PG8_BBASE
#undef PG8_SA
#undef PG8_SB
#undef PG8_STAGE
#undef PG8_Q64
#undef PG8_Q64_voffA
#undef PG8_Q64_voffB
#undef PG8_LDA
#undef PG8_LDB
#undef PG8_MMA
#undef PG8_WAIT_V
#undef PG8_WAIT_L
#undef PG8_BAR
#undef PG8_SCHED
}
}

namespace att {
#define ATT_BAR() do { asm volatile("s_waitcnt lgkmcnt(0)" ::: "memory"); __builtin_amdgcn_s_barrier(); asm volatile("" ::: "memory"); } while (0)
constexpr int KST_B = 208  , VST_B = 144  ;
constexpr int KBYTES = 64 * KST_B, VBYTES = 64 * VST_B, BUFB = KBYTES + VBYTES;
__device__ __forceinline__ int crow(int r, int hi) { return (r & 3) + 8 * (r >> 2) + 4 * hi; }
constexpr int NSLOT = 4, NPIECE = 22;
__device__ __forceinline__ void attn_unit(int b, int h, int qb, const bf16* Q, const bf16* KN, const bf16* KR, const bf16* VT, bf16* OUT, LAS unsigned char* lds, const int tid) {
    const int lane = tid & 63, r32 = lane & 31, hi = lane >> 5, wid = __builtin_amdgcn_readfirstlane(tid >> 6);
    const size_t rowbase = (size_t)b * SEQ; const int q0 = qb * 256; const int qrow = q0 + wid * 32 + r32;
    const int NT = (q0 + 256) / 64;
    const char* gp[3]; unsigned ginc[3];
#pragma unroll
    for (int i = 0; i < 3; ++i) { const int p = wid + 8 * i;
        if (p < 13) { const int c = p * 64 + lane, row = c / 13, c16 = c % 13;
            if (c16 >= 8 && c16 < 12) { gp[i] = (const char*)(KR + (rowbase + row) * 32 + (c16 - 8) * 8); ginc[i] = 64 * 32 * 2; }
            else { gp[i] = (const char*)(KN + (rowbase + row) * 512 + h * 64 + (c16 < 8 ? c16 : 0) * 8); ginc[i] = 64 * 512 * 2; } }
        else { const int c = ((p < NPIECE ? p : 13) - 13) * 64 + lane, d = c / 9, c16 = c % 9;
            gp[i] = (const char*)(VT + (size_t)(h * 64 + d) * M + rowbase + (c16 < 8 ? c16 : 0) * 8); ginc[i] = 64 * 2; } }
#define ATT_DMA(t) do { LAS unsigned char* sl_ = lds + ((t) & (NSLOT - 1)) * BUFB + wid * 1024; \
        __builtin_amdgcn_global_load_lds((const unsigned*)(gp[0] + (size_t)(t) * ginc[0]), (LAS unsigned*)(sl_), 16, 0, 0); \
        __builtin_amdgcn_global_load_lds((const unsigned*)(gp[1] + (size_t)(t) * ginc[1]), (LAS unsigned*)(sl_ + 8192), 16, 0, 0); \
        if (wid < NPIECE - 16) __builtin_amdgcn_global_load_lds((const unsigned*)(gp[2] + (size_t)(t) * ginc[2]), (LAS unsigned*)(sl_ + 16384), 16, 0, 0); } while (0)
    bf16x8 qr[6];
    { const bf16* qp = Q + (rowbase + qrow) * 768 + h * 96 + hi * 8;
#pragma unroll
      for (int ks = 0; ks < 6; ++ks) qr[ks] = *(const bf16x8*)(qp + ks * 16); }
    asm volatile("s_waitcnt vmcnt(0)" ::: "memory");
    ATT_DMA(0); ATT_DMA(1); ATT_DMA(2);
    f32x16 o0, o1;
#pragma unroll
    for (int r = 0; r < 16; ++r) { o0[r] = 0.f; o1[r] = 0.f; }
    float mrun = 0.f, lrun = 0.f;
    f32x16 negm;
#pragma unroll
    for (int r = 0; r < 16; ++r) negm[r] = 0.f;
    const int qmin = q0 + wid * 32;
    asm volatile("s_waitcnt vmcnt(4)" ::: "memory");
    ATT_BAR();
    if (wid >= 4) ATT_BAR();
#pragma unroll 1
    for (int t = 0; t < NT; ++t) {
        if (t + 3 < NT) ATT_DMA(t + 3);
        const int kv0 = t * 64;
        const bool active = kv0 <= qmin + 31;
        bf16x8 vf0[4], vf1[4]; f32x16 p0, p1;
        if (active) {
            const LAS unsigned char* buf = lds + (t & (NSLOT - 1)) * BUFB;
            const LAS unsigned char* kb = buf + r32 * KST_B + hi * 16;
            const LAS unsigned char* vb = buf + KBYTES + r32 * VST_B + hi * 16;
#pragma unroll
            for (int s = 0; s < 4; ++s) { vf0[s] = *(const LAS bf16x8*)(vb + s * 32); vf1[s] = *(const LAS bf16x8*)(vb + 32 * VST_B + s * 32); }
            __builtin_amdgcn_sched_barrier(0);
#pragma unroll
            for (int ks = 0; ks < 6; ++ks) { const bf16x8 a0 = *(const LAS bf16x8*)(kb + ks * 32), a1 = *(const LAS bf16x8*)(kb + 32 * KST_B + ks * 32);
                if (ks == 0) { p0 = __builtin_amdgcn_mfma_f32_32x32x16_bf16(a0, qr[0], negm, 0, 0, 0); p1 = __builtin_amdgcn_mfma_f32_32x32x16_bf16(a1, qr[0], negm, 0, 0, 0); }
                else { p0 = __builtin_amdgcn_mfma_f32_32x32x16_bf16(a0, qr[ks], p0, 0, 0, 0); p1 = __builtin_amdgcn_mfma_f32_32x32x16_bf16(a1, qr[ks], p1, 0, 0, 0); } }
        }
        if (t + 3 < NT) asm volatile("s_waitcnt vmcnt(4)" ::: "memory");
        else asm volatile("s_waitcnt vmcnt(0)" ::: "memory");
        ATT_BAR();
        if (active) {
            if (kv0 + 63 > qmin) {
#pragma unroll
                for (int r = 0; r < 16; ++r) { const int kv = kv0 + crow(r, hi); if (kv > qrow) p0[r] = -1e30f; if (kv + 32 > qrow) p1[r] = -1e30f; }
            }
            float mx = __builtin_amdgcn_fmed3f(p0[0], p1[0], __builtin_inff());
#pragma unroll
            for (int r = 1; r < 16; ++r) { mx = __builtin_amdgcn_fmed3f(mx, p0[r], __builtin_inff()); mx = __builtin_amdgcn_fmed3f(mx, p1[r], __builtin_inff()); }
            { auto rr = __builtin_amdgcn_permlane32_swap(__float_as_uint(mx), __float_as_uint(mx), false, false); mx = fmaxf(__uint_as_float(rr[0]), __uint_as_float(rr[1])); }
            const bool first = (t == 0);
            if (first || __builtin_amdgcn_ballot_w64(mx > 0.f) != 0ull) {
                const float d = first ? mx : fmaxf(mx, 0.f); mrun += d;
                if (!first) { const float alpha = ex2(-d); lrun *= alpha;
#pragma unroll
                    for (int r = 0; r < 16; ++r) { o0[r] *= alpha; o1[r] *= alpha; } }
#pragma unroll
                for (int r = 0; r < 16; ++r) { p0[r] -= d; p1[r] -= d; negm[r] = -mrun; }
            }
            float rs0 = 0.f, rs1 = 0.f;
#pragma unroll
            for (int r = 0; r < 16; ++r) { p0[r] = ex2(p0[r]); p1[r] = ex2(p1[r]); rs0 += p0[r]; asm volatile("" : "+v"(rs0)); rs1 += p1[r]; asm volatile("" : "+v"(rs1)); }
            lrun += rs0 + rs1;
            u32x4 pw[4];
#pragma unroll
            for (int j = 0; j < 4; ++j) { pw[0][j] = pk2(p0[2 * j], p0[2 * j + 1]); pw[1][j] = pk2(p0[8 + 2 * j], p0[8 + 2 * j + 1]); pw[2][j] = pk2(p1[2 * j], p1[2 * j + 1]); pw[3][j] = pk2(p1[8 + 2 * j], p1[8 + 2 * j + 1]); }
#pragma unroll
            for (int s = 0; s < 4; ++s) { const bf16x8 pf = __builtin_bit_cast(bf16x8, pw[s]);
                o0 = __builtin_amdgcn_mfma_f32_32x32x16_bf16(vf0[s], pf, o0, 0, 0, 0); o1 = __builtin_amdgcn_mfma_f32_32x32x16_bf16(vf1[s], pf, o1, 0, 0, 0); }
        }
        ATT_BAR();
    }
    if (wid < 4) ATT_BAR();
#undef ATT_DMA
    float ltot; { auto rr = __builtin_amdgcn_permlane32_swap(__float_as_uint(lrun), __float_as_uint(lrun), false, false); ltot = __uint_as_float(rr[0]) + __uint_as_float(rr[1]); }
    const float inv = rcp(ltot);
    bf16* op = OUT + (rowbase + qrow) * 1024 + h * 64 + 4 * hi;
#pragma unroll
    for (int g = 0; g < 4; ++g) {
        u32x2 w0, w1; w0.x = pk2(o0[4 * g] * inv, o0[4 * g + 1] * inv); w0.y = pk2(o0[4 * g + 2] * inv, o0[4 * g + 3] * inv);
        w1.x = pk2(o1[4 * g] * inv, o1[4 * g + 1] * inv); w1.y = pk2(o1[4 * g + 2] * inv, o1[4 * g + 3] * inv);
        *(u32x2*)(op + 8 * g) = w0; *(u32x2*)(op + 32 + 8 * g) = w1; }
    asm volatile("s_waitcnt vmcnt(0)" ::: "memory");
}
}

constexpr size_t MiB = 1u << 20;
constexpr size_t WS_BAR = 32 * 1024;
constexpr size_t WS_SP8 = 0;
constexpr size_t WS_CA = 64 * 1024, WS_CB = WS_CA + 256 * 1024 * 4;
constexpr size_t WS_SSQ = 2 * MiB + 128 * 1024;
constexpr size_t WS_COS = 3 * MiB, WS_SIN = 5 * MiB;
constexpr size_t WS_MN = 7 * MiB;
constexpr size_t WS_MK = 9 * MiB;
constexpr size_t WS_MVT = 11 * MiB;
constexpr size_t WS_W = 13 * MiB;
constexpr size_t W_EVIN = WS_W, W_POOL = W_EVIN + 2 * MiB, W_QUP = W_POOL + MiB, W_KN = W_QUP + MiB, W_V = W_KN + MiB / 4, W_EVOUT = W_KN + MiB;
constexpr size_t W_ODIN = W_EVOUT + 2 * MiB, W_GATE = W_ODIN + 4 * MiB, W_ODOUT = W_GATE + MiB, W_XAQ = W_ODOUT + 2 * MiB  , W_XAKV = W_XAQ + 4 * MiB  ;
constexpr size_t W_XAO = W_XAKV + 8 * MiB  , W_FFN1 = W_XAO + 4 * MiB  , W_FFN2 = W_FFN1 + 22 * MiB  , W_END = W_FFN2 + 11 * MiB;
static_assert(W_END <= 80 * MiB, "weights");
constexpr size_t WS_XN = 80 * MiB;
constexpr size_t WS_MIX = 144 * MiB;
constexpr size_t WS_H = 208 * MiB;
constexpr size_t WS_U = 208 * MiB, WS_CQ = 240 * MiB, WS_CKV = 256 * MiB, WS_KR = 264 * MiB, WS_POOLED = 266 * MiB, WS_CQN = 298 * MiB, WS_CKVN = 314 * MiB, WS_Q = 322 * MiB;
constexpr size_t WS_KN = 384 * MiB, WS_VT = 416 * MiB;
constexpr size_t WS_XQ = 208 * MiB, WS_P = 272 * MiB;
constexpr size_t WS_GB = 208 * MiB, WS_XBP = 272 * MiB, WS_B = 272 * MiB, WS_A = 336 * MiB;
constexpr size_t WS_WPP = 470 * MiB;
constexpr size_t WS_WQK = 478 * MiB;
constexpr size_t WS_NEED = 488 * MiB;

struct Args {
    const float* x; const float* mem; const int* pos;
    const float *ev_norm, *ev_w_in, *ev_pool_w, *ev_pool_scale, *ev_q_norm, *ev_w_q_up, *ev_kv_norm, *ev_w_kv_up, *ev_w_out;
    const float *od_norm, *od_w_in, *od_conv_w, *od_conv_b, *od_w_rgate, *od_b_rgate, *od_w_igate, *od_b_igate, *od_lambda, *od_w_out;
    const float *xa_norm_x, *xa_norm_mem, *xa_w_q, *xa_w_kv, *xa_w_o, *ffn_norm, *ffn_w_gate_up, *ffn_w_down, *final_norm;
    float* out; unsigned char* ws; int ph_lo, ph_hi;
};

template <class RM> __device__ __forceinline__ void tr_matrix(const float* W, int K, int N, int ldd, RM rowptr, LAS float* scr, int gw, int NGW, int lane, int& rot, const float* kg = nullptr) {
    const int nblk = N / 32, nit = (K / 64) * nblk;
    int it = (gw - (rot % NGW) + NGW) % NGW;
    rot += nit;
    float r[32];
    const int lrow = lane >> 5, lcol = lane & 31;
    if (it < nit) { const float* src = W + (size_t)(64 * (it / nblk) + lrow) * N + 32 * (it % nblk) + lcol;
#pragma unroll
        for (int i = 0; i < 32; ++i) r[i] = src[(size_t)(2 * i) * N]; }
    for (; it < nit; it += NGW) {
        const int k0 = 64 * (it / nblk), n0 = 32 * (it % nblk);
#pragma unroll
        for (int i = 0; i < 32; ++i) scr[(2 * i + lrow) * 33 + lcol] = r[i];
        LDS_WAIT(); asm volatile("" ::: "memory");
        const int itn = it + NGW;
        if (itn < nit) { const float* src = W + (size_t)(64 * (itn / nblk) + lrow) * N + 32 * (itn % nblk) + lcol;
#pragma unroll
            for (int i = 0; i < 32; ++i) r[i] = src[(size_t)(2 * i) * N]; }
        const int c = lane & 7; bf16* dst = rowptr(n0);
        f32x4 g0 = (f32x4){1.f, 1.f, 1.f, 1.f}, g1 = g0;
        if (kg) { g0 = *(const f32x4*)(kg + k0 + 8 * c); g1 = *(const f32x4*)(kg + k0 + 8 * c + 4); }
#pragma unroll
        for (int j = 0; j < 4; ++j) { const int n = (lane >> 3) + 8 * j; const LAS float* s = scr + (8 * c) * 33 + n;
            u32x4 o; o.x = pk2(s[0 * 33] * g0[0], s[1 * 33] * g0[1]); o.y = pk2(s[2 * 33] * g0[2], s[3 * 33] * g0[3]); o.z = pk2(s[4 * 33] * g1[0], s[5 * 33] * g1[1]); o.w = pk2(s[6 * 33] * g1[2], s[7 * 33] * g1[3]);
            *(u32x4*)(dst + (size_t)n * ldd + k0 + 8 * c) = o; }
        LDS_WAIT(); asm volatile("" ::: "memory");
    }
}
__device__ __forceinline__ void rms_row_bf16(const float* xrow, const float* g, bf16* orow, int lane) {
    const f32x4* xr = (const f32x4*)xrow + lane; const f32x4* gr = (const f32x4*)g + lane;
    f32x4 v[4]; float s = 0.f;
#pragma unroll
    for (int j = 0; j < 4; ++j) { v[j] = xr[64 * j]; s += (v[j][0] * v[j][0] + v[j][1] * v[j][1]) + (v[j][2] * v[j][2] + v[j][3] * v[j][3]); }
    const float rstd = rsqrtf(wave_sum(s) * (1.f / D) + RMS_EPS);
#pragma unroll
    for (int j = 0; j < 4; ++j) { const f32x4 o = v[j] * rstd * gr[64 * j]; u32x2 w; w.x = pk2(o[0], o[1]); w.y = pk2(o[2], o[3]); *(u32x2*)(orow + 4 * lane + 256 * j) = w; }
}
__device__ __forceinline__ void norm_pass(const float* X, const float* g, bf16* XN, int gw, int NGW, int lane) {
    for (int m = gw; m < M; m += NGW) rms_row_bf16(X + (size_t)m * D, g, XN + (size_t)m * D, lane);
}

__device__ __forceinline__ int fresh_tid(int wave) { int l; asm volatile("v_mbcnt_lo_u32_b32 %0, -1, 0\n\tv_mbcnt_hi_u32_b32 %0, -1, %0" : "=v"(l)); return wave * 64 + l; }
#define XB_TMO      128
#define XB_XCNT(j)  (256  + 64 * (j))
#define XB_XSUB(j)  (1280 + 64 * (j))
#define XB_XGEN(j)  (2304 + 64 * (j))
#define XB_TOP      3328
#define XB_TOPGEN   3392
#define XCD_BAR_WORDS 3456
#define XB_SPIN_CAP (1u << 18)
__device__ __forceinline__ unsigned xb_ld(unsigned* p)              { return __hip_atomic_load(p, __ATOMIC_RELAXED, __HIP_MEMORY_SCOPE_AGENT); }
__device__ __forceinline__ unsigned xb_add(unsigned* p, unsigned v) { return __hip_atomic_fetch_add(p, v, __ATOMIC_RELAXED, __HIP_MEMORY_SCOPE_AGENT); }
__device__ __forceinline__ unsigned xb_xcc_id() { return (unsigned)__builtin_amdgcn_s_getreg((3 << 11) | 20) & 0xFu; }
#define XB_SPIN(cond, bar) do { unsigned _sp = 0; while (cond) { __builtin_amdgcn_s_sleep(1); \
    if ((++_sp & 255u) == 0u) { if (xb_ld(&(bar)[XB_TMO])) break; if (_sp > XB_SPIN_CAP) { atomicAdd(&(bar)[XB_TMO], 1u); break; } } } } while (0)
__device__ __forceinline__ void xcd_barrier_complete(unsigned* bar, unsigned x, unsigned G, unsigned& nloc, unsigned& nx) {
    unsigned sum, cnt, mine, sp = 0u;
    for (;;) {
        sum = 0u; cnt = 0u; mine = 0u;
#pragma unroll
        for (unsigned j = 0; j < 16; ++j) { const unsigned c = xb_ld(&bar[XB_XCNT(j)]); sum += c; cnt += (c > 0u) ? 1u : 0u; mine = (j == x) ? c : mine; }
        if (sum == G) break;
        __builtin_amdgcn_s_sleep(1);
        if ((++sp & 255u) == 0u) { if (xb_ld(&bar[XB_TMO])) break; if (sp > XB_SPIN_CAP) { atomicAdd(&bar[XB_TMO], 1u); break; } }
    }
    nloc = mine > 0u ? mine : 1u; nx = cnt > 0u ? cnt : 1u;
}
__device__ __forceinline__ void xcd_barrier(unsigned* bar, unsigned x, volatile LAS unsigned* st, unsigned G, int tid) {
    asm volatile("s_waitcnt vmcnt(0)" ::: "memory");
    __syncthreads();
    if (tid == 0) {
        __builtin_amdgcn_s_waitcnt(0);
        unsigned nloc = st[0], nx = st[1];
        if (nloc == 0u) { xcd_barrier_complete(bar, x, G, nloc, nx); st[0] = nloc; st[1] = nx; }
        const unsigned old = xb_add(&bar[XB_XSUB(x)], 1u);
        const unsigned gen = old / nloc;
        if (old + 1u == (gen + 1u) * nloc) {
            __builtin_amdgcn_fence(__ATOMIC_RELEASE, "agent");
            asm volatile("s_waitcnt vmcnt(0)" ::: "memory");
            const unsigned og = xb_add(&bar[XB_TOP], 1u);
            const unsigned tg = og / nx;
            if (og + 1u == (tg + 1u) * nx) xb_add(&bar[XB_TOPGEN], 1u);
            else XB_SPIN(xb_ld(&bar[XB_TOPGEN]) == tg, bar);
            __builtin_amdgcn_fence(__ATOMIC_ACQUIRE, "agent");
            xb_add(&bar[XB_XGEN(x)], 1u);
            asm volatile("s_waitcnt vmcnt(0)" ::: "memory");
        } else {
            XB_SPIN(xb_ld(&bar[XB_XGEN(x)]) == gen, bar);
            __builtin_amdgcn_fence(__ATOMIC_ACQUIRE, "agent");
            asm volatile("s_waitcnt vmcnt(0)" ::: "memory");
        }
    }
    __syncthreads();
}

typedef const __attribute__((address_space(4))) Args* KArgs;
__global__ void __launch_bounds__(NTHREADS, 2) hybrid_fwd(Args a_) {
    extern __shared__ __attribute__((aligned(16))) unsigned char lds_raw[];
    LAS unsigned char* lds = (LAS unsigned char*)lds_raw;
    cg::grid_group grid = cg::this_grid();
    const int wave = __builtin_amdgcn_readfirstlane(threadIdx.x >> 6);
    const int G = gridDim.x, bx = blockIdx.x;
    volatile LAS unsigned* const xst = (volatile LAS unsigned*)(lds + EPI_OFF + 16000);
    if (threadIdx.x == 0) { xst[0] = 0u; xst[1] = 0u; }
    if (threadIdx.x == 0) (void)xb_add((unsigned*)(a_.ws + WS_BAR) + XB_XCNT(xb_xcc_id()), 1u);
    __syncthreads();
    if (a_.ph_hi < 0) grid.sync();
    const int vcu = (G % 8 == 0) ? (bx % 8) * (G / 8) + bx / 8 : bx;
    const int gw = vcu * NWAVES + wave, NGW = G * NWAVES;
#ifndef PREFIX_K
#define PREFIX_K 0
#endif
#pragma unroll 1
    for (int pass = (PREFIX_K > 0 ? 0 : 1); pass < 2; ++pass) {
    const int lo = a_.ph_lo, hi = (pass == 0) ? PREFIX_K : a_.ph_hi;
    int ph = 0;
#define a (*ap)
#ifndef PROBE_MASK
#define PROBE_MASK (0ull)
#endif
#define PHASE_BEGIN if (lo <= ph && ph < hi) for (int rep_ = ((PROBE_MASK >> ph) & 1ull) ? 2 : 1; rep_ > 0; --rep_) { KArgs ap = (KArgs)__builtin_amdgcn_kernarg_segment_ptr(); asm volatile("" : "+s"(ap)); int lane; asm volatile("v_mbcnt_lo_u32_b32 %0, -1, 0\n\tv_mbcnt_hi_u32_b32 %0, -1, %0" : "=v"(lane)); const int tid = wave * 64 + lane; (void)tid; unsigned char* const ws = a.ws; float* const outp = a.out; \
    bf16* const XN = WSP(bf16, WS_XN); bf16* const MIX = WSP(bf16, WS_MIX); const float* cosT = WSP(float, WS_COS); const float* sinT = WSP(float, WS_SIN); (void)XN; (void)MIX; (void)cosT; (void)sinT; (void)outp;
#define PHASE_END   if (rep_ == 1 && (ph + 1 < hi || pass == 0)) { xcd_barrier((unsigned*)(ws + WS_BAR), xb_xcc_id(), (volatile LAS unsigned*)(lds + EPI_OFF + 16000), (unsigned)G, tid); } } ++ph;
#define WSP(T, off) ((T*)(ws + (off)))
    using pg8::Gemm; using pg8::Epi; using pg8::StaticOrder;

    PHASE_BEGIN
    {
        LAS float* scr = (LAS float*)(lds + wave * 16384);
        int rot = 0;
        tr_matrix(a.ev_w_in, 1024, 928, 1024, [&](int n0) { return WSP(bf16, W_EVIN) + (size_t)n0 * 1024; }, scr, gw, NGW, lane, rot);
        tr_matrix(a.ev_w_q_up, 256, 768, 256, [&](int n0) { return WSP(bf16, W_QUP) + (size_t)n0 * 256; }, scr, gw, NGW, lane, rot);
        tr_matrix(a.ev_w_kv_up, 128, 1024, 128, [&](int n0) { const int h = n0 >> 7, j0 = n0 & 127; return (j0 < 64 ? WSP(bf16, W_KN) : WSP(bf16, W_V)) + (size_t)(h * 64 + (j0 & 63)) * 128; }, scr, gw, NGW, lane, rot);
        tr_matrix(a.ev_w_out, 1024, 1024, 1024, [&](int n0) { return WSP(bf16, W_EVOUT) + (size_t)n0 * 1024; }, scr, gw, NGW, lane, rot);
        tr_matrix(a.od_w_in, 1024, 2048, 1024, [&](int n0) { return WSP(bf16, W_ODIN) + (size_t)n0 * 1024; }, scr, gw, NGW, lane, rot, a.od_norm);
        for (int h = 0; h < 4; ++h) {
            tr_matrix(a.od_w_rgate + (size_t)h * 65536, 256, 256, 256, [&](int n0) { return WSP(bf16, W_GATE) + (size_t)(256 * (2 * h + (n0 >> 7)) + (n0 & 127)) * 256; }, scr, gw, NGW, lane, rot);
            tr_matrix(a.od_w_igate + (size_t)h * 65536, 256, 256, 256, [&](int n0) { return WSP(bf16, W_GATE) + (size_t)(256 * (2 * h + (n0 >> 7)) + 128 + (n0 & 127)) * 256; }, scr, gw, NGW, lane, rot);
        }
        tr_matrix(a.od_w_out, 1024, 1024, 1024, [&](int n0) { return WSP(bf16, W_ODOUT) + (size_t)n0 * 1024; }, scr, gw, NGW, lane, rot);
        for (int l = 0; l < 2; ++l) {
            tr_matrix(a.xa_w_kv + (size_t)l * 2097152, 1024, 2048, 1024, [&](int n0) { return WSP(bf16, W_XAKV + l * 4 * MiB) + (size_t)n0 * 1024; }, scr, gw, NGW, lane, rot);
            tr_matrix(a.xa_w_o + (size_t)l * 1048576, 1024, 1024, 1024, [&](int n0) { return WSP(bf16, W_XAO + l * 2 * MiB) + (size_t)n0 * 1024; }, scr, gw, NGW, lane, rot);
            tr_matrix(a.ffn_w_gate_up + (size_t)l * 1024 * 5632, 1024, 5632, 1024, [&](int n0) { const int isu = n0 >= DFF, nn = isu ? n0 - DFF : n0; return WSP(bf16, W_FFN1 + l * 11 * MiB) + (size_t)(256 * (nn >> 7) + 128 * isu + (nn & 127)) * 1024; }, scr, gw, NGW, lane, rot, a.ffn_norm + l * D);
            tr_matrix(a.ffn_w_down + (size_t)l * DFF * 1024, DFF, 1024, DFF, [&](int n0) { return WSP(bf16, W_FFN2) + (size_t)l * (1024 * DFF) + (size_t)n0 * DFF; }, scr, gw, NGW, lane, rot);
        }
        const int gt = vcu * NTHREADS + tid, NGT = G * NTHREADS;
        for (int i = gt; i < 512 * 256; i += NGT) { const int n = i >> 8, kk = i & 255, g = n >> 7; float v = 0.f; if ((kk >> 7) == (g & 1)) v = a.ev_pool_w[(size_t)g * 16384 + (size_t)(kk & 127) * 128 + (n & 127)];
            WSP(bf16, W_POOL)[i] = (bf16)(pk2(v, 0.f) & 0xffffu); }
        for (int i = gt; i < 2 * 1024 * 128; i += NGT) { const int l = i >> 17, r = (i >> 7) & 1023, c8 = (i & 127) * 8; const float g = a.xa_norm_x[l * D + r];
            const f32x4 v0 = *(const f32x4*)(a.xa_w_q + (size_t)l * 1048576 + (size_t)r * 1024 + c8), v1 = *(const f32x4*)(a.xa_w_q + (size_t)l * 1048576 + (size_t)r * 1024 + c8 + 4);
            u32x4 o; o.x = pk2(v0[0] * g, v0[1] * g); o.y = pk2(v0[2] * g, v0[3] * g); o.z = pk2(v1[0] * g, v1[1] * g); o.w = pk2(v1[2] * g, v1[3] * g);
            *(u32x4*)(WSP(bf16, W_XAQ + l * 2 * MiB) + (size_t)r * 1024 + c8) = o; }
        for (int i = gt; i < M * 16; i += NGT) { const int row = i >> 4, j = i & 15; const int f = j & 3, e = j >> 2;
            const float fa = f == 0 ? 1.0f : (f == 1 ? 0.5623413251903491f : (f == 2 ? 0.31622776601683794f : 0.1778279410038923f));
            const float fb = e == 0 ? 1.0f : (e == 1 ? 0.1f : (e == 2 ? 0.01f : 0.001f));
            const float inv_freq = fa * fb; const float ang = (float)a.pos[row] * inv_freq;
            const double t = (double)ang * 0.15915494309189535; const float fr = (float)(t - __builtin_floor(t));
            WSP(float, WS_COS)[i] = __builtin_amdgcn_cosf(fr); WSP(float, WS_SIN)[i] = __builtin_amdgcn_sinf(fr); }
        for (int i = gt; i < 6 * M; i += NGT) WSP(float, WS_SSQ)[i] = 0.f;
        for (int i = gt; i < 1024; i += NGT) { const float l = a.od_lambda[i]; const float y = ex2(-l * LOG2E);
            const float sp = (y < 0.03f) ? y * (1.0f - y * (0.5f - y * (1.0f / 3.0f - 0.25f * y))) : 0.6931471805599453f * __builtin_amdgcn_logf(1.0f + y);
            WSP(float, WS_SP8)[i] = 8.0f * sp; }
        for (int r = gw; r < 1024; r += NGW) { const int l = r >> 9, mr = r & 511; rms_row_bf16(a.mem + (size_t)mr * D, a.xa_norm_mem + l * D, WSP(bf16, WS_MN) + (size_t)r * D, lane); }
        norm_pass(a.x, a.ev_norm, XN, gw, NGW, lane);
    }
    PHASE_END

    PHASE_BEGIN
    {
        { Gemm g = pg8::mk(XN, WSP(bf16, W_EVIN), M, 1024, 1024); StaticOrder S; S.init(M, 1024, G, bx);
          Epi E{}; E.mode = pg8::E_EVIN; E.O = WSP(bf16, WS_U); E.O2 = WSP(bf16, WS_CQ); E.O3 = WSP(bf16, WS_CKV); E.O4 = WSP(bf16, WS_KR); E.cosT = cosT; E.sinT = sinT;
          pg8::gemm_phase(lds, g, S, E, fresh_tid(wave)); }
    }
    PHASE_END

    PHASE_BEGIN
    {
        const int NMEMWG = (G >= 64) ? 32 : 0;
        if (bx < NMEMWG) {
            const int l = bx >> 4, isv = (bx >> 3) & 1;
            if (!isv) { Gemm g = pg8::mk(WSP(bf16, WS_MN) + (size_t)l * 512 * D, WSP(bf16, W_XAKV + l * 4 * MiB), 512, 1024, 1024); StaticOrder S; S.init(512, 1024, G, bx & 7);
              Epi E{}; E.mode = pg8::E_PLAIN; E.O = WSP(bf16, WS_MK) + (size_t)l * 512 * D; E.ldc = 1024; E.scale = 1.f; pg8::gemm_phase(lds, g, S, E, fresh_tid(wave)); }
            else { Gemm g = pg8::mk(WSP(bf16, WS_MN) + (size_t)l * 512 * D, WSP(bf16, W_XAKV + l * 4 * MiB) + (size_t)1024 * 1024, 512, 1024, 1024); StaticOrder S; S.init(512, 1024, G, bx & 7);
              Epi E{}; E.mode = pg8::E_PLAIN; E.O = WSP(bf16, WS_MVT) + (size_t)l * 512 * D; E.ldc = 1024; E.scale = 1.f; pg8::gemm_phase(lds, g, S, E, fresh_tid(wave)); }
        } else {
        const int gw = (bx - NMEMWG) * NWAVES + wave, NGW = (G - NMEMWG) * NWAVES;
        const bf16* U = WSP(bf16, WS_U); const bf16* CQ = WSP(bf16, WS_CQ); const bf16* CKV = WSP(bf16, WS_CKV);
        bf16* PO = WSP(bf16, WS_POOLED); bf16* CQN = WSP(bf16, WS_CQN); bf16* CKVN = WSP(bf16, WS_CKVN);
        const int w = 2 << (lane >> 4);
        const f32x4 gq = *(const f32x4*)(a.ev_q_norm + 4 * lane); const f32x2 gk = *(const f32x2*)(a.ev_kv_norm + 2 * lane);
        for (int row = gw; row < M; row += NGW) {
            const int s = row & (SEQ - 1); const int cnt = (s + 1 < w) ? s + 1 : w;
            float sum[8]; float self[8];
            { const u32x4 v = *(const u32x4*)(U + (size_t)row * 512 + 8 * lane);
              self[0] = bflo(v.x); self[1] = bfhi(v.x); self[2] = bflo(v.y); self[3] = bfhi(v.y); self[4] = bflo(v.z); self[5] = bfhi(v.z); self[6] = bflo(v.w); self[7] = bfhi(v.w);
#pragma unroll
              for (int e = 0; e < 8; ++e) sum[e] = self[e]; }
            for (int tt = 1; tt < cnt; ++tt) { const u32x4 v = *(const u32x4*)(U + (size_t)(row - tt) * 512 + 8 * lane);
                sum[0] += bflo(v.x); sum[1] += bfhi(v.x); sum[2] += bflo(v.y); sum[3] += bfhi(v.y); sum[4] += bflo(v.z); sum[5] += bfhi(v.z); sum[6] += bflo(v.w); sum[7] += bfhi(v.w); }
            const float ic = 1.0f / (float)cnt;
            u32x4 o; o.x = pk2(sum[0] * ic - self[0], sum[1] * ic - self[1]); o.y = pk2(sum[2] * ic - self[2], sum[3] * ic - self[3]);
            o.z = pk2(sum[4] * ic - self[4], sum[5] * ic - self[5]); o.w = pk2(sum[6] * ic - self[6], sum[7] * ic - self[7]);
            *(u32x4*)(PO + (size_t)row * 512 + 8 * lane) = o;
            { const u32x2 v = *(const u32x2*)(CQ + (size_t)row * 256 + 4 * lane); const float x0 = bflo(v.x), x1 = bfhi(v.x), x2 = bflo(v.y), x3 = bfhi(v.y);
              const float rstd = rsqrtf(wave_sum((x0 * x0 + x1 * x1) + (x2 * x2 + x3 * x3)) * (1.f / 256.f) + RMS_EPS);
              u32x2 q; q.x = pk2(x0 * rstd * gq[0], x1 * rstd * gq[1]); q.y = pk2(x2 * rstd * gq[2], x3 * rstd * gq[3]); *(u32x2*)(CQN + (size_t)row * 256 + 4 * lane) = q; }
            { const unsigned v = *(const unsigned*)(CKV + (size_t)row * 128 + 2 * lane); const float x0 = bflo(v), x1 = bfhi(v);
              const float rstd = rsqrtf(wave_sum(x0 * x0 + x1 * x1) * (1.f / 128.f) + RMS_EPS);
              *(unsigned*)(CKVN + (size_t)row * 128 + 2 * lane) = pk2(x0 * rstd * gk[0], x1 * rstd * gk[1]); }
        }
        }
    }
    PHASE_END

    PHASE_BEGIN
    {
        { Gemm g = pg8::mk(WSP(bf16, WS_CQN), WSP(bf16, W_QUP), M, 768, 256); StaticOrder S; S.init(M, 768, G, bx);
          Epi E{}; E.mode = pg8::E_QROPE; E.O = WSP(bf16, WS_Q); E.scale = 0.10206207261596577f * LOG2E; E.cosT = cosT; E.sinT = sinT; pg8::gemm_phase(lds, g, S, E, fresh_tid(wave)); }
        { Gemm g = pg8::mk(WSP(bf16, WS_CKVN), WSP(bf16, W_KN), M, 512, 128); StaticOrder S; S.init(M, 512, G, bx);
          Epi E{}; E.mode = pg8::E_PLAIN; E.O = WSP(bf16, WS_KN); E.ldc = 512; E.scale = 1.f; pg8::gemm_phase(lds, g, S, E, fresh_tid(wave)); }
        { Gemm g = pg8::mk(WSP(bf16, W_V), WSP(bf16, WS_CKVN), 512, M, 128); StaticOrder S; S.init(512, M, G, bx);
          Epi E{}; E.mode = pg8::E_VT; E.O = WSP(bf16, WS_VT); E.ldc = M; pg8::gemm_phase(lds, g, S, E, fresh_tid(wave)); }
        { Gemm g = pg8::mk(WSP(bf16, WS_POOLED), WSP(bf16, W_POOL), M, 512, 256); g.lda = 512; g.a_pm_off = 256L * 512; g.a_pn_off = 256; StaticOrder S; S.init(M, 512, G, bx);
          Epi E{}; E.mode = pg8::E_POOL; E.O = MIX; E.ldc = 1024; E.vec0 = a.ev_pool_scale; pg8::gemm_phase(lds, g, S, E, fresh_tid(wave)); }
        { const int idx = bx >> 2;
          if (idx < 16) { const int l = idx >> 3, b = (idx >> 2) & 1, h = idx & 3;
            Gemm g = pg8::mk(WSP(bf16, W_XAO + l * 2 * MiB) + h * 256, WSP(bf16, WS_MVT) + (size_t)l * 512 * D + (size_t)b * 256 * D + h * 256, 1024, 256, 256); g.lda = 1024; g.a_pm_off = 256L * 1024; g.ldb = 1024;
            StaticOrder S; S.init(1024, 256, G, bx & 3);
            Epi E{}; E.mode = pg8::E_PLAIN; E.O = WSP(bf16, WS_WPP) + (size_t)(l * 2 + b) * 1024 * 1024 + h * 256; E.ldc = 1024; E.scale = 1.f; pg8::gemm_phase(lds, g, S, E, fresh_tid(wave)); }
          else if (idx < 32) { const int i2 = idx - 16, l = i2 >> 3, b = (i2 >> 2) & 1, h = i2 & 3;
            Gemm g = pg8::mk(WSP(bf16, WS_MK) + (size_t)l * 512 * D + (size_t)b * 256 * D + h * 256, WSP(bf16, W_XAQ + l * 2 * MiB) + h * 256, 256, 1024, 256); g.lda = 1024; g.ldb = 1024; g.b_pn_off = 256L * 1024;
            StaticOrder S; S.init(256, 1024, G, bx & 3);
            Epi E{}; E.mode = pg8::E_PLAIN; E.O = WSP(bf16, WS_WQK) + (size_t)(l * 2 + b) * 1024 * 1024 + (size_t)h * 256 * 1024; E.ldc = 1024; E.scale = 1.f; pg8::gemm_phase(lds, g, S, E, fresh_tid(wave)); } }
    }
    PHASE_END

    PHASE_BEGIN
    {
        for (int vw = vcu; vw < 256; vw += G) { const int bh = vw >> 4, s = vw & 15;
#pragma unroll 1
            for (int i = 0; i < 4; ++i) { const int qb = (i == 0) ? 63 - s : (i == 1) ? s : (i == 2) ? 32 + s : 31 - s;
                size_t z0 = 0; asm volatile("" : "+s"(z0)); unsigned char* w2 = ws + z0;
                att::attn_unit(bh >> 3, bh & 7, qb, (const bf16*)(w2 + WS_Q), (const bf16*)(w2 + WS_KN), (const bf16*)(w2 + WS_KR), (const bf16*)(w2 + WS_VT), (bf16*)(w2 + WS_MIX) + 512, lds, fresh_tid(wave)); } }
    }
    PHASE_END

    PHASE_BEGIN
    { Gemm g = pg8::mk(MIX, WSP(bf16, W_EVOUT), M, 1024, 1024); StaticOrder S; S.init(M, 1024, G, bx);
      Epi E{}; E.mode = pg8::E_RES; E.base = a.x; E.out = outp; E.O = XN; E.aout = WSP(float, WS_SSQ); pg8::gemm_phase(lds, g, S, E, fresh_tid(wave)); }
    PHASE_END

#pragma unroll 1
    for (int l = 0; l < 2; ++l) {
        if (l == 1) {
            PHASE_BEGIN
            { Gemm g = pg8::mk(XN, WSP(bf16, W_ODIN), M, 2048, 1024); StaticOrder S; S.init(M, 2048, G, bx);
              Epi E{}; E.mode = pg8::E_ODIN; E.O = WSP(bf16, WS_GB); E.O2 = WSP(bf16, WS_XBP); E.vec0 = WSP(float, WS_SSQ) + 2 * (size_t)M; pg8::gemm_phase(lds, g, S, E, fresh_tid(wave)); }
            PHASE_END
            PHASE_BEGIN
            {
                const bf16* XBP = WSP(bf16, WS_XBP); bf16* XB = XN;
                const int half = gw & 1; const int c0 = half * 512 + 8 * lane;
                float wv[4][8], bias[8];
#pragma unroll
                for (int j = 0; j < 4; ++j)
#pragma unroll
                    for (int e = 0; e < 8; ++e) wv[j][e] = a.od_conv_w[j * 1024 + c0 + e];
#pragma unroll
                for (int e = 0; e < 8; ++e) bias[e] = a.od_conv_b[c0 + e];
                for (int row = gw >> 1; row < M; row += NGW >> 1) { const int s = row & (SEQ - 1); float acc[8];
#pragma unroll
                    for (int e = 0; e < 8; ++e) acc[e] = bias[e];
#pragma unroll
                    for (int j = 0; j < 4; ++j) { if (s - 3 + j >= 0) { const u32x4 v = *(const u32x4*)(XBP + (size_t)(row - 3 + j) * D + c0);
                        acc[0] += wv[j][0] * bflo(v.x); acc[1] += wv[j][1] * bfhi(v.x); acc[2] += wv[j][2] * bflo(v.y); acc[3] += wv[j][3] * bfhi(v.y);
                        acc[4] += wv[j][4] * bflo(v.z); acc[5] += wv[j][5] * bfhi(v.z); acc[6] += wv[j][6] * bflo(v.w); acc[7] += wv[j][7] * bfhi(v.w); } }
                    u32x4 o; o.x = pk2(acc[0], acc[1]); o.y = pk2(acc[2], acc[3]); o.z = pk2(acc[4], acc[5]); o.w = pk2(acc[6], acc[7]);
                    *(u32x4*)(XB + (size_t)row * D + c0) = o; }
            }
            PHASE_END
            PHASE_BEGIN
            { Gemm g = pg8::mk(XN, WSP(bf16, W_GATE), M, 2048, 256); g.lda = 1024; g.a_pm_off = 256L * 1024; g.a_pn_off = 256; g.a_pn_shift = 1; StaticOrder S; S.init(M, 2048, G, bx);
              Epi E{}; E.mode = pg8::E_GATE; E.O = WSP(bf16, WS_B); E.aout = WSP(float, WS_A); E.vec0 = a.od_b_rgate; E.vec1 = a.od_b_igate; E.vec2 = WSP(float, WS_SP8); E.pos = a.pos; E.xb = XN;
              pg8::gemm_phase(lds, g, S, E, fresh_tid(wave)); }
            PHASE_END
            PHASE_BEGIN
            {
                const float* A_ = WSP(float, WS_A); const bf16* B_ = WSP(bf16, WS_B);
                for (int it = vcu; it < 256; it += G) { const size_t r0 = (size_t)it * 128; const int c = 2 * tid;
                    float A0 = 1.f, A1 = 1.f, B0 = 0.f, B1 = 0.f;
#pragma unroll 8
                    for (int t = 0; t < 128; ++t) { const f32x2 av = *(const f32x2*)(A_ + (r0 + t) * D + c); const unsigned bw = *(const unsigned*)(B_ + (r0 + t) * D + c);
                        B0 = av[0] * B0 + bflo(bw); B1 = av[1] * B1 + bfhi(bw); A0 *= av[0]; A1 *= av[1]; }
                    *(f32x2*)(WSP(float, WS_CA) + (size_t)it * D + c) = (f32x2){A0, A1}; *(f32x2*)(WSP(float, WS_CB) + (size_t)it * D + c) = (f32x2){B0, B1}; }
            }
            PHASE_END
            PHASE_BEGIN
            {
                const float* A_ = WSP(float, WS_A); const bf16* B_ = WSP(bf16, WS_B); const bf16* GB = WSP(bf16, WS_GB);
                for (int it = vcu; it < 256; it += G) { const size_t r0 = (size_t)it * 128; const int c = 2 * tid; const int j = it & 127, it0 = it - j;
                    float h0 = 0.f, h1 = 0.f;
#pragma unroll 8
                    for (int jj = 0; jj < j; ++jj) { const f32x2 ca = *(const f32x2*)(WSP(float, WS_CA) + (size_t)(it0 + jj) * D + c), cb = *(const f32x2*)(WSP(float, WS_CB) + (size_t)(it0 + jj) * D + c);
                        h0 = ca[0] * h0 + cb[0]; h1 = ca[1] * h1 + cb[1]; }
#pragma unroll 8
                    for (int t = 0; t < 128; ++t) { const f32x2 av = *(const f32x2*)(A_ + (r0 + t) * D + c); const unsigned bw = *(const unsigned*)(B_ + (r0 + t) * D + c); const unsigned gv = *(const unsigned*)(GB + (r0 + t) * D + c);
                        h0 = av[0] * h0 + bflo(bw); h1 = av[1] * h1 + bfhi(bw);
                        *(unsigned*)(MIX + (r0 + t) * D + c) = pk2(bflo(gv) * h0, bfhi(gv) * h1); }
                }
            }
            PHASE_END
            PHASE_BEGIN
            { Gemm g = pg8::mk(MIX, WSP(bf16, W_ODOUT), M, 1024, 1024); StaticOrder S; S.init(M, 1024, G, bx);
              Epi E{}; E.mode = pg8::E_RES; E.base = outp; E.out = outp; E.O = XN; E.aout = WSP(float, WS_SSQ) + 3 * (size_t)M; pg8::gemm_phase(lds, g, S, E, fresh_tid(wave)); }
            PHASE_END
        }
        PHASE_BEGIN
        { Gemm g = pg8::mk(XN, WSP(bf16, WS_WQK) + (size_t)l * 2 * 1024 * 1024, M, 1024, 1024); g.b_pm_div = 64; g.b_pm_off = 1024L * 1024; StaticOrder S; S.init(M, 1024, G, bx);
          Epi E{}; E.mode = pg8::E_SOFTMAX; E.O = WSP(bf16, WS_P); E.ldc = 1024; E.scale = 0.0625f * LOG2E; E.vec0 = WSP(float, WS_SSQ) + (size_t)(3 * l) * M; pg8::gemm_phase(lds, g, S, E, fresh_tid(wave)); }
        PHASE_END
        PHASE_BEGIN
        { Gemm g = pg8::mk(WSP(bf16, WS_P), WSP(bf16, WS_WPP) + (size_t)l * 2 * 1024 * 1024, M, 1024, 1024); g.b_pm_div = 64; g.b_pm_off = 1024L * 1024; StaticOrder S; S.init(M, 1024, G, bx);
          Epi E{}; E.mode = pg8::E_RES; E.base = outp; E.out = outp; E.O = XN; E.aout = WSP(float, WS_SSQ) + (size_t)(3 * l + 1) * M; pg8::gemm_phase(lds, g, S, E, fresh_tid(wave)); }
        PHASE_END
        PHASE_BEGIN
        { Gemm g = pg8::mk(XN, WSP(bf16, W_FFN1 + l * 11 * MiB), M, 2 * DFF, 1024); StaticOrder S; S.init(M, 2 * DFF, G, bx);
          Epi E{}; E.mode = pg8::E_SWIGLU; E.O = WSP(bf16, WS_H); E.vec0 = WSP(float, WS_SSQ) + (size_t)(3 * l + 1) * M; pg8::gemm_phase(lds, g, S, E, fresh_tid(wave)); }
        PHASE_END
        PHASE_BEGIN
        { Gemm g = pg8::mk(WSP(bf16, WS_H), WSP(bf16, W_FFN2) + (size_t)l * (1024 * DFF), M, 1024, DFF); StaticOrder S; S.init(M, 1024, G, bx);
          Epi E{}; E.mode = pg8::E_RES; E.base = outp; E.out = outp; E.O = (l == 0) ? XN : nullptr; E.aout = WSP(float, WS_SSQ) + (size_t)(l == 0 ? 2 : 5) * M; pg8::gemm_phase(lds, g, S, E, fresh_tid(wave)); }
        PHASE_END
    }

    PHASE_BEGIN
    {
        const f32x4* gr = (const f32x4*)a.final_norm + lane; const float* ssq = WSP(float, WS_SSQ) + 5 * (size_t)M;
        for (int m = gw; m < M; m += NGW) { f32x4* xr = (f32x4*)(outp + (size_t)m * D) + lane; const float rstd = rsqrtf(ssq[m] * (1.f / D) + RMS_EPS);
#pragma unroll
            for (int j = 0; j < 4; ++j) xr[64 * j] = xr[64 * j] * rstd * gr[64 * j]; }
    }
    PHASE_END
    }
}
#undef a
constexpr int N_PHASES = 6 + 6 + 8 + 1;

#ifndef MK_N_LAUNCHES
#define MK_N_LAUNCHES 1
#endif
extern "C" void kernel_launch(void* const* d_in, const int* in_sizes, int n_in, void* d_out, int out_size, void* d_ws, size_t ws_size, hipStream_t stream) {
    static int grid = 0;
    if (grid == 0) {
        if (n_in != 31 || ws_size < WS_NEED) { fprintf(stderr, "kernel_launch: unexpected n_in %d or ws_size %zu\n", n_in, ws_size); grid = -1; return; }
        int dev = 0, cus = 0, per_cu = 0;
        hipGetDevice(&dev); hipDeviceGetAttribute(&cus, hipDeviceAttributeMultiprocessorCount, dev);
        if (hipFuncSetAttribute((const void*)hybrid_fwd, hipFuncAttributeMaxDynamicSharedMemorySize, LDS_BYTES) != hipSuccess) { fprintf(stderr, "kernel_launch: hipFuncSetAttribute failed\n"); grid = -1; return; }
        hipOccupancyMaxActiveBlocksPerMultiprocessor(&per_cu, (const void*)hybrid_fwd, NTHREADS, LDS_BYTES);
        (void)hipGetLastError();
        if (per_cu < 1) per_cu = 1;
        grid = cus * 1;
        if (grid > 256) grid = 256;
    }
    if (grid < 0) return;
    Args a{};
    const float* const* f = (const float* const*)d_in;
    a.x = f[0]; a.mem = f[1]; a.pos = (const int*)d_in[2];
    a.ev_norm = f[3]; a.ev_w_in = f[4]; a.ev_pool_w = f[5]; a.ev_pool_scale = f[6]; a.ev_q_norm = f[7]; a.ev_w_q_up = f[8]; a.ev_kv_norm = f[9]; a.ev_w_kv_up = f[10]; a.ev_w_out = f[11];
    a.od_norm = f[12]; a.od_w_in = f[13]; a.od_conv_w = f[14]; a.od_conv_b = f[15]; a.od_w_rgate = f[16]; a.od_b_rgate = f[17]; a.od_w_igate = f[18]; a.od_b_igate = f[19]; a.od_lambda = f[20]; a.od_w_out = f[21];
    a.xa_norm_x = f[22]; a.xa_norm_mem = f[23]; a.xa_w_q = f[24]; a.xa_w_kv = f[25]; a.xa_w_o = f[26]; a.ffn_norm = f[27]; a.ffn_w_gate_up = f[28]; a.ffn_w_down = f[29]; a.final_norm = f[30];
    a.out = (float*)d_out; a.ws = (unsigned char*)d_ws;
#if MK_N_LAUNCHES == 1
    if (hipMemsetAsync((unsigned char*)d_ws + WS_BAR, 0, 16384, stream) != hipSuccess) { fprintf(stderr, "kernel_launch: memset failed\n"); return; }
    a.ph_lo = 0; a.ph_hi = N_PHASES;
    void* args[] = {&a};
    hipError_t e = hipLaunchCooperativeKernel((const void*)hybrid_fwd, dim3(grid), dim3(NTHREADS), args, LDS_BYTES, stream);
    if (e != hipSuccess) fprintf(stderr, "kernel_launch: cooperative launch failed: %s (grid %d)\n", hipGetErrorString(e), grid);
#else
    for (int p = 0; p < N_PHASES; ++p) { a.ph_lo = p; a.ph_hi = p + 1; hipLaunchKernelGGL(hybrid_fwd, dim3(grid), dim3(NTHREADS), LDS_BYTES, stream, a); }
#endif
}
```

```cpp
#include <hip/hip_runtime.h>
#include <hip/hip_cooperative_groups.h>
#include <cstdio>
#include <cstdint>
namespace cg = cooperative_groups;

#define LAS __attribute__((address_space(3)))
typedef unsigned short bf16;
typedef short bf16x8 __attribute__((ext_vector_type(8)));
typedef short s16x4 __attribute__((ext_vector_type(4)));
typedef float f32x4 __attribute__((ext_vector_type(4)));
typedef float f32x2 __attribute__((ext_vector_type(2)));
typedef float f32x16 __attribute__((ext_vector_type(16)));
typedef unsigned u32x4 __attribute__((ext_vector_type(4)));
typedef unsigned u32x2 __attribute__((ext_vector_type(2)));

constexpr int SEQ = 16384, BATCH = 2, M = BATCH * SEQ, D = 1024;
constexpr int DFF = 2816;
constexpr float RMS_EPS = 1e-6f;
constexpr float LOG2E = 1.4426950408889634f;
constexpr int NTHREADS = 512, NWAVES = 8;
constexpr int RING_BYTES = 131072, LDS_BYTES = 147456, EPI_OFF = RING_BYTES;

typedef __bf16 bf16x2_t __attribute__((ext_vector_type(2)));
__device__ __forceinline__ unsigned pk2(float lo, float hi) { f32x2 v = {lo, hi}; bf16x2_t b = __builtin_convertvector(v, bf16x2_t); return __builtin_bit_cast(unsigned, b); }
__device__ __forceinline__ float bflo(unsigned w) { return __uint_as_float(w << 16); }
__device__ __forceinline__ float bfhi(unsigned w) { return __uint_as_float(w & 0xffff0000u); }
__device__ __forceinline__ float ex2(float x) { return __builtin_amdgcn_exp2f(x); }
__device__ __forceinline__ float rcp(float x) { return __builtin_amdgcn_rcpf(x); }
__device__ __forceinline__ float sigmoidf_(float x) { return rcp(1.0f + ex2(-x * LOG2E)); }
__device__ __forceinline__ float gelu_tanh(float x) { const float u = 0.7978845608028654f * (x + 0.044715f * x * x * x); return x * sigmoidf_(2.0f * u); }
__device__ __forceinline__ float wave_sum(float v) {
#pragma unroll
    for (int o = 1; o < 64; o <<= 1) v += __shfl_xor(v, o);
    return v;
}
#define LDS_WAIT() asm volatile("s_waitcnt lgkmcnt(0)" ::: "memory")

namespace pg8 {
constexpr int BM = 256, BK = 64, HALF = 128, HTB = HALF * BK * 2, NXCD = 8, WGM = 4;
__host__ __device__ __forceinline__ int lds_byte(int r, int c) { const int st = (r >> 4) * 2 + (c >> 5), rr = r & 15, cc = c & 31, ob = rr * 64 + cc * 2; return st * 1024 + (ob ^ (((ob >> 9) & 1) << 5)); }
__host__ __device__ __forceinline__ void stage_rc(int b, int& R, int& C) { const int st = b / 1024, sb = b % 1024, swz = sb ^ (((sb >> 9) & 1) << 5); R = (st >> 1) * 16 + swz / 64; C = (st & 1) * 32 + (swz % 64) / 2; }
struct Unit { int pm, pn; };
struct Gemm { const bf16* A; const bf16* Bt; int Mr, N, K, lda, ldb; long a_pm_off, a_pn_off; int a_pn_shift; long b_pn_off; int b_pm_div; long b_pm_off; };
__device__ __forceinline__ Gemm mk(const bf16* A, const bf16* Bt, int Mr, int N, int K) {
    Gemm g; g.A = A; g.Bt = Bt; g.Mr = Mr; g.N = N; g.K = K; g.lda = K; g.ldb = K; g.a_pm_off = 256L * K; g.a_pn_off = 0; g.a_pn_shift = 0; g.b_pn_off = 256L * K; g.b_pm_div = 1 << 30; g.b_pm_off = 0; return g; }
struct StaticOrder {
    int nM, nN, nwg, G, c;
    __device__ void init(int Mr, int N, int G_, int c_) { nM = Mr / BM; nN = N / BM; nwg = nM * nN; G = G_; c = c_; }
    __device__ bool next(int i, Unit& u) const {
        const long L = (long)i * G + c; if (L >= nwg) return false;
        int wgid = (int)L; { const int q = nwg / NXCD, r = nwg % NXCD, xcd = wgid % NXCD, off = wgid / NXCD; wgid = (xcd < r ? xcd * (q + 1) : r * (q + 1) + (xcd - r) * q) + off; }
        const int nig = WGM * nN, gid = wgid / nig, fm = gid * WGM, gsz = (nM - fm) < WGM ? (nM - fm) : WGM;
        u.pm = fm + ((wgid % nig) % gsz); u.pn = (wgid % nig) / gsz; return true;
    }
};

enum { E_PLAIN = 0, E_EVIN, E_QROPE, E_POOL, E_RES, E_SOFTMAX, E_SWIGLU, E_ODIN, E_GATE, E_VT };
struct Epi {
    int mode;
    bf16* O; int ldc; float scale;
    bf16 *O2, *O3, *O4;
    const float* base; float* out;
    const float *cosT, *sinT;
    const float *vec0, *vec1, *vec2;
    const int* pos;
    const bf16* xb; float* aout;
};
__device__ __forceinline__ void st8(bf16* p, f32x4 v0, f32x4 v1) { u32x4 w; w.x = pk2(v0[0], v0[1]); w.y = pk2(v0[2], v0[3]); w.z = pk2(v1[0], v1[1]); w.w = pk2(v1[2], v1[3]); *(u32x4*)p = w; }
__device__ __forceinline__ void st4(bf16* p, f32x4 v) { u32x2 w; w.x = pk2(v[0], v[1]); w.y = pk2(v[2], v[3]); *(u32x2*)p = w; }

__device__ __forceinline__ void run_epi(const Epi& E, f32x4 (&acc)[2][2][4][2], const Unit& u, int wr, int wc, int fr, int fq, LAS unsigned char* lds) {
    const int rowb = u.pm * BM + wr * 64 + fr, colb = u.pn * BM + wc * 32 + 4 * fq;
    const int colp = u.pn * BM + wc * 32 + 8 * fq;
    switch (E.mode) {
    case E_PLAIN: {
#pragma unroll
        for (int ai = 0; ai < 2; ++ai)
#pragma unroll
            for (int m = 0; m < 4; ++m) { const size_t row = (size_t)(rowb + ai * HALF + m * 16); bf16* rp = E.O + row * E.ldc + colp;
                float sc = E.scale; if (E.vec0) sc *= rsqrtf(E.vec0[row] * (1.f / D) + RMS_EPS);
#pragma unroll
                for (int bj = 0; bj < 2; ++bj) st8(rp + bj * HALF, acc[ai][bj][m][0] * sc, acc[ai][bj][m][1] * sc); }
    } break;
    case E_EVIN: {
        const int pn = u.pn;
#pragma unroll
        for (int ai = 0; ai < 2; ++ai)
#pragma unroll
            for (int m = 0; m < 4; ++m) { const size_t row = (size_t)(rowb + ai * HALF + m * 16);
                if (pn < 2) { bf16* rp = E.O + row * 512 + colb;
#pragma unroll
                    for (int bj = 0; bj < 2; ++bj)
#pragma unroll
                        for (int n = 0; n < 2; ++n) st4(rp + bj * HALF + n * 16, acc[ai][bj][m][n]);
                } else if (pn == 2) { bf16* rp = E.O2 + row * 256 + (colb - 512);
#pragma unroll
                    for (int bj = 0; bj < 2; ++bj)
#pragma unroll
                        for (int n = 0; n < 2; ++n) st4(rp + bj * HALF + n * 16, acc[ai][bj][m][n]);
                } else { bf16* rp = E.O3 + row * 128 + (colb - 768);
#pragma unroll
                    for (int n = 0; n < 2; ++n) st4(rp + n * 16, acc[ai][0][m][n]);
                    if (wc == 0) { const f32x4 c = *(const f32x4*)(E.cosT + row * 16 + 4 * fq), s = *(const f32x4*)(E.sinT + row * 16 + 4 * fq);
                        const f32x4 v0 = acc[ai][1][m][0], v1 = acc[ai][1][m][1];
                        st4(E.O4 + row * 32 + 4 * fq, v0 * c - v1 * s); st4(E.O4 + row * 32 + 16 + 4 * fq, v1 * c + v0 * s); }
                } }
    } break;
    case E_QROPE: {
#pragma unroll
        for (int bj = 0; bj < 2; ++bj) { const int cb = u.pn * BM + bj * HALF + wc * 32; const bool rope = (cb % 96) == 64;
#pragma unroll
            for (int ai = 0; ai < 2; ++ai)
#pragma unroll
                for (int m = 0; m < 4; ++m) { const size_t row = (size_t)(rowb + ai * HALF + m * 16); bf16* rp = E.O + row * 768 + cb + 4 * fq;
                    f32x4 v0 = acc[ai][bj][m][0] * E.scale, v1 = acc[ai][bj][m][1] * E.scale;
                    if (rope) { const f32x4 c = *(const f32x4*)(E.cosT + row * 16 + 4 * fq), s = *(const f32x4*)(E.sinT + row * 16 + 4 * fq);
                        const f32x4 o0 = v0 * c - v1 * s, o1 = v1 * c + v0 * s; v0 = o0; v1 = o1; }
                    st4(rp, v0); st4(rp + 16, v1); } }
    } break;
    case E_POOL: {
#pragma unroll
        for (int bj = 0; bj < 2; ++bj) { const int col = colp + bj * HALF; const f32x4 s0 = *(const f32x4*)(E.vec0 + col), s1 = *(const f32x4*)(E.vec0 + col + 4);
#pragma unroll
            for (int ai = 0; ai < 2; ++ai)
#pragma unroll
                for (int m = 0; m < 4; ++m) st8(E.O + (size_t)(rowb + ai * HALF + m * 16) * E.ldc + col, acc[ai][bj][m][0] * s0, acc[ai][bj][m][1] * s1); }
    } break;
    case E_RES: {
        f32x4 bs[2][2][2][2];
#define RES_LOAD(ch) do { _Pragma("unroll") for (int g_ = 0; g_ < 2; ++g_) { const int ai_ = (ch) >> 1, m_ = 2 * ((ch) & 1) + g_; const size_t off_ = (size_t)(rowb + ai_ * HALF + m_ * 16) * D + colp; \
            _Pragma("unroll") for (int bj = 0; bj < 2; ++bj) _Pragma("unroll") for (int n = 0; n < 2; ++n) bs[(ch) & 1][g_][bj][n] = *(const f32x4*)(E.base + off_ + bj * HALF + n * 4); } } while (0)
        RES_LOAD(0);
#pragma unroll
        for (int ch = 0; ch < 4; ++ch) {
            if (ch < 3) RES_LOAD(ch + 1);
#pragma unroll
            for (int g_ = 0; g_ < 2; ++g_) { const int ai = ch >> 1, m = 2 * (ch & 1) + g_; const size_t row = (size_t)(rowb + ai * HALF + m * 16); const size_t off = row * D + colp; float q = 0.f;
#pragma unroll
                for (int bj = 0; bj < 2; ++bj) { const f32x4 o0 = bs[ch & 1][g_][bj][0] + acc[ai][bj][m][0], o1 = bs[ch & 1][g_][bj][1] + acc[ai][bj][m][1];
                    *(f32x4*)(E.out + off + bj * HALF) = o0; *(f32x4*)(E.out + off + bj * HALF + 4) = o1;
                    if (E.O) st8(E.O + off + bj * HALF, o0, o1);
                    q += (o0[0] * o0[0] + o0[1] * o0[1]) + (o0[2] * o0[2] + o0[3] * o0[3]) + (o1[0] * o1[0] + o1[1] * o1[1]) + (o1[2] * o1[2] + o1[3] * o1[3]); }
                q += __shfl_xor(q, 16); q += __shfl_xor(q, 32);
                if (fq == 0) atomicAdd(E.aout + row, q); }
            asm volatile("" ::: "memory"); }
#undef RES_LOAD
    } break;
    case E_SOFTMAX: {
        LAS float* RM = (LAS float*)(lds + EPI_OFF);
        LAS float* RS = (LAS float*)(lds + EPI_OFF + 4096);
#pragma unroll
        for (int ai = 0; ai < 2; ++ai)
#pragma unroll
            for (int m = 0; m < 4; ++m) { float mx = -3.0e38f;
                float sc = E.scale; if (E.vec0) sc *= rsqrtf(E.vec0[(size_t)(rowb + ai * HALF + m * 16)] * (1.f / D) + RMS_EPS);
#pragma unroll
                for (int bj = 0; bj < 2; ++bj)
#pragma unroll
                    for (int n = 0; n < 2; ++n) { const f32x4 x = acc[ai][bj][m][n] * sc; acc[ai][bj][m][n] = x; mx = fmaxf(mx, fmaxf(fmaxf(x[0], x[1]), fmaxf(x[2], x[3]))); }
                mx = fmaxf(mx, __shfl_xor(mx, 16)); mx = fmaxf(mx, __shfl_xor(mx, 32));
                if (fq == 0) RM[(ai * HALF + wr * 64 + m * 16 + fr) * 4 + wc] = mx; }
        LDS_WAIT(); __builtin_amdgcn_s_barrier(); asm volatile("" ::: "memory");
#pragma unroll
        for (int ai = 0; ai < 2; ++ai)
#pragma unroll
            for (int m = 0; m < 4; ++m) { const int rl = ai * HALF + wr * 64 + m * 16 + fr; const f32x4 mm = *(LAS f32x4*)(RM + rl * 4);
                const float mx = fmaxf(fmaxf(mm[0], mm[1]), fmaxf(mm[2], mm[3])); float s = 0.f;
#pragma unroll
                for (int bj = 0; bj < 2; ++bj)
#pragma unroll
                    for (int n = 0; n < 2; ++n) { f32x4 x = acc[ai][bj][m][n]; x[0] = ex2(x[0] - mx); x[1] = ex2(x[1] - mx); x[2] = ex2(x[2] - mx); x[3] = ex2(x[3] - mx); acc[ai][bj][m][n] = x; s += (x[0] + x[1]) + (x[2] + x[3]); }
                s += __shfl_xor(s, 16); s += __shfl_xor(s, 32);
                if (fq == 0) RS[rl * 4 + wc] = s; }
        LDS_WAIT(); __builtin_amdgcn_s_barrier(); asm volatile("" ::: "memory");
#pragma unroll
        for (int ai = 0; ai < 2; ++ai)
#pragma unroll
            for (int m = 0; m < 4; ++m) { const int rl = ai * HALF + wr * 64 + m * 16 + fr; const f32x4 ss = *(LAS f32x4*)(RS + rl * 4);
                const float inv = rcp((ss[0] + ss[1]) + (ss[2] + ss[3])); bf16* rp = E.O + (size_t)(u.pm * BM + rl) * E.ldc + colp;
#pragma unroll
                for (int bj = 0; bj < 2; ++bj) st8(rp + bj * HALF, acc[ai][bj][m][0] * inv, acc[ai][bj][m][1] * inv); }
    } break;
    case E_SWIGLU: {
        const int colh = u.pn * HALF + wc * 32 + 8 * fq;
#pragma unroll
        for (int ai = 0; ai < 2; ++ai)
#pragma unroll
            for (int m = 0; m < 4; ++m) { const size_t row = (size_t)(rowb + ai * HALF + m * 16); const float rs = rsqrtf(E.vec0[row] * (1.f / D) + RMS_EPS); f32x4 o[2];
#pragma unroll
                for (int n = 0; n < 2; ++n) { const f32x4 g = acc[ai][0][m][n] * rs, uu = acc[ai][1][m][n] * rs;
#pragma unroll
                    for (int e = 0; e < 4; ++e) o[n][e] = g[e] * sigmoidf_(g[e]) * uu[e]; }
                st8(E.O + row * DFF + colh, o[0], o[1]); }
    } break;
    case E_ODIN: {
        const bool isg = u.pn < 4;
#pragma unroll
        for (int ai = 0; ai < 2; ++ai)
#pragma unroll
            for (int m = 0; m < 4; ++m) { const size_t row = (size_t)(rowb + ai * HALF + m * 16); const float rs = rsqrtf(E.vec0[row] * (1.f / D) + RMS_EPS);
                bf16* rp = (isg ? E.O + row * D + colp : E.O2 + row * D + (colp - D));
#pragma unroll
                for (int bj = 0; bj < 2; ++bj) { f32x4 v0 = acc[ai][bj][m][0] * rs, v1 = acc[ai][bj][m][1] * rs;
                    if (isg) {
#pragma unroll
                        for (int e = 0; e < 4; ++e) { v0[e] = gelu_tanh(v0[e]); v1[e] = gelu_tanh(v1[e]); } }
                    st8(rp + bj * HALF, v0, v1); } }
    } break;
    case E_GATE: {
        const int c = (u.pn >> 1) * 256 + (u.pn & 1) * HALF + wc * 32 + 8 * fq;
        f32x4 br[2], bi[2], sp[2];
#pragma unroll
        for (int n = 0; n < 2; ++n) { br[n] = *(const f32x4*)(E.vec0 + c + 4 * n); bi[n] = *(const f32x4*)(E.vec1 + c + 4 * n); sp[n] = *(const f32x4*)(E.vec2 + c + 4 * n); }
#pragma unroll
        for (int ai = 0; ai < 2; ++ai) {
            u32x4 xws[4]; int pss[4];
#pragma unroll
            for (int m = 0; m < 4; ++m) { const size_t row = (size_t)(rowb + ai * HALF + m * 16); xws[m] = *(const u32x4*)(E.xb + row * D + c); pss[m] = E.pos[row]; }
#pragma unroll
            for (int m = 0; m < 4; ++m) { const size_t row = (size_t)(rowb + ai * HALF + m * 16); const bool rst = pss[m] == 0;
                const u32x4 xw = xws[m]; const float xv[8] = {bflo(xw.x), bfhi(xw.x), bflo(xw.y), bfhi(xw.y), bflo(xw.z), bfhi(xw.z), bflo(xw.w), bfhi(xw.w)};
                f32x4 av[2], bv[2];
#pragma unroll
                for (int n = 0; n < 2; ++n) { const f32x4 pr = acc[ai][0][m][n] + br[n], pi = acc[ai][1][m][n] + bi[n];
#pragma unroll
                    for (int e = 0; e < 4; ++e) { const float r = sigmoidf_(pr[e]), ig = sigmoidf_(pi[e]); const float la = -sp[n][e] * r; float a = ex2(la * LOG2E);
                        const float x2 = 2.0f * la; const float om = (x2 > -0.01f) ? -(x2 + x2 * x2 * (0.5f + x2 * (1.0f / 6.0f))) : 1.0f - ex2(x2 * LOG2E);
                        float mult = sqrtf(fmaxf(om, 0.f)); if (rst) { a = 0.f; mult = 1.f; }
                        av[n][e] = a; bv[n][e] = mult * (ig * xv[4 * n + e]); } }
                *(f32x4*)(E.aout + row * D + c) = av[0]; *(f32x4*)(E.aout + row * D + c + 4) = av[1]; st8(E.O + row * D + c, bv[0], bv[1]); }
            asm volatile("" ::: "memory"); }
    } break;
    case E_VT: {
#pragma unroll
        for (int ai = 0; ai < 2; ++ai)
#pragma unroll
            for (int m = 0; m < 4; ++m) { const size_t row = (size_t)(rowb + ai * HALF + m * 16);
#pragma unroll
                for (int bj = 0; bj < 2; ++bj) { const int col = colp + bj * HALF, b16 = col & ~15, hf = (col >> 3) & 1; bf16* rp = E.O + row * E.ldc + b16 + 4 * hf;
                    st4(rp, acc[ai][bj][m][0]); st4(rp + 8, acc[ai][bj][m][1]); } }
    } break;
    default: break;
    }
}

__device__ __forceinline__ void gemm_phase(LAS unsigned char* lds, const Gemm g, const StaticOrder& S, const Epi& E, const int tid) {
    const int wid = __builtin_amdgcn_readfirstlane(tid >> 6), lane = tid & 63, wr = wid >> 2, wc = wid & 3, fr = lane & 15, fq = lane >> 4;
    const int K = g.K, nt = K / BK;
    unsigned voffA, voffB;
    { int R, C; stage_rc(tid * 16, R, C); const bool perm = (E.mode != E_EVIN) && (E.mode != E_QROPE);
      const int rho = R & 31, Rb = perm ? ((R & ~31) + 8 * ((rho & 15) >> 2) + 4 * (rho >> 4) + (rho & 3)) : R;
      voffA = (unsigned)(R * g.lda + C) * 2u; voffB = (unsigned)(Rb * g.ldb + C) * 2u; }
    const size_t q64A = (size_t)64 * g.lda * 2, q64B = (size_t)64 * g.ldb * 2;
    const size_t kstep = (size_t)(BK * 2);
    const size_t hstepA = (size_t)HALF * g.lda * 2, hstepB = (size_t)HALF * g.ldb * 2;
    const unsigned ldsw = (unsigned)wid * 1024u;
    const int aoff = lds_byte(wr * 64 + fr, fq * 8), boff = lds_byte(wc * 32 + fr, fq * 8);
#define PG8_ABASE(u) ((const char*)g.A + ((size_t)(u).pm * g.a_pm_off + (size_t)((u).pn >> g.a_pn_shift) * g.a_pn_off) * 2)
#define PG8_BBASE(u) ((const char*)g.Bt + ((size_t)(u).pn * g.b_pn_off + (size_t)((u).pm / g.b_pm_div) * g.b_pm_off) * 2)
#define PG8_SA(b, h) (((b) * 2 + (h)) * HTB)
#define PG8_SB(b, h) ((4 + (b) * 2 + (h)) * HTB)
#define PG8_Q64(v) PG8_Q64_##v
#define PG8_Q64_voffA q64A
#define PG8_Q64_voffB q64B
#define PG8_STAGE(bufoff, gbase, voff) do { \
        __builtin_amdgcn_global_load_lds((const unsigned*)((const char*)(gbase) + (voff)), (LAS unsigned*)(lds + (bufoff) + ldsw), 16, 0, 0); \
        __builtin_amdgcn_global_load_lds((const unsigned*)((const char*)(gbase) + PG8_Q64(voff) + (voff)), (LAS unsigned*)(lds + (bufoff) + ldsw + 8192), 16, 0, 0); } while (0)
#define PG8_LDA(dst, b, h) do { _Pragma("unroll") for (int m = 0; m < 4; ++m) _Pragma("unroll") for (int k = 0; k < 2; ++k) dst[m][k] = *(const LAS bf16x8*)(lds + PG8_SA(b, h) + aoff + m * 2048 + k * 1024); } while (0)
#define PG8_LDB(dst, b, h) do { _Pragma("unroll") for (int n = 0; n < 2; ++n) _Pragma("unroll") for (int k = 0; k < 2; ++k) dst[n][k] = *(const LAS bf16x8*)(lds + PG8_SB(b, h) + boff + n * 2048 + k * 1024); } while (0)
#define PG8_MMA(ai, bj, At, Bt) do { __builtin_amdgcn_s_setprio(1); _Pragma("unroll") for (int m = 0; m < 4; ++m) _Pragma("unroll") for (int n = 0; n < 2; ++n) _Pragma("unroll") for (int k = 0; k < 2; ++k) \
        acc[ai][bj][m][n] = __builtin_amdgcn_mfma_f32_16x16x32_bf16(Bt[n][k], At[m][k], acc[ai][bj][m][n], 0, 0, 0); __builtin_amdgcn_s_setprio(0); } while (0)
#define PG8_WAIT_V(n) asm volatile("s_waitcnt vmcnt(" #n ")" ::: "memory")
#define PG8_WAIT_L(n) asm volatile("s_waitcnt lgkmcnt(" #n ")" ::: "memory")
#define PG8_BAR __builtin_amdgcn_s_barrier()
#define PG8_SCHED __builtin_amdgcn_sched_barrier(0)
    Unit cur, nxt; int ui = 0;
    if (!S.next(0, cur)) return;
    f32x4 acc[2][2][4][2];
#pragma unroll
    for (int a = 0; a < 2; ++a)
#pragma unroll
        for (int b = 0; b < 2; ++b)
#pragma unroll
            for (int m = 0; m < 4; ++m)
#pragma unroll
                for (int n = 0; n < 2; ++n) acc[a][b][m][n] = (f32x4){0.f, 0.f, 0.f, 0.f};
    bf16x8 At[4][2], B0[2][2], B1[2][2];
    const char* cA = PG8_ABASE(cur); const char* cB = PG8_BBASE(cur);
    PG8_STAGE(PG8_SB(0, 0), cB, voffB); PG8_STAGE(PG8_SB(0, 1), cB + hstepB, voffB); PG8_STAGE(PG8_SA(0, 0), cA, voffA); PG8_STAGE(PG8_SA(0, 1), cA + hstepA, voffA);
    if (wr == 1) PG8_BAR;
    PG8_WAIT_V(2); PG8_BAR;
    PG8_STAGE(PG8_SB(1, 0), cB + kstep, voffB); PG8_STAGE(PG8_SA(1, 0), cA + kstep, voffA); PG8_STAGE(PG8_SB(1, 1), cB + hstepB + kstep, voffB);
    PG8_WAIT_V(6); PG8_BAR;
    for (;;) {
        const bool has_next = S.next(ui + 1, nxt);
        const char* nA = has_next ? PG8_ABASE(nxt) : cA; const char* nB = has_next ? PG8_BBASE(nxt) : cB;
        for (int t = 0; t < nt; t += 2) {
            const bool last = (t == nt - 2);
            const char* a1 = cA + (size_t)(t + 1) * kstep;
            const char* a2 = last ? nA : cA + (size_t)(t + 2) * kstep; const char* b2 = last ? nB : cB + (size_t)(t + 2) * kstep;
            const char* a3 = a2 + kstep; const char* b3 = b2 + kstep;
            PG8_LDB(B0, 0, 0); PG8_LDB(B1, 0, 1); PG8_SCHED; PG8_LDA(At, 0, 0); PG8_STAGE(PG8_SA(1, 1), a1 + hstepA, voffA);
            PG8_WAIT_V(8); PG8_WAIT_L(0); PG8_BAR; PG8_MMA(0, 0, At, B0); PG8_MMA(0, 1, At, B1); PG8_BAR; PG8_SCHED;
            PG8_LDA(At, 0, 1); PG8_STAGE(PG8_SB(0, 0), b2, voffB); PG8_STAGE(PG8_SB(0, 1), b2 + hstepB, voffB); PG8_STAGE(PG8_SA(0, 0), a2, voffA);
            PG8_WAIT_V(8); PG8_WAIT_L(0); PG8_BAR; PG8_MMA(1, 0, At, B0); PG8_MMA(1, 1, At, B1); PG8_BAR; PG8_SCHED;
            PG8_LDB(B0, 1, 0); PG8_LDB(B1, 1, 1); PG8_SCHED; PG8_LDA(At, 1, 0); PG8_STAGE(PG8_SA(0, 1), a2 + hstepA, voffA);
            PG8_WAIT_V(8); PG8_WAIT_L(0); PG8_BAR; PG8_MMA(0, 0, At, B0); PG8_MMA(0, 1, At, B1); PG8_BAR; PG8_SCHED;
            PG8_LDA(At, 1, 1); PG8_STAGE(PG8_SB(1, 0), b3, voffB); PG8_STAGE(PG8_SB(1, 1), b3 + hstepB, voffB); PG8_STAGE(PG8_SA(1, 0), a3, voffA);
            PG8_WAIT_V(8); PG8_WAIT_L(0); PG8_BAR; PG8_MMA(1, 0, At, B0); PG8_MMA(1, 1, At, B1); PG8_BAR; PG8_SCHED;
        }
        if (wr == 0) PG8_BAR;
        run_epi(E, acc, cur, wr, wc, fr, fq, lds);
        if (!has_next) break;
#pragma unroll
        for (int a = 0; a < 2; ++a)
#pragma unroll
            for (int b = 0; b < 2; ++b)
#pragma unroll
                for (int m = 0; m < 4; ++m)
#pragma unroll
                    for (int n = 0; n < 2; ++n) acc[a][b][m][n] = (f32x4){0.f, 0.f, 0.f, 0.f};
        cur = nxt; cA = nA; cB = nB; ++ui;
        if (wr == 1) PG8_BAR;
    }
    PG8_WAIT_V(0);
    PG8_BAR;
#undef PG8_ABASE
#undef PG8_BBASE
#undef PG8_SA
#undef PG8_SB
#undef PG8_STAGE
#undef PG8_Q64
#undef PG8_Q64_voffA
#undef PG8_Q64_voffB
#undef PG8_LDA
#undef PG8_LDB
#undef PG8_MMA
#undef PG8_WAIT_V
#undef PG8_WAIT_L
#undef PG8_BAR
#undef PG8_SCHED
}
}

namespace att {
#define ATT_BAR() do { asm volatile("s_waitcnt lgkmcnt(0)" ::: "memory"); __builtin_amdgcn_s_barrier(); asm volatile("" ::: "memory"); } while (0)
constexpr int KST_B = 208  , VST_B = 144  ;
constexpr int KBYTES = 64 * KST_B, VBYTES = 64 * VST_B, BUFB = KBYTES + VBYTES;
__device__ __forceinline__ int crow(int r, int hi) { return (r & 3) + 8 * (r >> 2) + 4 * hi; }
constexpr int NSLOT = 4, NPIECE = 22;
__device__ __forceinline__ void attn_unit(int b, int h, int qb, const bf16* Q, const bf16* KN, const bf16* KR, const bf16* VT, bf16* OUT, LAS unsigned char* lds, const int tid) {
    const int lane = tid & 63, r32 = lane & 31, hi = lane >> 5, wid = __builtin_amdgcn_readfirstlane(tid >> 6);
    const size_t rowbase = (size_t)b * SEQ; const int q0 = qb * 256; const int qrow = q0 + wid * 32 + r32;
    const int NT = (q0 + 256) / 64;
    const char* gp[3]; unsigned ginc[3];
#pragma unroll
    for (int i = 0; i < 3; ++i) { const int p = wid + 8 * i;
        if (p < 13) { const int c = p * 64 + lane, row = c / 13, c16 = c % 13;
            if (c16 >= 8 && c16 < 12) { gp[i] = (const char*)(KR + (rowbase + row) * 32 + (c16 - 8) * 8); ginc[i] = 64 * 32 * 2; }
            else { gp[i] = (const char*)(KN + (rowbase + row) * 512 + h * 64 + (c16 < 8 ? c16 : 0) * 8); ginc[i] = 64 * 512 * 2; } }
        else { const int c = ((p < NPIECE ? p : 13) - 13) * 64 + lane, d = c / 9, c16 = c % 9;
            gp[i] = (const char*)(VT + (size_t)(h * 64 + d) * M + rowbase + (c16 < 8 ? c16 : 0) * 8); ginc[i] = 64 * 2; } }
#define ATT_DMA(t) do { LAS unsigned char* sl_ = lds + ((t) & (NSLOT - 1)) * BUFB + wid * 1024; \
        __builtin_amdgcn_global_load_lds((const unsigned*)(gp[0] + (size_t)(t) * ginc[0]), (LAS unsigned*)(sl_), 16, 0, 0); \
        __builtin_amdgcn_global_load_lds((const unsigned*)(gp[1] + (size_t)(t) * ginc[1]), (LAS unsigned*)(sl_ + 8192), 16, 0, 0); \
        if (wid < NPIECE - 16) __builtin_amdgcn_global_load_lds((const unsigned*)(gp[2] + (size_t)(t) * ginc[2]), (LAS unsigned*)(sl_ + 16384), 16, 0, 0); } while (0)
    bf16x8 qr[6];
    { const bf16* qp = Q + (rowbase + qrow) * 768 + h * 96 + hi * 8;
#pragma unroll
      for (int ks = 0; ks < 6; ++ks) qr[ks] = *(const bf16x8*)(qp + ks * 16); }
    asm volatile("s_waitcnt vmcnt(0)" ::: "memory");
    ATT_DMA(0); ATT_DMA(1); ATT_DMA(2);
    f32x16 o0, o1;
#pragma unroll
    for (int r = 0; r < 16; ++r) { o0[r] = 0.f; o1[r] = 0.f; }
    float mrun = 0.f, lrun = 0.f;
    f32x16 negm;
#pragma unroll
    for (int r = 0; r < 16; ++r) negm[r] = 0.f;
    const int qmin = q0 + wid * 32;
    asm volatile("s_waitcnt vmcnt(4)" ::: "memory");
    ATT_BAR();
    if (wid >= 4) ATT_BAR();
#pragma unroll 1
    for (int t = 0; t < NT; ++t) {
        if (t + 3 < NT) ATT_DMA(t + 3);
        const int kv0 = t * 64;
        const bool active = kv0 <= qmin + 31;
        bf16x8 vf0[4], vf1[4]; f32x16 p0, p1;
        if (active) {
            const LAS unsigned char* buf = lds + (t & (NSLOT - 1)) * BUFB;
            const LAS unsigned char* kb = buf + r32 * KST_B + hi * 16;
            const LAS unsigned char* vb = buf + KBYTES + r32 * VST_B + hi * 16;
#pragma unroll
            for (int s = 0; s < 4; ++s) { vf0[s] = *(const LAS bf16x8*)(vb + s * 32); vf1[s] = *(const LAS bf16x8*)(vb + 32 * VST_B + s * 32); }
            __builtin_amdgcn_sched_barrier(0);
#pragma unroll
            for (int ks = 0; ks < 6; ++ks) { const bf16x8 a0 = *(const LAS bf16x8*)(kb + ks * 32), a1 = *(const LAS bf16x8*)(kb + 32 * KST_B + ks * 32);
                if (ks == 0) { p0 = __builtin_amdgcn_mfma_f32_32x32x16_bf16(a0, qr[0], negm, 0, 0, 0); p1 = __builtin_amdgcn_mfma_f32_32x32x16_bf16(a1, qr[0], negm, 0, 0, 0); }
                else { p0 = __builtin_amdgcn_mfma_f32_32x32x16_bf16(a0, qr[ks], p0, 0, 0, 0); p1 = __builtin_amdgcn_mfma_f32_32x32x16_bf16(a1, qr[ks], p1, 0, 0, 0); } }
        }
        if (t + 3 < NT) asm volatile("s_waitcnt vmcnt(4)" ::: "memory");
        else asm volatile("s_waitcnt vmcnt(0)" ::: "memory");
        ATT_BAR();
        if (active) {
            if (kv0 + 63 > qmin) {
#pragma unroll
                for (int r = 0; r < 16; ++r) { const int kv = kv0 + crow(r, hi); if (kv > qrow) p0[r] = -1e30f; if (kv + 32 > qrow) p1[r] = -1e30f; }
            }
            float mx = __builtin_amdgcn_fmed3f(p0[0], p1[0], __builtin_inff());
#pragma unroll
            for (int r = 1; r < 16; ++r) { mx = __builtin_amdgcn_fmed3f(mx, p0[r], __builtin_inff()); mx = __builtin_amdgcn_fmed3f(mx, p1[r], __builtin_inff()); }
            { auto rr = __builtin_amdgcn_permlane32_swap(__float_as_uint(mx), __float_as_uint(mx), false, false); mx = fmaxf(__uint_as_float(rr[0]), __uint_as_float(rr[1])); }
            const bool first = (t == 0);
            if (first || __builtin_amdgcn_ballot_w64(mx > 0.f) != 0ull) {
                const float d = first ? mx : fmaxf(mx, 0.f); mrun += d;
                if (!first) { const float alpha = ex2(-d); lrun *= alpha;
#pragma unroll
                    for (int r = 0; r < 16; ++r) { o0[r] *= alpha; o1[r] *= alpha; } }
#pragma unroll
                for (int r = 0; r < 16; ++r) { p0[r] -= d; p1[r] -= d; negm[r] = -mrun; }
            }
            float rs0 = 0.f, rs1 = 0.f;
#pragma unroll
            for (int r = 0; r < 16; ++r) { p0[r] = ex2(p0[r]); p1[r] = ex2(p1[r]); rs0 += p0[r]; asm volatile("" : "+v"(rs0)); rs1 += p1[r]; asm volatile("" : "+v"(rs1)); }
            lrun += rs0 + rs1;
            u32x4 pw[4];
#pragma unroll
            for (int j = 0; j < 4; ++j) { pw[0][j] = pk2(p0[2 * j], p0[2 * j + 1]); pw[1][j] = pk2(p0[8 + 2 * j], p0[8 + 2 * j + 1]); pw[2][j] = pk2(p1[2 * j], p1[2 * j + 1]); pw[3][j] = pk2(p1[8 + 2 * j], p1[8 + 2 * j + 1]); }
#pragma unroll
            for (int s = 0; s < 4; ++s) { const bf16x8 pf = __builtin_bit_cast(bf16x8, pw[s]);
                o0 = __builtin_amdgcn_mfma_f32_32x32x16_bf16(vf0[s], pf, o0, 0, 0, 0); o1 = __builtin_amdgcn_mfma_f32_32x32x16_bf16(vf1[s], pf, o1, 0, 0, 0); }
        }
        ATT_BAR();
    }
    if (wid < 4) ATT_BAR();
#undef ATT_DMA
    float ltot; { auto rr = __builtin_amdgcn_permlane32_swap(__float_as_uint(lrun), __float_as_uint(lrun), false, false); ltot = __uint_as_float(rr[0]) + __uint_as_float(rr[1]); }
    const float inv = rcp(ltot);
    bf16* op = OUT + (rowbase + qrow) * 1024 + h * 64 + 4 * hi;
#pragma unroll
    for (int g = 0; g < 4; ++g) {
        u32x2 w0, w1; w0.x = pk2(o0[4 * g] * inv, o0[4 * g + 1] * inv); w0.y = pk2(o0[4 * g + 2] * inv, o0[4 * g + 3] * inv);
        w1.x = pk2(o1[4 * g] * inv, o1[4 * g + 1] * inv); w1.y = pk2(o1[4 * g + 2] * inv, o1[4 * g + 3] * inv);
        *(u32x2*)(op + 8 * g) = w0; *(u32x2*)(op + 32 + 8 * g) = w1; }
    asm volatile("s_waitcnt vmcnt(0)" ::: "memory");
}
}

constexpr size_t MiB = 1u << 20;
constexpr size_t WS_BAR = 32 * 1024;
constexpr size_t WS_SP8 = 0;
constexpr size_t WS_CA = 64 * 1024, WS_CB = WS_CA + 256 * 1024 * 4;
constexpr size_t WS_SSQ = 2 * MiB + 128 * 1024;
constexpr size_t WS_COS = 3 * MiB, WS_SIN = 5 * MiB;
constexpr size_t WS_MN = 7 * MiB;
constexpr size_t WS_MK = 9 * MiB;
constexpr size_t WS_MVT = 11 * MiB;
constexpr size_t WS_W = 13 * MiB;
constexpr size_t W_EVIN = WS_W, W_POOL = W_EVIN + 2 * MiB, W_QUP = W_POOL + MiB, W_KN = W_QUP + MiB, W_V = W_KN + MiB / 4, W_EVOUT = W_KN + MiB;
constexpr size_t W_ODIN = W_EVOUT + 2 * MiB, W_GATE = W_ODIN + 4 * MiB, W_ODOUT = W_GATE + MiB, W_XAQ = W_ODOUT + 2 * MiB  , W_XAKV = W_XAQ + 4 * MiB  ;
constexpr size_t W_XAO = W_XAKV + 8 * MiB  , W_FFN1 = W_XAO + 4 * MiB  , W_FFN2 = W_FFN1 + 22 * MiB  , W_END = W_FFN2 + 11 * MiB;
static_assert(W_END <= 80 * MiB, "weights");
constexpr size_t WS_XN = 80 * MiB;
constexpr size_t WS_MIX = 144 * MiB;
constexpr size_t WS_H = 208 * MiB;
constexpr size_t WS_U = 208 * MiB, WS_CQ = 240 * MiB, WS_CKV = 256 * MiB, WS_KR = 264 * MiB, WS_POOLED = 266 * MiB, WS_CQN = 298 * MiB, WS_CKVN = 314 * MiB, WS_Q = 322 * MiB;
constexpr size_t WS_KN = 384 * MiB, WS_VT = 416 * MiB;
constexpr size_t WS_XQ = 208 * MiB, WS_P = 272 * MiB;
constexpr size_t WS_GB = 208 * MiB, WS_XBP = 272 * MiB, WS_B = 272 * MiB, WS_A = 336 * MiB;
constexpr size_t WS_WPP = 470 * MiB;
constexpr size_t WS_WQK = 478 * MiB;
constexpr size_t WS_SA = 488 * MiB, WS_SB = 492 * MiB;
constexpr size_t WS_NEED = 496 * MiB;

struct Args {
    const float* x; const float* mem; const int* pos;
    const float *ev_norm, *ev_w_in, *ev_pool_w, *ev_pool_scale, *ev_q_norm, *ev_w_q_up, *ev_kv_norm, *ev_w_kv_up, *ev_w_out;
    const float *od_norm, *od_w_in, *od_conv_w, *od_conv_b, *od_w_rgate, *od_b_rgate, *od_w_igate, *od_b_igate, *od_lambda, *od_w_out;
    const float *xa_norm_x, *xa_norm_mem, *xa_w_q, *xa_w_kv, *xa_w_o, *ffn_norm, *ffn_w_gate_up, *ffn_w_down, *final_norm;
    float* out; unsigned char* ws; int ph_lo, ph_hi;
};

template <class RM> __device__ __forceinline__ void tr_matrix(const float* W, int K, int N, int ldd, RM rowptr, LAS float* scr, int gw, int NGW, int lane, int& rot, const float* kg = nullptr) {
    const int nblk = N / 32, nit = (K / 64) * nblk;
    int it = (gw - (rot % NGW) + NGW) % NGW;
    rot += nit;
    float r[32];
    const int lrow = lane >> 5, lcol = lane & 31;
    if (it < nit) { const float* src = W + (size_t)(64 * (it / nblk) + lrow) * N + 32 * (it % nblk) + lcol;
#pragma unroll
        for (int i = 0; i < 32; ++i) r[i] = src[(size_t)(2 * i) * N]; }
    for (; it < nit; it += NGW) {
        const int k0 = 64 * (it / nblk), n0 = 32 * (it % nblk);
#pragma unroll
        for (int i = 0; i < 32; ++i) scr[(2 * i + lrow) * 33 + lcol] = r[i];
        LDS_WAIT(); asm volatile("" ::: "memory");
        const int itn = it + NGW;
        if (itn < nit) { const float* src = W + (size_t)(64 * (itn / nblk) + lrow) * N + 32 * (itn % nblk) + lcol;
#pragma unroll
            for (int i = 0; i < 32; ++i) r[i] = src[(size_t)(2 * i) * N]; }
        const int c = lane & 7; bf16* dst = rowptr(n0);
        f32x4 g0 = (f32x4){1.f, 1.f, 1.f, 1.f}, g1 = g0;
        if (kg) { g0 = *(const f32x4*)(kg + k0 + 8 * c); g1 = *(const f32x4*)(kg + k0 + 8 * c + 4); }
#pragma unroll
        for (int j = 0; j < 4; ++j) { const int n = (lane >> 3) + 8 * j; const LAS float* s = scr + (8 * c) * 33 + n;
            u32x4 o; o.x = pk2(s[0 * 33] * g0[0], s[1 * 33] * g0[1]); o.y = pk2(s[2 * 33] * g0[2], s[3 * 33] * g0[3]); o.z = pk2(s[4 * 33] * g1[0], s[5 * 33] * g1[1]); o.w = pk2(s[6 * 33] * g1[2], s[7 * 33] * g1[3]);
            *(u32x4*)(dst + (size_t)n * ldd + k0 + 8 * c) = o; }
        LDS_WAIT(); asm volatile("" ::: "memory");
    }
}
__device__ __forceinline__ void rms_row_bf16(const float* xrow, const float* g, bf16* orow, int lane) {
    const f32x4* xr = (const f32x4*)xrow + lane; const f32x4* gr = (const f32x4*)g + lane;
    f32x4 v[4]; float s = 0.f;
#pragma unroll
    for (int j = 0; j < 4; ++j) { v[j] = xr[64 * j]; s += (v[j][0] * v[j][0] + v[j][1] * v[j][1]) + (v[j][2] * v[j][2] + v[j][3] * v[j][3]); }
    const float rstd = rsqrtf(wave_sum(s) * (1.f / D) + RMS_EPS);
#pragma unroll
    for (int j = 0; j < 4; ++j) { const f32x4 o = v[j] * rstd * gr[64 * j]; u32x2 w; w.x = pk2(o[0], o[1]); w.y = pk2(o[2], o[3]); *(u32x2*)(orow + 4 * lane + 256 * j) = w; }
}
__device__ __forceinline__ void norm_pass(const float* X, const float* g, bf16* XN, int gw, int NGW, int lane) {
    for (int m = gw; m < M; m += NGW) rms_row_bf16(X + (size_t)m * D, g, XN + (size_t)m * D, lane);
}

__device__ __forceinline__ int fresh_tid(int wave) { int l; asm volatile("v_mbcnt_lo_u32_b32 %0, -1, 0\n\tv_mbcnt_hi_u32_b32 %0, -1, %0" : "=v"(l)); return wave * 64 + l; }
#define XB_TMO      128
#define XB_XCNT(j)  (256  + 64 * (j))
#define XB_XSUB(j)  (1280 + 64 * (j))
#define XB_XGEN(j)  (2304 + 64 * (j))
#define XB_TOP      3328
#define XB_TOPGEN   3392
#define XCD_BAR_WORDS 3456
#define XB_SPIN_CAP (1u << 18)
__device__ __forceinline__ unsigned xb_ld(unsigned* p)              { return __hip_atomic_load(p, __ATOMIC_RELAXED, __HIP_MEMORY_SCOPE_AGENT); }
__device__ __forceinline__ unsigned xb_add(unsigned* p, unsigned v) { return __hip_atomic_fetch_add(p, v, __ATOMIC_RELAXED, __HIP_MEMORY_SCOPE_AGENT); }
__device__ __forceinline__ unsigned xb_xcc_id() { return (unsigned)__builtin_amdgcn_s_getreg((3 << 11) | 20) & 0xFu; }
#define XB_SPIN(cond, bar) do { unsigned _sp = 0; while (cond) { __builtin_amdgcn_s_sleep(1); \
    if ((++_sp & 255u) == 0u) { if (xb_ld(&(bar)[XB_TMO])) break; if (_sp > XB_SPIN_CAP) { atomicAdd(&(bar)[XB_TMO], 1u); break; } } } } while (0)
__device__ __forceinline__ void xcd_barrier_complete(unsigned* bar, unsigned x, unsigned G, unsigned& nloc, unsigned& nx) {
    unsigned sum, cnt, mine, sp = 0u;
    for (;;) {
        sum = 0u; cnt = 0u; mine = 0u;
#pragma unroll
        for (unsigned j = 0; j < 16; ++j) { const unsigned c = xb_ld(&bar[XB_XCNT(j)]); sum += c; cnt += (c > 0u) ? 1u : 0u; mine = (j == x) ? c : mine; }
        if (sum == G) break;
        __builtin_amdgcn_s_sleep(1);
        if ((++sp & 255u) == 0u) { if (xb_ld(&bar[XB_TMO])) break; if (sp > XB_SPIN_CAP) { atomicAdd(&bar[XB_TMO], 1u); break; } }
    }
    nloc = mine > 0u ? mine : 1u; nx = cnt > 0u ? cnt : 1u;
}
__device__ __forceinline__ void xcd_barrier(unsigned* bar, unsigned x, volatile LAS unsigned* st, unsigned G, int tid) {
    asm volatile("s_waitcnt vmcnt(0)" ::: "memory");
    __syncthreads();
    if (tid == 0) {
        __builtin_amdgcn_s_waitcnt(0);
        unsigned nloc = st[0], nx = st[1];
        if (nloc == 0u) { xcd_barrier_complete(bar, x, G, nloc, nx); st[0] = nloc; st[1] = nx; }
        const unsigned old = xb_add(&bar[XB_XSUB(x)], 1u);
        const unsigned gen = old / nloc;
        if (old + 1u == (gen + 1u) * nloc) {
            __builtin_amdgcn_fence(__ATOMIC_RELEASE, "agent");
            asm volatile("s_waitcnt vmcnt(0)" ::: "memory");
            const unsigned og = xb_add(&bar[XB_TOP], 1u);
            const unsigned tg = og / nx;
            if (og + 1u == (tg + 1u) * nx) xb_add(&bar[XB_TOPGEN], 1u);
            else XB_SPIN(xb_ld(&bar[XB_TOPGEN]) == tg, bar);
            __builtin_amdgcn_fence(__ATOMIC_ACQUIRE, "agent");
            xb_add(&bar[XB_XGEN(x)], 1u);
            asm volatile("s_waitcnt vmcnt(0)" ::: "memory");
        } else {
            XB_SPIN(xb_ld(&bar[XB_XGEN(x)]) == gen, bar);
            __builtin_amdgcn_fence(__ATOMIC_ACQUIRE, "agent");
            asm volatile("s_waitcnt vmcnt(0)" ::: "memory");
        }
    }
    __syncthreads();
}

typedef const __attribute__((address_space(4))) Args* KArgs;
__global__ void __launch_bounds__(NTHREADS, 2) hybrid_fwd(Args a_) {
    extern __shared__ __attribute__((aligned(16))) unsigned char lds_raw[];
    LAS unsigned char* lds = (LAS unsigned char*)lds_raw;
    cg::grid_group grid = cg::this_grid();
    const int wave = __builtin_amdgcn_readfirstlane(threadIdx.x >> 6);
    const int G = gridDim.x, bx = blockIdx.x;
    volatile LAS unsigned* const xst = (volatile LAS unsigned*)(lds + EPI_OFF + 16000);
    if (threadIdx.x == 0) { xst[0] = 0u; xst[1] = 0u; }
    if (threadIdx.x == 0) (void)xb_add((unsigned*)(a_.ws + WS_BAR) + XB_XCNT(xb_xcc_id()), 1u);
    __syncthreads();
    if (a_.ph_hi < 0) grid.sync();
    const int vcu = (G % 8 == 0) ? (bx % 8) * (G / 8) + bx / 8 : bx;
    const int gw = vcu * NWAVES + wave, NGW = G * NWAVES;
#ifndef PREFIX_K
#define PREFIX_K 0
#endif
#pragma unroll 1
    for (int pass = (PREFIX_K > 0 ? 0 : 1); pass < 2; ++pass) {
    const int lo = a_.ph_lo, hi = (pass == 0) ? PREFIX_K : a_.ph_hi;
    int ph = 0;
#define a (*ap)
#ifndef PROBE_MASK
#define PROBE_MASK (0ull)
#endif
#define PHASE_BEGIN if (lo <= ph && ph < hi) for (int rep_ = ((PROBE_MASK >> ph) & 1ull) ? 2 : 1; rep_ > 0; --rep_) { KArgs ap = (KArgs)__builtin_amdgcn_kernarg_segment_ptr(); asm volatile("" : "+s"(ap)); int lane; asm volatile("v_mbcnt_lo_u32_b32 %0, -1, 0\n\tv_mbcnt_hi_u32_b32 %0, -1, %0" : "=v"(lane)); const int tid = wave * 64 + lane; (void)tid; unsigned char* const ws = a.ws; float* const outp = a.out; \
    bf16* const XN = WSP(bf16, WS_XN); bf16* const MIX = WSP(bf16, WS_MIX); const float* cosT = WSP(float, WS_COS); const float* sinT = WSP(float, WS_SIN); (void)XN; (void)MIX; (void)cosT; (void)sinT; (void)outp;
#define PHASE_END   if (rep_ == 1 && (ph + 1 < hi || pass == 0)) { xcd_barrier((unsigned*)(ws + WS_BAR), xb_xcc_id(), (volatile LAS unsigned*)(lds + EPI_OFF + 16000), (unsigned)G, tid); } } ++ph;
#define WSP(T, off) ((T*)(ws + (off)))
    using pg8::Gemm; using pg8::Epi; using pg8::StaticOrder;

    PHASE_BEGIN
    {
        LAS float* scr = (LAS float*)(lds + wave * 16384);
        int rot = 0;
        tr_matrix(a.ev_w_in, 1024, 928, 1024, [&](int n0) { return WSP(bf16, W_EVIN) + (size_t)n0 * 1024; }, scr, gw, NGW, lane, rot);
        tr_matrix(a.ev_w_q_up, 256, 768, 256, [&](int n0) { return WSP(bf16, W_QUP) + (size_t)n0 * 256; }, scr, gw, NGW, lane, rot);
        tr_matrix(a.ev_w_kv_up, 128, 1024, 128, [&](int n0) { const int h = n0 >> 7, j0 = n0 & 127; return (j0 < 64 ? WSP(bf16, W_KN) : WSP(bf16, W_V)) + (size_t)(h * 64 + (j0 & 63)) * 128; }, scr, gw, NGW, lane, rot);
        tr_matrix(a.ev_w_out, 1024, 1024, 1024, [&](int n0) { return WSP(bf16, W_EVOUT) + (size_t)n0 * 1024; }, scr, gw, NGW, lane, rot);
        tr_matrix(a.od_w_in, 1024, 2048, 1024, [&](int n0) { return WSP(bf16, W_ODIN) + (size_t)n0 * 1024; }, scr, gw, NGW, lane, rot, a.od_norm);
        for (int h = 0; h < 4; ++h) {
            tr_matrix(a.od_w_rgate + (size_t)h * 65536, 256, 256, 256, [&](int n0) { return WSP(bf16, W_GATE) + (size_t)(256 * (2 * h + (n0 >> 7)) + (n0 & 127)) * 256; }, scr, gw, NGW, lane, rot);
            tr_matrix(a.od_w_igate + (size_t)h * 65536, 256, 256, 256, [&](int n0) { return WSP(bf16, W_GATE) + (size_t)(256 * (2 * h + (n0 >> 7)) + 128 + (n0 & 127)) * 256; }, scr, gw, NGW, lane, rot);
        }
        tr_matrix(a.od_w_out, 1024, 1024, 1024, [&](int n0) { return WSP(bf16, W_ODOUT) + (size_t)n0 * 1024; }, scr, gw, NGW, lane, rot);
        for (int l = 0; l < 2; ++l) {
            tr_matrix(a.xa_w_kv + (size_t)l * 2097152, 1024, 2048, 1024, [&](int n0) { return WSP(bf16, W_XAKV + l * 4 * MiB) + (size_t)n0 * 1024; }, scr, gw, NGW, lane, rot);
            tr_matrix(a.xa_w_o + (size_t)l * 1048576, 1024, 1024, 1024, [&](int n0) { return WSP(bf16, W_XAO + l * 2 * MiB) + (size_t)n0 * 1024; }, scr, gw, NGW, lane, rot);
            tr_matrix(a.ffn_w_gate_up + (size_t)l * 1024 * 5632, 1024, 5632, 1024, [&](int n0) { const int isu = n0 >= DFF, nn = isu ? n0 - DFF : n0; return WSP(bf16, W_FFN1 + l * 11 * MiB) + (size_t)(256 * (nn >> 7) + 128 * isu + (nn & 127)) * 1024; }, scr, gw, NGW, lane, rot, a.ffn_norm + l * D);
            tr_matrix(a.ffn_w_down + (size_t)l * DFF * 1024, DFF, 1024, DFF, [&](int n0) { return WSP(bf16, W_FFN2) + (size_t)l * (1024 * DFF) + (size_t)n0 * DFF; }, scr, gw, NGW, lane, rot);
        }
        const int gt = vcu * NTHREADS + tid, NGT = G * NTHREADS;
        for (int i = gt; i < 512 * 256; i += NGT) { const int n = i >> 8, kk = i & 255, g = n >> 7; float v = 0.f; if ((kk >> 7) == (g & 1)) v = a.ev_pool_w[(size_t)g * 16384 + (size_t)(kk & 127) * 128 + (n & 127)];
            WSP(bf16, W_POOL)[i] = (bf16)(pk2(v, 0.f) & 0xffffu); }
        for (int i = gt; i < 2 * 1024 * 128; i += NGT) { const int l = i >> 17, r = (i >> 7) & 1023, c8 = (i & 127) * 8; const float g = a.xa_norm_x[l * D + r];
            const f32x4 v0 = *(const f32x4*)(a.xa_w_q + (size_t)l * 1048576 + (size_t)r * 1024 + c8), v1 = *(const f32x4*)(a.xa_w_q + (size_t)l * 1048576 + (size_t)r * 1024 + c8 + 4);
            u32x4 o; o.x = pk2(v0[0] * g, v0[1] * g); o.y = pk2(v0[2] * g, v0[3] * g); o.z = pk2(v1[0] * g, v1[1] * g); o.w = pk2(v1[2] * g, v1[3] * g);
            *(u32x4*)(WSP(bf16, W_XAQ + l * 2 * MiB) + (size_t)r * 1024 + c8) = o; }
        for (int i = gt; i < M * 16; i += NGT) { const int row = i >> 4, j = i & 15; const int f = j & 3, e = j >> 2;
            const float fa = f == 0 ? 1.0f : (f == 1 ? 0.5623413251903491f : (f == 2 ? 0.31622776601683794f : 0.1778279410038923f));
            const float fb = e == 0 ? 1.0f : (e == 1 ? 0.1f : (e == 2 ? 0.01f : 0.001f));
            const float inv_freq = fa * fb; const float ang = (float)a.pos[row] * inv_freq;
            const double t = (double)ang * 0.15915494309189535; const float fr = (float)(t - __builtin_floor(t));
            WSP(float, WS_COS)[i] = __builtin_amdgcn_cosf(fr); WSP(float, WS_SIN)[i] = __builtin_amdgcn_sinf(fr); }
        for (int i = gt; i < 6 * M; i += NGT) WSP(float, WS_SSQ)[i] = 0.f;
        for (int i = gt; i < 1024; i += NGT) { const float l = a.od_lambda[i]; const float y = ex2(-l * LOG2E);
            const float sp = (y < 0.03f) ? y * (1.0f - y * (0.5f - y * (1.0f / 3.0f - 0.25f * y))) : 0.6931471805599453f * __builtin_amdgcn_logf(1.0f + y);
            WSP(float, WS_SP8)[i] = 8.0f * sp; }
        for (int r = gw; r < 1024; r += NGW) { const int l = r >> 9, mr = r & 511; rms_row_bf16(a.mem + (size_t)mr * D, a.xa_norm_mem + l * D, WSP(bf16, WS_MN) + (size_t)r * D, lane); }
        norm_pass(a.x, a.ev_norm, XN, gw, NGW, lane);
    }
    PHASE_END

    PHASE_BEGIN
    {
        { Gemm g = pg8::mk(XN, WSP(bf16, W_EVIN), M, 1024, 1024); StaticOrder S; S.init(M, 1024, G, bx);
          Epi E{}; E.mode = pg8::E_EVIN; E.O = WSP(bf16, WS_U); E.O2 = WSP(bf16, WS_CQ); E.O3 = WSP(bf16, WS_CKV); E.O4 = WSP(bf16, WS_KR); E.cosT = cosT; E.sinT = sinT;
          pg8::gemm_phase(lds, g, S, E, fresh_tid(wave)); }
    }
    PHASE_END

    PHASE_BEGIN
    {
        const int NMEMWG = (G >= 64) ? 32 : 0;
        if (bx < NMEMWG) {
            const int l = bx >> 4, isv = (bx >> 3) & 1;
            if (!isv) { Gemm g = pg8::mk(WSP(bf16, WS_MN) + (size_t)l * 512 * D, WSP(bf16, W_XAKV + l * 4 * MiB), 512, 1024, 1024); StaticOrder S; S.init(512, 1024, G, bx & 7);
              Epi E{}; E.mode = pg8::E_PLAIN; E.O = WSP(bf16, WS_MK) + (size_t)l * 512 * D; E.ldc = 1024; E.scale = 1.f; pg8::gemm_phase(lds, g, S, E, fresh_tid(wave)); }
            else { Gemm g = pg8::mk(WSP(bf16, WS_MN) + (size_t)l * 512 * D, WSP(bf16, W_XAKV + l * 4 * MiB) + (size_t)1024 * 1024, 512, 1024, 1024); StaticOrder S; S.init(512, 1024, G, bx & 7);
              Epi E{}; E.mode = pg8::E_PLAIN; E.O = WSP(bf16, WS_MVT) + (size_t)l * 512 * D; E.ldc = 1024; E.scale = 1.f; pg8::gemm_phase(lds, g, S, E, fresh_tid(wave)); }
        } else {
        const int gw = (bx - NMEMWG) * NWAVES + wave, NGW = (G - NMEMWG) * NWAVES;
        const bf16* U = WSP(bf16, WS_U); const bf16* CQ = WSP(bf16, WS_CQ); const bf16* CKV = WSP(bf16, WS_CKV);
        bf16* PO = WSP(bf16, WS_POOLED); bf16* CQN = WSP(bf16, WS_CQN); bf16* CKVN = WSP(bf16, WS_CKVN);
        const int w = 2 << (lane >> 4);
        const f32x4 gq = *(const f32x4*)(a.ev_q_norm + 4 * lane); const f32x2 gk = *(const f32x2*)(a.ev_kv_norm + 2 * lane);
        for (int row = gw; row < M; row += NGW) {
            const int s = row & (SEQ - 1); const int cnt = (s + 1 < w) ? s + 1 : w;
            float sum[8]; float self[8];
            { const u32x4 v = *(const u32x4*)(U + (size_t)row * 512 + 8 * lane);
              self[0] = bflo(v.x); self[1] = bfhi(v.x); self[2] = bflo(v.y); self[3] = bfhi(v.y); self[4] = bflo(v.z); self[5] = bfhi(v.z); self[6] = bflo(v.w); self[7] = bfhi(v.w);
#pragma unroll
              for (int e = 0; e < 8; ++e) sum[e] = self[e]; }
            for (int tt = 1; tt < cnt; ++tt) { const u32x4 v = *(const u32x4*)(U + (size_t)(row - tt) * 512 + 8 * lane);
                sum[0] += bflo(v.x); sum[1] += bfhi(v.x); sum[2] += bflo(v.y); sum[3] += bfhi(v.y); sum[4] += bflo(v.z); sum[5] += bfhi(v.z); sum[6] += bflo(v.w); sum[7] += bfhi(v.w); }
            const float ic = 1.0f / (float)cnt;
            u32x4 o; o.x = pk2(sum[0] * ic - self[0], sum[1] * ic - self[1]); o.y = pk2(sum[2] * ic - self[2], sum[3] * ic - self[3]);
            o.z = pk2(sum[4] * ic - self[4], sum[5] * ic - self[5]); o.w = pk2(sum[6] * ic - self[6], sum[7] * ic - self[7]);
            *(u32x4*)(PO + (size_t)row * 512 + 8 * lane) = o;
            { const u32x2 v = *(const u32x2*)(CQ + (size_t)row * 256 + 4 * lane); const float x0 = bflo(v.x), x1 = bfhi(v.x), x2 = bflo(v.y), x3 = bfhi(v.y);
              const float rstd = rsqrtf(wave_sum((x0 * x0 + x1 * x1) + (x2 * x2 + x3 * x3)) * (1.f / 256.f) + RMS_EPS);
              u32x2 q; q.x = pk2(x0 * rstd * gq[0], x1 * rstd * gq[1]); q.y = pk2(x2 * rstd * gq[2], x3 * rstd * gq[3]); *(u32x2*)(CQN + (size_t)row * 256 + 4 * lane) = q; }
            { const unsigned v = *(const unsigned*)(CKV + (size_t)row * 128 + 2 * lane); const float x0 = bflo(v), x1 = bfhi(v);
              const float rstd = rsqrtf(wave_sum(x0 * x0 + x1 * x1) * (1.f / 128.f) + RMS_EPS);
              *(unsigned*)(CKVN + (size_t)row * 128 + 2 * lane) = pk2(x0 * rstd * gk[0], x1 * rstd * gk[1]); }
        }
        }
    }
    PHASE_END

    PHASE_BEGIN
    {
        { Gemm g = pg8::mk(WSP(bf16, WS_CQN), WSP(bf16, W_QUP), M, 768, 256); StaticOrder S; S.init(M, 768, G, bx);
          Epi E{}; E.mode = pg8::E_QROPE; E.O = WSP(bf16, WS_Q); E.scale = 0.10206207261596577f * LOG2E; E.cosT = cosT; E.sinT = sinT; pg8::gemm_phase(lds, g, S, E, fresh_tid(wave)); }
        { Gemm g = pg8::mk(WSP(bf16, WS_CKVN), WSP(bf16, W_KN), M, 512, 128); StaticOrder S; S.init(M, 512, G, bx);
          Epi E{}; E.mode = pg8::E_PLAIN; E.O = WSP(bf16, WS_KN); E.ldc = 512; E.scale = 1.f; pg8::gemm_phase(lds, g, S, E, fresh_tid(wave)); }
        { Gemm g = pg8::mk(WSP(bf16, W_V), WSP(bf16, WS_CKVN), 512, M, 128); StaticOrder S; S.init(512, M, G, bx);
          Epi E{}; E.mode = pg8::E_VT; E.O = WSP(bf16, WS_VT); E.ldc = M; pg8::gemm_phase(lds, g, S, E, fresh_tid(wave)); }
        { Gemm g = pg8::mk(WSP(bf16, WS_POOLED), WSP(bf16, W_POOL), M, 512, 256); g.lda = 512; g.a_pm_off = 256L * 512; g.a_pn_off = 256; StaticOrder S; S.init(M, 512, G, bx);
          Epi E{}; E.mode = pg8::E_POOL; E.O = MIX; E.ldc = 1024; E.vec0 = a.ev_pool_scale; pg8::gemm_phase(lds, g, S, E, fresh_tid(wave)); }
        { const int idx = bx >> 2;
          if (idx < 16) { const int l = idx >> 3, b = (idx >> 2) & 1, h = idx & 3;
            Gemm g = pg8::mk(WSP(bf16, W_XAO + l * 2 * MiB) + h * 256, WSP(bf16, WS_MVT) + (size_t)l * 512 * D + (size_t)b * 256 * D + h * 256, 1024, 256, 256); g.lda = 1024; g.a_pm_off = 256L * 1024; g.ldb = 1024;
            StaticOrder S; S.init(1024, 256, G, bx & 3);
            Epi E{}; E.mode = pg8::E_PLAIN; E.O = WSP(bf16, WS_WPP) + (size_t)(l * 2 + b) * 1024 * 1024 + h * 256; E.ldc = 1024; E.scale = 1.f; pg8::gemm_phase(lds, g, S, E, fresh_tid(wave)); }
          else if (idx < 32) { const int i2 = idx - 16, l = i2 >> 3, b = (i2 >> 2) & 1, h = i2 & 3;
            Gemm g = pg8::mk(WSP(bf16, WS_MK) + (size_t)l * 512 * D + (size_t)b * 256 * D + h * 256, WSP(bf16, W_XAQ + l * 2 * MiB) + h * 256, 256, 1024, 256); g.lda = 1024; g.ldb = 1024; g.b_pn_off = 256L * 1024;
            StaticOrder S; S.init(256, 1024, G, bx & 3);
            Epi E{}; E.mode = pg8::E_PLAIN; E.O = WSP(bf16, WS_WQK) + (size_t)(l * 2 + b) * 1024 * 1024 + (size_t)h * 256 * 1024; E.ldc = 1024; E.scale = 1.f; pg8::gemm_phase(lds, g, S, E, fresh_tid(wave)); } }
    }
    PHASE_END

    PHASE_BEGIN
    {
        for (int vw = vcu; vw < 256; vw += G) { const int bh = vw >> 4, s = vw & 15;
#pragma unroll 1
            for (int i = 0; i < 4; ++i) { const int qb = (i == 0) ? 63 - s : (i == 1) ? s : (i == 2) ? 32 + s : 31 - s;
                size_t z0 = 0; asm volatile("" : "+s"(z0)); unsigned char* w2 = ws + z0;
                att::attn_unit(bh >> 3, bh & 7, qb, (const bf16*)(w2 + WS_Q), (const bf16*)(w2 + WS_KN), (const bf16*)(w2 + WS_KR), (const bf16*)(w2 + WS_VT), (bf16*)(w2 + WS_MIX) + 512, lds, fresh_tid(wave)); } }
    }
    PHASE_END

    PHASE_BEGIN
    { Gemm g = pg8::mk(MIX, WSP(bf16, W_EVOUT), M, 1024, 1024); StaticOrder S; S.init(M, 1024, G, bx);
      Epi E{}; E.mode = pg8::E_RES; E.base = a.x; E.out = outp; E.O = XN; E.aout = WSP(float, WS_SSQ); pg8::gemm_phase(lds, g, S, E, fresh_tid(wave)); }
    PHASE_END

#pragma unroll 1
    for (int l = 0; l < 2; ++l) {
        if (l == 1) {
            PHASE_BEGIN
            { Gemm g = pg8::mk(XN, WSP(bf16, W_ODIN), M, 2048, 1024); StaticOrder S; S.init(M, 2048, G, bx);
              Epi E{}; E.mode = pg8::E_ODIN; E.O = WSP(bf16, WS_GB); E.O2 = WSP(bf16, WS_XBP); E.vec0 = WSP(float, WS_SSQ) + 2 * (size_t)M; pg8::gemm_phase(lds, g, S, E, fresh_tid(wave)); }
            PHASE_END
            PHASE_BEGIN
            {
                const bf16* XBP = WSP(bf16, WS_XBP); bf16* XB = XN;
                const int half = gw & 1; const int c0 = half * 512 + 8 * lane;
                float wv[4][8], bias[8];
#pragma unroll
                for (int j = 0; j < 4; ++j)
#pragma unroll
                    for (int e = 0; e < 8; ++e) wv[j][e] = a.od_conv_w[j * 1024 + c0 + e];
#pragma unroll
                for (int e = 0; e < 8; ++e) bias[e] = a.od_conv_b[c0 + e];
                const int NW2 = NGW >> 1, RPW = (M + NW2 - 1) / NW2, r0 = (gw >> 1) * RPW, r1 = (r0 + RPW < M) ? r0 + RPW : M;
                float h1[8], h2[8], h3[8];
#pragma unroll
                for (int e = 0; e < 8; ++e) { h1[e] = 0.f; h2[e] = 0.f; h3[e] = 0.f; }
                if (r0 < M) { const int s0 = r0 & (SEQ - 1);
                    if (s0 >= 1) { const u32x4 v = *(const u32x4*)(XBP + (size_t)(r0 - 1) * D + c0); h1[0] = bflo(v.x); h1[1] = bfhi(v.x); h1[2] = bflo(v.y); h1[3] = bfhi(v.y); h1[4] = bflo(v.z); h1[5] = bfhi(v.z); h1[6] = bflo(v.w); h1[7] = bfhi(v.w); }
                    if (s0 >= 2) { const u32x4 v = *(const u32x4*)(XBP + (size_t)(r0 - 2) * D + c0); h2[0] = bflo(v.x); h2[1] = bfhi(v.x); h2[2] = bflo(v.y); h2[3] = bfhi(v.y); h2[4] = bflo(v.z); h2[5] = bfhi(v.z); h2[6] = bflo(v.w); h2[7] = bfhi(v.w); }
                    if (s0 >= 3) { const u32x4 v = *(const u32x4*)(XBP + (size_t)(r0 - 3) * D + c0); h3[0] = bflo(v.x); h3[1] = bfhi(v.x); h3[2] = bflo(v.y); h3[3] = bfhi(v.y); h3[4] = bflo(v.z); h3[5] = bfhi(v.z); h3[6] = bflo(v.w); h3[7] = bfhi(v.w); } }
                for (int rb = r0; rb < r1; rb += 8) {
                    u32x4 vv[8];
#pragma unroll
                    for (int q = 0; q < 8; ++q) { const int row = (rb + q < r1) ? rb + q : r1 - 1; vv[q] = *(const u32x4*)(XBP + (size_t)row * D + c0); }
#pragma unroll
                    for (int q = 0; q < 8; ++q) { const int row = rb + q;
                        if (row < r1) {
                            if ((row & (SEQ - 1)) == 0) {
#pragma unroll
                                for (int e = 0; e < 8; ++e) { h1[e] = 0.f; h2[e] = 0.f; h3[e] = 0.f; } }
                            const float cur[8] = {bflo(vv[q].x), bfhi(vv[q].x), bflo(vv[q].y), bfhi(vv[q].y), bflo(vv[q].z), bfhi(vv[q].z), bflo(vv[q].w), bfhi(vv[q].w)};
                            float acc[8];
#pragma unroll
                            for (int e = 0; e < 8; ++e) { acc[e] = bias[e] + wv[0][e] * h3[e] + wv[1][e] * h2[e] + wv[2][e] * h1[e] + wv[3][e] * cur[e]; h3[e] = h2[e]; h2[e] = h1[e]; h1[e] = cur[e]; }
                            u32x4 o; o.x = pk2(acc[0], acc[1]); o.y = pk2(acc[2], acc[3]); o.z = pk2(acc[4], acc[5]); o.w = pk2(acc[6], acc[7]);
                            *(u32x4*)(XB + (size_t)row * D + c0) = o; } }
                }
            }
            PHASE_END
            PHASE_BEGIN
            { Gemm g = pg8::mk(XN, WSP(bf16, W_GATE), M, 2048, 256); g.lda = 1024; g.a_pm_off = 256L * 1024; g.a_pn_off = 256; g.a_pn_shift = 1; StaticOrder S; S.init(M, 2048, G, bx);
              Epi E{}; E.mode = pg8::E_GATE; E.O = WSP(bf16, WS_B); E.aout = WSP(float, WS_A); E.vec0 = a.od_b_rgate; E.vec1 = a.od_b_igate; E.vec2 = WSP(float, WS_SP8); E.pos = a.pos; E.xb = XN;
              pg8::gemm_phase(lds, g, S, E, fresh_tid(wave)); }
            PHASE_END
            PHASE_BEGIN
            {
                const float* A_ = WSP(float, WS_A); const bf16* B_ = WSP(bf16, WS_B);
                const int grp = tid >> 7, c = 8 * (tid & 127);
                LAS float* X = (LAS float*)lds;
                for (int it = vcu; it < 256; it += G) { const size_t r0 = (size_t)it * 128 + 32 * grp;
                    float A[8], B[8];
#pragma unroll
                    for (int e = 0; e < 8; ++e) { A[e] = 1.f; B[e] = 0.f; }
#pragma unroll 8
                    for (int t = 0; t < 32; ++t) { const f32x4 a0 = *(const f32x4*)(A_ + (r0 + t) * D + c), a1 = *(const f32x4*)(A_ + (r0 + t) * D + c + 4); const u32x4 bw = *(const u32x4*)(B_ + (r0 + t) * D + c);
                        const float av[8] = {a0[0], a0[1], a0[2], a0[3], a1[0], a1[1], a1[2], a1[3]}; const float bv[8] = {bflo(bw.x), bfhi(bw.x), bflo(bw.y), bfhi(bw.y), bflo(bw.z), bfhi(bw.z), bflo(bw.w), bfhi(bw.w)};
#pragma unroll
                        for (int e = 0; e < 8; ++e) { B[e] = av[e] * B[e] + bv[e]; A[e] *= av[e]; } }
                    float* sa = WSP(float, WS_SA) + ((size_t)it * 4 + grp) * D + c; float* sb = WSP(float, WS_SB) + ((size_t)it * 4 + grp) * D + c;
                    *(f32x4*)sa = (f32x4){A[0], A[1], A[2], A[3]}; *(f32x4*)(sa + 4) = (f32x4){A[4], A[5], A[6], A[7]};
                    *(f32x4*)sb = (f32x4){B[0], B[1], B[2], B[3]}; *(f32x4*)(sb + 4) = (f32x4){B[4], B[5], B[6], B[7]};
                    LAS float* xp = X + (grp * 128 + (tid & 127)) * 16;
#pragma unroll
                    for (int e = 0; e < 8; ++e) { xp[e] = A[e]; xp[8 + e] = B[e]; }
                    __syncthreads();
                    if (grp == 0) { float CA_[8], CB_[8];
#pragma unroll
                        for (int e = 0; e < 8; ++e) { CA_[e] = A[e]; CB_[e] = B[e]; }
#pragma unroll
                        for (int g2 = 1; g2 < 4; ++g2) { const LAS float* yp = X + (g2 * 128 + tid) * 16;
#pragma unroll
                            for (int e = 0; e < 8; ++e) { const float a2 = yp[e], b2 = yp[8 + e]; CB_[e] = a2 * CB_[e] + b2; CA_[e] *= a2; } }
                        float* ca = WSP(float, WS_CA) + (size_t)it * D + c; float* cb = WSP(float, WS_CB) + (size_t)it * D + c;
                        *(f32x4*)ca = (f32x4){CA_[0], CA_[1], CA_[2], CA_[3]}; *(f32x4*)(ca + 4) = (f32x4){CA_[4], CA_[5], CA_[6], CA_[7]};
                        *(f32x4*)cb = (f32x4){CB_[0], CB_[1], CB_[2], CB_[3]}; *(f32x4*)(cb + 4) = (f32x4){CB_[4], CB_[5], CB_[6], CB_[7]}; }
                    __syncthreads(); }
            }
            PHASE_END
            PHASE_BEGIN
            {
                const float* A_ = WSP(float, WS_A); const bf16* B_ = WSP(bf16, WS_B); const bf16* GB = WSP(bf16, WS_GB);
                const int grp = tid >> 7, c = 8 * (tid & 127);
                for (int it = vcu; it < 256; it += G) { const size_t r0 = (size_t)it * 128 + 32 * grp; const int j = it & 127, it0 = it - j;
                    float h[8];
#pragma unroll
                    for (int e = 0; e < 8; ++e) h[e] = 0.f;
#pragma unroll 4
                    for (int jj = 0; jj < j; ++jj) { const float* ca = WSP(float, WS_CA) + (size_t)(it0 + jj) * D + c; const float* cb = WSP(float, WS_CB) + (size_t)(it0 + jj) * D + c;
                        const f32x4 a0 = *(const f32x4*)ca, a1 = *(const f32x4*)(ca + 4), b0 = *(const f32x4*)cb, b1 = *(const f32x4*)(cb + 4);
#pragma unroll
                        for (int e = 0; e < 4; ++e) { h[e] = a0[e] * h[e] + b0[e]; h[4 + e] = a1[e] * h[4 + e] + b1[e]; } }
                    for (int g2 = 0; g2 < grp; ++g2) { const float* sa = WSP(float, WS_SA) + ((size_t)it * 4 + g2) * D + c; const float* sb = WSP(float, WS_SB) + ((size_t)it * 4 + g2) * D + c;
                        const f32x4 a0 = *(const f32x4*)sa, a1 = *(const f32x4*)(sa + 4), b0 = *(const f32x4*)sb, b1 = *(const f32x4*)(sb + 4);
#pragma unroll
                        for (int e = 0; e < 4; ++e) { h[e] = a0[e] * h[e] + b0[e]; h[4 + e] = a1[e] * h[4 + e] + b1[e]; } }
#pragma unroll 8
                    for (int t = 0; t < 32; ++t) { const f32x4 a0 = *(const f32x4*)(A_ + (r0 + t) * D + c), a1 = *(const f32x4*)(A_ + (r0 + t) * D + c + 4); const u32x4 bw = *(const u32x4*)(B_ + (r0 + t) * D + c), gv = *(const u32x4*)(GB + (r0 + t) * D + c);
                        const float av[8] = {a0[0], a0[1], a0[2], a0[3], a1[0], a1[1], a1[2], a1[3]}; const float bv[8] = {bflo(bw.x), bfhi(bw.x), bflo(bw.y), bfhi(bw.y), bflo(bw.z), bfhi(bw.z), bflo(bw.w), bfhi(bw.w)};
                        const float gg[8] = {bflo(gv.x), bfhi(gv.x), bflo(gv.y), bfhi(gv.y), bflo(gv.z), bfhi(gv.z), bflo(gv.w), bfhi(gv.w)};
#pragma unroll
                        for (int e = 0; e < 8; ++e) h[e] = av[e] * h[e] + bv[e];
                        u32x4 o; o.x = pk2(gg[0] * h[0], gg[1] * h[1]); o.y = pk2(gg[2] * h[2], gg[3] * h[3]); o.z = pk2(gg[4] * h[4], gg[5] * h[5]); o.w = pk2(gg[6] * h[6], gg[7] * h[7]);
                        *(u32x4*)(MIX + (r0 + t) * D + c) = o; }
                }
            }
            PHASE_END
            PHASE_BEGIN
            { Gemm g = pg8::mk(MIX, WSP(bf16, W_ODOUT), M, 1024, 1024); StaticOrder S; S.init(M, 1024, G, bx);
              Epi E{}; E.mode = pg8::E_RES; E.base = outp; E.out = outp; E.O = XN; E.aout = WSP(float, WS_SSQ) + 3 * (size_t)M; pg8::gemm_phase(lds, g, S, E, fresh_tid(wave)); }
            PHASE_END
        }
        PHASE_BEGIN
        { Gemm g = pg8::mk(XN, WSP(bf16, WS_WQK) + (size_t)l * 2 * 1024 * 1024, M, 1024, 1024); g.b_pm_div = 64; g.b_pm_off = 1024L * 1024; StaticOrder S; S.init(M, 1024, G, bx);
          Epi E{}; E.mode = pg8::E_SOFTMAX; E.O = WSP(bf16, WS_P); E.ldc = 1024; E.scale = 0.0625f * LOG2E; E.vec0 = WSP(float, WS_SSQ) + (size_t)(3 * l) * M; pg8::gemm_phase(lds, g, S, E, fresh_tid(wave)); }
        PHASE_END
        PHASE_BEGIN
        { Gemm g = pg8::mk(WSP(bf16, WS_P), WSP(bf16, WS_WPP) + (size_t)l * 2 * 1024 * 1024, M, 1024, 1024); g.b_pm_div = 64; g.b_pm_off = 1024L * 1024; StaticOrder S; S.init(M, 1024, G, bx);
          Epi E{}; E.mode = pg8::E_RES; E.base = outp; E.out = outp; E.O = XN; E.aout = WSP(float, WS_SSQ) + (size_t)(3 * l + 1) * M; pg8::gemm_phase(lds, g, S, E, fresh_tid(wave)); }
        PHASE_END
        PHASE_BEGIN
        { Gemm g = pg8::mk(XN, WSP(bf16, W_FFN1 + l * 11 * MiB), M, 2 * DFF, 1024); StaticOrder S; S.init(M, 2 * DFF, G, bx);
          Epi E{}; E.mode = pg8::E_SWIGLU; E.O = WSP(bf16, WS_H); E.vec0 = WSP(float, WS_SSQ) + (size_t)(3 * l + 1) * M; pg8::gemm_phase(lds, g, S, E, fresh_tid(wave)); }
        PHASE_END
        PHASE_BEGIN
        { Gemm g = pg8::mk(WSP(bf16, WS_H), WSP(bf16, W_FFN2) + (size_t)l * (1024 * DFF), M, 1024, DFF); StaticOrder S; S.init(M, 1024, G, bx);
          Epi E{}; E.mode = pg8::E_RES; E.base = outp; E.out = outp; E.O = (l == 0) ? XN : nullptr; E.aout = WSP(float, WS_SSQ) + (size_t)(l == 0 ? 2 : 5) * M; pg8::gemm_phase(lds, g, S, E, fresh_tid(wave)); }
        PHASE_END
    }

    PHASE_BEGIN
    {
        const f32x4* gr = (const f32x4*)a.final_norm + lane; const float* ssq = WSP(float, WS_SSQ) + 5 * (size_t)M;
        f32x4 gg[4];
#pragma unroll
        for (int j = 0; j < 4; ++j) gg[j] = gr[64 * j];
        int m = gw;
        for (; m + 3 * NGW < M; m += 4 * NGW) {
            f32x4 v[4][4]; float rs[4];
#pragma unroll
            for (int q = 0; q < 4; ++q) { const f32x4* xr = (const f32x4*)(outp + (size_t)(m + q * NGW) * D) + lane; rs[q] = ssq[m + q * NGW];
#pragma unroll
                for (int j = 0; j < 4; ++j) v[q][j] = xr[64 * j]; }
#pragma unroll
            for (int q = 0; q < 4; ++q) { f32x4* xr = (f32x4*)(outp + (size_t)(m + q * NGW) * D) + lane; const float rstd = rsqrtf(rs[q] * (1.f / D) + RMS_EPS);
#pragma unroll
                for (int j = 0; j < 4; ++j) xr[64 * j] = v[q][j] * rstd * gg[j]; }
        }
        for (; m < M; m += NGW) { f32x4* xr = (f32x4*)(outp + (size_t)m * D) + lane; const float rstd = rsqrtf(ssq[m] * (1.f / D) + RMS_EPS);
#pragma unroll
            for (int j = 0; j < 4; ++j) xr[64 * j] = xr[64 * j] * rstd * gg[j]; }
    }
    PHASE_END
    }
}
#undef a
constexpr int N_PHASES = 6 + 6 + 8 + 1;

#ifndef MK_N_LAUNCHES
#define MK_N_LAUNCHES 1
#endif
extern "C" void kernel_launch(void* const* d_in, const int* in_sizes, int n_in, void* d_out, int out_size, void* d_ws, size_t ws_size, hipStream_t stream) {
    static int grid = 0;
    if (grid == 0) {
        if (n_in != 31 || ws_size < WS_NEED) { fprintf(stderr, "kernel_launch: unexpected n_in %d or ws_size %zu\n", n_in, ws_size); grid = -1; return; }
        int dev = 0, cus = 0, per_cu = 0;
        hipGetDevice(&dev); hipDeviceGetAttribute(&cus, hipDeviceAttributeMultiprocessorCount, dev);
        if (hipFuncSetAttribute((const void*)hybrid_fwd, hipFuncAttributeMaxDynamicSharedMemorySize, LDS_BYTES) != hipSuccess) { fprintf(stderr, "kernel_launch: hipFuncSetAttribute failed\n"); grid = -1; return; }
        hipOccupancyMaxActiveBlocksPerMultiprocessor(&per_cu, (const void*)hybrid_fwd, NTHREADS, LDS_BYTES);
        (void)hipGetLastError();
        if (per_cu < 1) per_cu = 1;
        grid = cus * 1;
        if (grid > 256) grid = 256;
    }
    if (grid < 0) return;
    Args a{};
    const float* const* f = (const float* const*)d_in;
    a.x = f[0]; a.mem = f[1]; a.pos = (const int*)d_in[2];
    a.ev_norm = f[3]; a.ev_w_in = f[4]; a.ev_pool_w = f[5]; a.ev_pool_scale = f[6]; a.ev_q_norm = f[7]; a.ev_w_q_up = f[8]; a.ev_kv_norm = f[9]; a.ev_w_kv_up = f[10]; a.ev_w_out = f[11];
    a.od_norm = f[12]; a.od_w_in = f[13]; a.od_conv_w = f[14]; a.od_conv_b = f[15]; a.od_w_rgate = f[16]; a.od_b_rgate = f[17]; a.od_w_igate = f[18]; a.od_b_igate = f[19]; a.od_lambda = f[20]; a.od_w_out = f[21];
    a.xa_norm_x = f[22]; a.xa_norm_mem = f[23]; a.xa_w_q = f[24]; a.xa_w_kv = f[25]; a.xa_w_o = f[26]; a.ffn_norm = f[27]; a.ffn_w_gate_up = f[28]; a.ffn_w_down = f[29]; a.final_norm = f[30];
    a.out = (float*)d_out; a.ws = (unsigned char*)d_ws;
#if MK_N_LAUNCHES == 1
    if (hipMemsetAsync((unsigned char*)d_ws + WS_BAR, 0, 16384, stream) != hipSuccess) { fprintf(stderr, "kernel_launch: memset failed\n"); return; }
    a.ph_lo = 0; a.ph_hi = N_PHASES;
    void* args[] = {&a};
    hipError_t e = hipLaunchCooperativeKernel((const void*)hybrid_fwd, dim3(grid), dim3(NTHREADS), args, LDS_BYTES, stream);
    if (e != hipSuccess) fprintf(stderr, "kernel_launch: cooperative launch failed: %s (grid %d)\n", hipGetErrorString(e), grid);
#else
    for (int p = 0; p < N_PHASES; ++p) { a.ph_lo = p; a.ph_hi = p + 1; hipLaunchKernelGGL(hybrid_fwd, dim3(grid), dim3(NTHREADS), LDS_BYTES, stream, a); }
#endif
}
```

```cpp
#include <hip/hip_runtime.h>
#include <hip/hip_cooperative_groups.h>
#include <cstdio>
#include <cstdint>
namespace cg = cooperative_groups;

#define LAS __attribute__((address_space(3)))
typedef unsigned short bf16;
typedef short bf16x8 __attribute__((ext_vector_type(8)));
typedef short s16x4 __attribute__((ext_vector_type(4)));
typedef float f32x4 __attribute__((ext_vector_type(4)));
typedef float f32x2 __attribute__((ext_vector_type(2)));
typedef float f32x16 __attribute__((ext_vector_type(16)));
typedef unsigned u32x4 __attribute__((ext_vector_type(4)));
typedef unsigned u32x2 __attribute__((ext_vector_type(2)));

constexpr int SEQ = 16384, BATCH = 2, M = BATCH * SEQ, D = 1024;
constexpr int DFF = 2816;
constexpr float RMS_EPS = 1e-6f;
constexpr float LOG2E = 1.4426950408889634f;
constexpr int NTHREADS = 512, NWAVES = 8;
constexpr int RING_BYTES = 131072, LDS_BYTES = 147456, EPI_OFF = RING_BYTES;

typedef __bf16 bf16x2_t __attribute__((ext_vector_type(2)));
__device__ __forceinline__ unsigned pk2(float lo, float hi) { f32x2 v = {lo, hi}; bf16x2_t b = __builtin_convertvector(v, bf16x2_t); return __builtin_bit_cast(unsigned, b); }
__device__ __forceinline__ float bflo(unsigned w) { return __uint_as_float(w << 16); }
__device__ __forceinline__ float bfhi(unsigned w) { return __uint_as_float(w & 0xffff0000u); }
__device__ __forceinline__ float ex2(float x) { return __builtin_amdgcn_exp2f(x); }
__device__ __forceinline__ float rcp(float x) { return __builtin_amdgcn_rcpf(x); }
__device__ __forceinline__ float sigmoidf_(float x) { return rcp(1.0f + ex2(-x * LOG2E)); }
__device__ __forceinline__ float gelu_tanh(float x) { const float u = 0.7978845608028654f * (x + 0.044715f * x * x * x); return x * sigmoidf_(2.0f * u); }
__device__ __forceinline__ float wave_sum(float v) {
#pragma unroll
    for (int o = 1; o < 64; o <<= 1) v += __shfl_xor(v, o);
    return v;
}
#define LDS_WAIT() asm volatile("s_waitcnt lgkmcnt(0)" ::: "memory")

namespace pg8 {
constexpr int BM = 256, BK = 64, HALF = 128, HTB = HALF * BK * 2, NXCD = 8, WGM = 4;
__host__ __device__ __forceinline__ int lds_byte(int r, int c) { const int st = (r >> 4) * 2 + (c >> 5), rr = r & 15, cc = c & 31, ob = rr * 64 + cc * 2; return st * 1024 + (ob ^ (((ob >> 9) & 1) << 5)); }
__host__ __device__ __forceinline__ void stage_rc(int b, int& R, int& C) { const int st = b / 1024, sb = b % 1024, swz = sb ^ (((sb >> 9) & 1) << 5); R = (st >> 1) * 16 + swz / 64; C = (st & 1) * 32 + (swz % 64) / 2; }
struct Unit { int pm, pn; };
struct Gemm { const bf16* A; const bf16* Bt; int Mr, N, K, lda, ldb; long a_pm_off, a_pn_off; int a_pn_shift; long b_pn_off; int b_pm_div; long b_pm_off; };
__device__ __forceinline__ Gemm mk(const bf16* A, const bf16* Bt, int Mr, int N, int K) {
    Gemm g; g.A = A; g.Bt = Bt; g.Mr = Mr; g.N = N; g.K = K; g.lda = K; g.ldb = K; g.a_pm_off = 256L * K; g.a_pn_off = 0; g.a_pn_shift = 0; g.b_pn_off = 256L * K; g.b_pm_div = 1 << 30; g.b_pm_off = 0; return g; }
struct StaticOrder {
    int nM, nN, nwg, G, c;
    __device__ void init(int Mr, int N, int G_, int c_) { nM = Mr / BM; nN = N / BM; nwg = nM * nN; G = G_; c = c_; }
    __device__ bool next(int i, Unit& u) const {
        const long L = (long)i * G + c; if (L >= nwg) return false;
        int wgid = (int)L; { const int q = nwg / NXCD, r = nwg % NXCD, xcd = wgid % NXCD, off = wgid / NXCD; wgid = (xcd < r ? xcd * (q + 1) : r * (q + 1) + (xcd - r) * q) + off; }
        const int nig = WGM * nN, gid = wgid / nig, fm = gid * WGM, gsz = (nM - fm) < WGM ? (nM - fm) : WGM;
        u.pm = fm + ((wgid % nig) % gsz); u.pn = (wgid % nig) / gsz; return true;
    }
};

enum { E_PLAIN = 0, E_EVIN, E_QROPE, E_POOL, E_RES, E_SOFTMAX, E_SWIGLU, E_ODIN, E_GATE, E_VT };
struct Epi {
    int mode;
    bf16* O; int ldc; float scale;
    bf16 *O2, *O3, *O4;
    const float* base; float* out;
    const float *cosT, *sinT;
    const float *vec0, *vec1, *vec2;
    const int* pos;
    const bf16* xb; float* aout;
};
__device__ __forceinline__ void st8(bf16* p, f32x4 v0, f32x4 v1) { u32x4 w; w.x = pk2(v0[0], v0[1]); w.y = pk2(v0[2], v0[3]); w.z = pk2(v1[0], v1[1]); w.w = pk2(v1[2], v1[3]); *(u32x4*)p = w; }
__device__ __forceinline__ void st4(bf16* p, f32x4 v) { u32x2 w; w.x = pk2(v[0], v[1]); w.y = pk2(v[2], v[3]); *(u32x2*)p = w; }

__device__ __forceinline__ void run_epi(const Epi& E, f32x4 (&acc)[2][2][4][2], const Unit& u, int wr, int wc, int fr, int fq, LAS unsigned char* lds) {
    const int rowb = u.pm * BM + wr * 64 + fr, colb = u.pn * BM + wc * 32 + 4 * fq;
    const int colp = u.pn * BM + wc * 32 + 8 * fq;
    switch (E.mode) {
    case E_PLAIN: {
#pragma unroll
        for (int ai = 0; ai < 2; ++ai)
#pragma unroll
            for (int m = 0; m < 4; ++m) { const size_t row = (size_t)(rowb + ai * HALF + m * 16); bf16* rp = E.O + row * E.ldc + colp;
                float sc = E.scale; if (E.vec0) sc *= rsqrtf(E.vec0[row] * (1.f / D) + RMS_EPS);
#pragma unroll
                for (int bj = 0; bj < 2; ++bj) st8(rp + bj * HALF, acc[ai][bj][m][0] * sc, acc[ai][bj][m][1] * sc); }
    } break;
    case E_EVIN: {
        const int pn = u.pn; const float sgn = (fq < 2) ? -1.f : 1.f; const int ci = 8 * (fq & 1);
#pragma unroll
        for (int ai = 0; ai < 2; ++ai)
#pragma unroll
            for (int m = 0; m < 4; ++m) { const size_t row = (size_t)(rowb + ai * HALF + m * 16);
                if (pn < 2) { bf16* rp = E.O + row * 512 + colp;
#pragma unroll
                    for (int bj = 0; bj < 2; ++bj) st8(rp + bj * HALF, acc[ai][bj][m][0], acc[ai][bj][m][1]);
                } else if (pn == 2) { bf16* rp = E.O2 + row * 256 + (colp - 512);
#pragma unroll
                    for (int bj = 0; bj < 2; ++bj) st8(rp + bj * HALF, acc[ai][bj][m][0], acc[ai][bj][m][1]);
                } else { st8(E.O3 + row * 128 + (colp - 768), acc[ai][0][m][0], acc[ai][0][m][1]);
                    if (wc == 0) { const f32x4 v0 = acc[ai][1][m][0], v1 = acc[ai][1][m][1]; f32x4 p0, p1;
#pragma unroll
                        for (int e = 0; e < 4; ++e) { p0[e] = __shfl_xor(v0[e], 32); p1[e] = __shfl_xor(v1[e], 32); }
                        const f32x4 c0 = *(const f32x4*)(E.cosT + row * 16 + ci), c1 = *(const f32x4*)(E.cosT + row * 16 + ci + 4), s0 = *(const f32x4*)(E.sinT + row * 16 + ci), s1 = *(const f32x4*)(E.sinT + row * 16 + ci + 4);
                        st8(E.O4 + row * 32 + 8 * fq, v0 * c0 + p0 * s0 * sgn, v1 * c1 + p1 * s1 * sgn); }
                } }
    } break;
    case E_QROPE: {
        const float sgn = (fq < 2) ? -1.f : 1.f; const int ci = 8 * (fq & 1);
#pragma unroll
        for (int bj = 0; bj < 2; ++bj) { const int cb = u.pn * BM + bj * HALF + wc * 32; const bool rope = (cb % 96) == 64;
#pragma unroll
            for (int ai = 0; ai < 2; ++ai)
#pragma unroll
                for (int m = 0; m < 4; ++m) { const size_t row = (size_t)(rowb + ai * HALF + m * 16); bf16* rp = E.O + row * 768 + cb + 8 * fq;
                    f32x4 v0 = acc[ai][bj][m][0] * E.scale, v1 = acc[ai][bj][m][1] * E.scale;
                    if (rope) { f32x4 p0, p1;
#pragma unroll
                        for (int e = 0; e < 4; ++e) { p0[e] = __shfl_xor(v0[e], 32); p1[e] = __shfl_xor(v1[e], 32); }
                        const f32x4 c0 = *(const f32x4*)(E.cosT + row * 16 + ci), c1 = *(const f32x4*)(E.cosT + row * 16 + ci + 4), s0 = *(const f32x4*)(E.sinT + row * 16 + ci), s1 = *(const f32x4*)(E.sinT + row * 16 + ci + 4);
                        v0 = v0 * c0 + p0 * s0 * sgn; v1 = v1 * c1 + p1 * s1 * sgn; }
                    st8(rp, v0, v1); } }
    } break;
    case E_POOL: {
#pragma unroll
        for (int bj = 0; bj < 2; ++bj) { const int col = colp + bj * HALF; const f32x4 s0 = *(const f32x4*)(E.vec0 + col), s1 = *(const f32x4*)(E.vec0 + col + 4);
#pragma unroll
            for (int ai = 0; ai < 2; ++ai)
#pragma unroll
                for (int m = 0; m < 4; ++m) st8(E.O + (size_t)(rowb + ai * HALF + m * 16) * E.ldc + col, acc[ai][bj][m][0] * s0, acc[ai][bj][m][1] * s1); }
    } break;
    case E_RES: {
        f32x4 bs[2][2][2][2];
#define RES_LOAD(ch) do { _Pragma("unroll") for (int g_ = 0; g_ < 2; ++g_) { const int ai_ = (ch) >> 1, m_ = 2 * ((ch) & 1) + g_; const size_t off_ = (size_t)(rowb + ai_ * HALF + m_ * 16) * D + colp; \
            _Pragma("unroll") for (int bj = 0; bj < 2; ++bj) _Pragma("unroll") for (int n = 0; n < 2; ++n) bs[(ch) & 1][g_][bj][n] = *(const f32x4*)(E.base + off_ + bj * HALF + n * 4); } } while (0)
        RES_LOAD(0);
#pragma unroll
        for (int ch = 0; ch < 4; ++ch) {
            if (ch < 3) RES_LOAD(ch + 1);
#pragma unroll
            for (int g_ = 0; g_ < 2; ++g_) { const int ai = ch >> 1, m = 2 * (ch & 1) + g_; const size_t row = (size_t)(rowb + ai * HALF + m * 16); const size_t off = row * D + colp; float q = 0.f;
#pragma unroll
                for (int bj = 0; bj < 2; ++bj) { const f32x4 o0 = bs[ch & 1][g_][bj][0] + acc[ai][bj][m][0], o1 = bs[ch & 1][g_][bj][1] + acc[ai][bj][m][1];
                    *(f32x4*)(E.out + off + bj * HALF) = o0; *(f32x4*)(E.out + off + bj * HALF + 4) = o1;
                    if (E.O) st8(E.O + off + bj * HALF, o0, o1);
                    q += (o0[0] * o0[0] + o0[1] * o0[1]) + (o0[2] * o0[2] + o0[3] * o0[3]) + (o1[0] * o1[0] + o1[1] * o1[1]) + (o1[2] * o1[2] + o1[3] * o1[3]); }
                q += __shfl_xor(q, 16); q += __shfl_xor(q, 32);
                if (fq == 0) atomicAdd(E.aout + row, q); }
            asm volatile("" ::: "memory"); }
#undef RES_LOAD
    } break;
    case E_SOFTMAX: {
        LAS float* RM = (LAS float*)(lds + EPI_OFF);
        LAS float* RS = (LAS float*)(lds + EPI_OFF + 4096);
#pragma unroll
        for (int ai = 0; ai < 2; ++ai)
#pragma unroll
            for (int m = 0; m < 4; ++m) { float mx = -3.0e38f;
                float sc = E.scale; if (E.vec0) sc *= rsqrtf(E.vec0[(size_t)(rowb + ai * HALF + m * 16)] * (1.f / D) + RMS_EPS);
#pragma unroll
                for (int bj = 0; bj < 2; ++bj)
#pragma unroll
                    for (int n = 0; n < 2; ++n) { const f32x4 x = acc[ai][bj][m][n] * sc; acc[ai][bj][m][n] = x; mx = fmaxf(mx, fmaxf(fmaxf(x[0], x[1]), fmaxf(x[2], x[3]))); }
                mx = fmaxf(mx, __shfl_xor(mx, 16)); mx = fmaxf(mx, __shfl_xor(mx, 32));
                if (fq == 0) RM[(ai * HALF + wr * 64 + m * 16 + fr) * 4 + wc] = mx; }
        LDS_WAIT(); __builtin_amdgcn_s_barrier(); asm volatile("" ::: "memory");
#pragma unroll
        for (int ai = 0; ai < 2; ++ai)
#pragma unroll
            for (int m = 0; m < 4; ++m) { const int rl = ai * HALF + wr * 64 + m * 16 + fr; const f32x4 mm = *(LAS f32x4*)(RM + rl * 4);
                const float mx = fmaxf(fmaxf(mm[0], mm[1]), fmaxf(mm[2], mm[3])); float s = 0.f;
#pragma unroll
                for (int bj = 0; bj < 2; ++bj)
#pragma unroll
                    for (int n = 0; n < 2; ++n) { f32x4 x = acc[ai][bj][m][n]; x[0] = ex2(x[0] - mx); x[1] = ex2(x[1] - mx); x[2] = ex2(x[2] - mx); x[3] = ex2(x[3] - mx); acc[ai][bj][m][n] = x; s += (x[0] + x[1]) + (x[2] + x[3]); }
                s += __shfl_xor(s, 16); s += __shfl_xor(s, 32);
                if (fq == 0) RS[rl * 4 + wc] = s; }
        LDS_WAIT(); __builtin_amdgcn_s_barrier(); asm volatile("" ::: "memory");
#pragma unroll
        for (int ai = 0; ai < 2; ++ai)
#pragma unroll
            for (int m = 0; m < 4; ++m) { const int rl = ai * HALF + wr * 64 + m * 16 + fr; const f32x4 ss = *(LAS f32x4*)(RS + rl * 4);
                const float inv = rcp((ss[0] + ss[1]) + (ss[2] + ss[3])); bf16* rp = E.O + (size_t)(u.pm * BM + rl) * E.ldc + colp;
#pragma unroll
                for (int bj = 0; bj < 2; ++bj) st8(rp + bj * HALF, acc[ai][bj][m][0] * inv, acc[ai][bj][m][1] * inv); }
    } break;
    case E_SWIGLU: {
        const int colh = u.pn * HALF + wc * 32 + 8 * fq;
#pragma unroll
        for (int ai = 0; ai < 2; ++ai)
#pragma unroll
            for (int m = 0; m < 4; ++m) { const size_t row = (size_t)(rowb + ai * HALF + m * 16); const float rs = rsqrtf(E.vec0[row] * (1.f / D) + RMS_EPS); f32x4 o[2];
#pragma unroll
                for (int n = 0; n < 2; ++n) { const f32x4 g = acc[ai][0][m][n] * rs, uu = acc[ai][1][m][n] * rs;
#pragma unroll
                    for (int e = 0; e < 4; ++e) o[n][e] = g[e] * sigmoidf_(g[e]) * uu[e]; }
                st8(E.O + row * DFF + colh, o[0], o[1]); }
    } break;
    case E_ODIN: {
        const bool isg = u.pn < 4;
#pragma unroll
        for (int ai = 0; ai < 2; ++ai)
#pragma unroll
            for (int m = 0; m < 4; ++m) { const size_t row = (size_t)(rowb + ai * HALF + m * 16); const float rs = rsqrtf(E.vec0[row] * (1.f / D) + RMS_EPS);
                bf16* rp = (isg ? E.O + row * D + colp : E.O2 + row * D + (colp - D));
#pragma unroll
                for (int bj = 0; bj < 2; ++bj) { f32x4 v0 = acc[ai][bj][m][0] * rs, v1 = acc[ai][bj][m][1] * rs;
                    if (isg) {
#pragma unroll
                        for (int e = 0; e < 4; ++e) { v0[e] = gelu_tanh(v0[e]); v1[e] = gelu_tanh(v1[e]); } }
                    st8(rp + bj * HALF, v0, v1); } }
    } break;
    case E_GATE: {
        const int c = (u.pn >> 1) * 256 + (u.pn & 1) * HALF + wc * 32 + 8 * fq;
        f32x4 br[2], bi[2], sp[2];
#pragma unroll
        for (int n = 0; n < 2; ++n) { br[n] = *(const f32x4*)(E.vec0 + c + 4 * n); bi[n] = *(const f32x4*)(E.vec1 + c + 4 * n); sp[n] = *(const f32x4*)(E.vec2 + c + 4 * n); }
#pragma unroll
        for (int ai = 0; ai < 2; ++ai) {
            u32x4 xws[4]; int pss[4];
#pragma unroll
            for (int m = 0; m < 4; ++m) { const size_t row = (size_t)(rowb + ai * HALF + m * 16); xws[m] = *(const u32x4*)(E.xb + row * D + c); pss[m] = E.pos[row]; }
#pragma unroll
            for (int m = 0; m < 4; ++m) { const size_t row = (size_t)(rowb + ai * HALF + m * 16); const bool rst = pss[m] == 0;
                const u32x4 xw = xws[m]; const float xv[8] = {bflo(xw.x), bfhi(xw.x), bflo(xw.y), bfhi(xw.y), bflo(xw.z), bfhi(xw.z), bflo(xw.w), bfhi(xw.w)};
                f32x4 av[2], bv[2];
#pragma unroll
                for (int n = 0; n < 2; ++n) { const f32x4 pr = acc[ai][0][m][n] + br[n], pi = acc[ai][1][m][n] + bi[n];
#pragma unroll
                    for (int e = 0; e < 4; ++e) { const float r = sigmoidf_(pr[e]), ig = sigmoidf_(pi[e]); const float la = -sp[n][e] * r; float a = ex2(la * LOG2E);
                        const float x2 = 2.0f * la; const float om = (x2 > -0.01f) ? -(x2 + x2 * x2 * (0.5f + x2 * (1.0f / 6.0f))) : 1.0f - ex2(x2 * LOG2E);
                        float mult = sqrtf(fmaxf(om, 0.f)); if (rst) { a = 0.f; mult = 1.f; }
                        av[n][e] = a; bv[n][e] = mult * (ig * xv[4 * n + e]); } }
                *(f32x4*)(E.aout + row * D + c) = av[0]; *(f32x4*)(E.aout + row * D + c + 4) = av[1]; st8(E.O + row * D + c, bv[0], bv[1]); }
            asm volatile("" ::: "memory"); }
    } break;
    case E_VT: {
#pragma unroll
        for (int ai = 0; ai < 2; ++ai)
#pragma unroll
            for (int m = 0; m < 4; ++m) { const size_t row = (size_t)(rowb + ai * HALF + m * 16);
#pragma unroll
                for (int bj = 0; bj < 2; ++bj) { const int col = colp + bj * HALF, b16 = col & ~15, hf = (col >> 3) & 1; bf16* rp = E.O + row * E.ldc + b16 + 4 * hf;
                    st4(rp, acc[ai][bj][m][0]); st4(rp + 8, acc[ai][bj][m][1]); } }
    } break;
    default: break;
    }
}

__device__ __forceinline__ void gemm_phase(LAS unsigned char* lds, const Gemm g, const StaticOrder& S, const Epi& E, const int tid) {
    const int wid = __builtin_amdgcn_readfirstlane(tid >> 6), lane = tid & 63, wr = wid >> 2, wc = wid & 3, fr = lane & 15, fq = lane >> 4;
    const int K = g.K, nt = K / BK;
    unsigned voffA, voffB;
    { int R, C; stage_rc(tid * 16, R, C); const bool perm = true;
      const int rho = R & 31, Rb = perm ? ((R & ~31) + 8 * ((rho & 15) >> 2) + 4 * (rho >> 4) + (rho & 3)) : R;
      voffA = (unsigned)(R * g.lda + C) * 2u; voffB = (unsigned)(Rb * g.ldb + C) * 2u; }
    const size_t q64A = (size_t)64 * g.lda * 2, q64B = (size_t)64 * g.ldb * 2;
    const size_t kstep = (size_t)(BK * 2);
    const size_t hstepA = (size_t)HALF * g.lda * 2, hstepB = (size_t)HALF * g.ldb * 2;
    const unsigned ldsw = (unsigned)wid * 1024u;
    const int aoff = lds_byte(wr * 64 + fr, fq * 8), boff = lds_byte(wc * 32 + fr, fq * 8);
#define PG8_ABASE(u) ((const char*)g.A + ((size_t)(u).pm * g.a_pm_off + (size_t)((u).pn >> g.a_pn_shift) * g.a_pn_off) * 2)
#define PG8_BBASE(u) ((const char*)g.Bt + ((size_t)(u).pn * g.b_pn_off + (size_t)((u).pm / g.b_pm_div) * g.b_pm_off) * 2)
#define PG8_SA(b, h) (((b) * 2 + (h)) * HTB)
#define PG8_SB(b, h) ((4 + (b) * 2 + (h)) * HTB)
#define PG8_Q64(v) PG8_Q64_##v
#define PG8_Q64_voffA q64A
#define PG8_Q64_voffB q64B
#define PG8_STAGE(bufoff, gbase, voff) do { \
        __builtin_amdgcn_global_load_lds((const unsigned*)((const char*)(gbase) + (voff)), (LAS unsigned*)(lds + (bufoff) + ldsw), 16, 0, 0); \
        __builtin_amdgcn_global_load_lds((const unsigned*)((const char*)(gbase) + PG8_Q64(voff) + (voff)), (LAS unsigned*)(lds + (bufoff) + ldsw + 8192), 16, 0, 0); } while (0)
#define PG8_LDA(dst, b, h) do { _Pragma("unroll") for (int m = 0; m < 4; ++m) _Pragma("unroll") for (int k = 0; k < 2; ++k) dst[m][k] = *(const LAS bf16x8*)(lds + PG8_SA(b, h) + aoff + m * 2048 + k * 1024); } while (0)
#define PG8_LDB(dst, b, h) do { _Pragma("unroll") for (int n = 0; n < 2; ++n) _Pragma("unroll") for (int k = 0; k < 2; ++k) dst[n][k] = *(const LAS bf16x8*)(lds + PG8_SB(b, h) + boff + n * 2048 + k * 1024); } while (0)
#define PG8_MMA(ai, bj, At, Bt) do { __builtin_amdgcn_s_setprio(1); _Pragma("unroll") for (int m = 0; m < 4; ++m) _Pragma("unroll") for (int n = 0; n < 2; ++n) _Pragma("unroll") for (int k = 0; k < 2; ++k) \
        acc[ai][bj][m][n] = __builtin_amdgcn_mfma_f32_16x16x32_bf16(Bt[n][k], At[m][k], acc[ai][bj][m][n], 0, 0, 0); __builtin_amdgcn_s_setprio(0); } while (0)
#define PG8_WAIT_V(n) asm volatile("s_waitcnt vmcnt(" #n ")" ::: "memory")
#define PG8_WAIT_L(n) asm volatile("s_waitcnt lgkmcnt(" #n ")" ::: "memory")
#define PG8_BAR __builtin_amdgcn_s_barrier()
#define PG8_SCHED __builtin_amdgcn_sched_barrier(0)
    Unit cur, nxt; int ui = 0;
    if (!S.next(0, cur)) return;
    f32x4 acc[2][2][4][2];
#pragma unroll
    for (int a = 0; a < 2; ++a)
#pragma unroll
        for (int b = 0; b < 2; ++b)
#pragma unroll
            for (int m = 0; m < 4; ++m)
#pragma unroll
                for (int n = 0; n < 2; ++n) acc[a][b][m][n] = (f32x4){0.f, 0.f, 0.f, 0.f};
    bf16x8 At[4][2], B0[2][2], B1[2][2];
    const char* cA = PG8_ABASE(cur); const char* cB = PG8_BBASE(cur);
    PG8_STAGE(PG8_SB(0, 0), cB, voffB); PG8_STAGE(PG8_SB(0, 1), cB + hstepB, voffB); PG8_STAGE(PG8_SA(0, 0), cA, voffA); PG8_STAGE(PG8_SA(0, 1), cA + hstepA, voffA);
    if (wr == 1) PG8_BAR;
    PG8_WAIT_V(2); PG8_BAR;
    PG8_STAGE(PG8_SB(1, 0), cB + kstep, voffB); PG8_STAGE(PG8_SA(1, 0), cA + kstep, voffA); PG8_STAGE(PG8_SB(1, 1), cB + hstepB + kstep, voffB);
    PG8_WAIT_V(6); PG8_BAR;
    for (;;) {
        const bool has_next = S.next(ui + 1, nxt);
        const char* nA = has_next ? PG8_ABASE(nxt) : cA; const char* nB = has_next ? PG8_BBASE(nxt) : cB;
        for (int t = 0; t < nt; t += 2) {
            const bool last = (t == nt - 2);
            const char* a1 = cA + (size_t)(t + 1) * kstep;
            const char* a2 = last ? nA : cA + (size_t)(t + 2) * kstep; const char* b2 = last ? nB : cB + (size_t)(t + 2) * kstep;
            const char* a3 = a2 + kstep; const char* b3 = b2 + kstep;
            PG8_LDB(B0, 0, 0); PG8_LDB(B1, 0, 1); PG8_SCHED; PG8_LDA(At, 0, 0); PG8_STAGE(PG8_SA(1, 1), a1 + hstepA, voffA);
            PG8_WAIT_V(8); PG8_WAIT_L(0); PG8_BAR; PG8_MMA(0, 0, At, B0); PG8_MMA(0, 1, At, B1); PG8_BAR; PG8_SCHED;
            PG8_LDA(At, 0, 1); PG8_STAGE(PG8_SB(0, 0), b2, voffB); PG8_STAGE(PG8_SB(0, 1), b2 + hstepB, voffB); PG8_STAGE(PG8_SA(0, 0), a2, voffA);
            PG8_WAIT_V(8); PG8_WAIT_L(0); PG8_BAR; PG8_MMA(1, 0, At, B0); PG8_MMA(1, 1, At, B1); PG8_BAR; PG8_SCHED;
            PG8_LDB(B0, 1, 0); PG8_LDB(B1, 1, 1); PG8_SCHED; PG8_LDA(At, 1, 0); PG8_STAGE(PG8_SA(0, 1), a2 + hstepA, voffA);
            PG8_WAIT_V(8); PG8_WAIT_L(0); PG8_BAR; PG8_MMA(0, 0, At, B0); PG8_MMA(0, 1, At, B1); PG8_BAR; PG8_SCHED;
            PG8_LDA(At, 1, 1); PG8_STAGE(PG8_SB(1, 0), b3, voffB); PG8_STAGE(PG8_SB(1, 1), b3 + hstepB, voffB); PG8_STAGE(PG8_SA(1, 0), a3, voffA);
            PG8_WAIT_V(8); PG8_WAIT_L(0); PG8_BAR; PG8_MMA(1, 0, At, B0); PG8_MMA(1, 1, At, B1); PG8_BAR; PG8_SCHED;
        }
        if (wr == 0) PG8_BAR;
        run_epi(E, acc, cur, wr, wc, fr, fq, lds);
        if (!has_next) break;
#pragma unroll
        for (int a = 0; a < 2; ++a)
#pragma unroll
            for (int b = 0; b < 2; ++b)
#pragma unroll
                for (int m = 0; m < 4; ++m)
#pragma unroll
                    for (int n = 0; n < 2; ++n) acc[a][b][m][n] = (f32x4){0.f, 0.f, 0.f, 0.f};
        cur = nxt; cA = nA; cB = nB; ++ui;
        if (wr == 1) PG8_BAR;
    }
    PG8_WAIT_V(0);
    PG8_BAR;
#undef PG8_ABASE
#undef PG8_BBASE
#undef PG8_SA
#undef PG8_SB
#undef PG8_STAGE
#undef PG8_Q64
#undef PG8_Q64_voffA
#undef PG8_Q64_voffB
#undef PG8_LDA
#undef PG8_LDB
#undef PG8_MMA
#undef PG8_WAIT_V
#undef PG8_WAIT_L
#undef PG8_BAR
#undef PG8_SCHED
}
}

namespace att {
#define ATT_BAR() do { asm volatile("s_waitcnt lgkmcnt(0)" ::: "memory"); __builtin_amdgcn_s_barrier(); asm volatile("" ::: "memory"); } while (0)
constexpr int KST_B = 208  , VST_B = 144  ;
constexpr int KBYTES = 64 * KST_B, VBYTES = 64 * VST_B, BUFB = KBYTES + VBYTES;
__device__ __forceinline__ int crow(int r, int hi) { return (r & 3) + 8 * (r >> 2) + 4 * hi; }
constexpr int NSLOT = 4, NPIECE = 22;
__device__ __forceinline__ void attn_unit(int b, int h, int qb, const bf16* Q, const bf16* KN, const bf16* KR, const bf16* VT, bf16* OUT, LAS unsigned char* lds, const int tid) {
    const int lane = tid & 63, r32 = lane & 31, hi = lane >> 5, wid = __builtin_amdgcn_readfirstlane(tid >> 6);
    const size_t rowbase = (size_t)b * SEQ; const int q0 = qb * 256; const int qrow = q0 + wid * 32 + r32;
    const int NT = (q0 + 256) / 64;
    const char* gp[3]; unsigned ginc[3];
#pragma unroll
    for (int i = 0; i < 3; ++i) { const int p = wid + 8 * i;
        if (p < 13) { const int c = p * 64 + lane, row = c / 13, c16 = c % 13;
            if (c16 >= 8 && c16 < 12) { gp[i] = (const char*)(KR + (rowbase + row) * 32 + (c16 - 8) * 8); ginc[i] = 64 * 32 * 2; }
            else { gp[i] = (const char*)(KN + (rowbase + row) * 512 + h * 64 + (c16 < 8 ? c16 : 0) * 8); ginc[i] = 64 * 512 * 2; } }
        else { const int c = ((p < NPIECE ? p : 13) - 13) * 64 + lane, d = c / 9, c16 = c % 9;
            gp[i] = (const char*)(VT + (size_t)(h * 64 + d) * M + rowbase + (c16 < 8 ? c16 : 0) * 8); ginc[i] = 64 * 2; } }
#define ATT_DMA(t) do { LAS unsigned char* sl_ = lds + ((t) & (NSLOT - 1)) * BUFB + wid * 1024; \
        __builtin_amdgcn_global_load_lds((const unsigned*)(gp[0] + (size_t)(t) * ginc[0]), (LAS unsigned*)(sl_), 16, 0, 0); \
        __builtin_amdgcn_global_load_lds((const unsigned*)(gp[1] + (size_t)(t) * ginc[1]), (LAS unsigned*)(sl_ + 8192), 16, 0, 0); \
        if (wid < NPIECE - 16) __builtin_amdgcn_global_load_lds((const unsigned*)(gp[2] + (size_t)(t) * ginc[2]), (LAS unsigned*)(sl_ + 16384), 16, 0, 0); } while (0)
    bf16x8 qr[6];
    { const bf16* qp = Q + (rowbase + qrow) * 768 + h * 96 + hi * 8;
#pragma unroll
      for (int ks = 0; ks < 6; ++ks) qr[ks] = *(const bf16x8*)(qp + ks * 16); }
    asm volatile("s_waitcnt vmcnt(0)" ::: "memory");
    ATT_DMA(0); ATT_DMA(1); ATT_DMA(2);
    f32x16 o0, o1;
#pragma unroll
    for (int r = 0; r < 16; ++r) { o0[r] = 0.f; o1[r] = 0.f; }
    float mrun = 0.f, lrun = 0.f;
    f32x16 negm;
#pragma unroll
    for (int r = 0; r < 16; ++r) negm[r] = 0.f;
    const int qmin = q0 + wid * 32;
    asm volatile("s_waitcnt vmcnt(4)" ::: "memory");
    ATT_BAR();
    if (wid >= 4) ATT_BAR();
#pragma unroll 1
    for (int t = 0; t < NT; ++t) {
        if (t + 3 < NT) ATT_DMA(t + 3);
        const int kv0 = t * 64;
        const bool active = kv0 <= qmin + 31;
        bf16x8 vf0[4], vf1[4]; f32x16 p0, p1;
        if (active) {
            const LAS unsigned char* buf = lds + (t & (NSLOT - 1)) * BUFB;
            const LAS unsigned char* kb = buf + r32 * KST_B + hi * 16;
            const LAS unsigned char* vb = buf + KBYTES + r32 * VST_B + hi * 16;
#pragma unroll
            for (int s = 0; s < 4; ++s) { vf0[s] = *(const LAS bf16x8*)(vb + s * 32); vf1[s] = *(const LAS bf16x8*)(vb + 32 * VST_B + s * 32); }
            __builtin_amdgcn_sched_barrier(0);
#pragma unroll
            for (int ks = 0; ks < 6; ++ks) { const bf16x8 a0 = *(const LAS bf16x8*)(kb + ks * 32), a1 = *(const LAS bf16x8*)(kb + 32 * KST_B + ks * 32);
                if (ks == 0) { p0 = __builtin_amdgcn_mfma_f32_32x32x16_bf16(a0, qr[0], negm, 0, 0, 0); p1 = __builtin_amdgcn_mfma_f32_32x32x16_bf16(a1, qr[0], negm, 0, 0, 0); }
                else { p0 = __builtin_amdgcn_mfma_f32_32x32x16_bf16(a0, qr[ks], p0, 0, 0, 0); p1 = __builtin_amdgcn_mfma_f32_32x32x16_bf16(a1, qr[ks], p1, 0, 0, 0); } }
        }
        if (t + 3 < NT) asm volatile("s_waitcnt vmcnt(4)" ::: "memory");
        else asm volatile("s_waitcnt vmcnt(0)" ::: "memory");
        ATT_BAR();
        if (active) {
            if (kv0 + 63 > qmin) {
#pragma unroll
                for (int r = 0; r < 16; ++r) { const int kv = kv0 + crow(r, hi); if (kv > qrow) p0[r] = -1e30f; if (kv + 32 > qrow) p1[r] = -1e30f; }
            }
            float mx = __builtin_amdgcn_fmed3f(p0[0], p1[0], __builtin_inff());
#pragma unroll
            for (int r = 1; r < 16; ++r) { mx = __builtin_amdgcn_fmed3f(mx, p0[r], __builtin_inff()); mx = __builtin_amdgcn_fmed3f(mx, p1[r], __builtin_inff()); }
            { auto rr = __builtin_amdgcn_permlane32_swap(__float_as_uint(mx), __float_as_uint(mx), false, false); mx = fmaxf(__uint_as_float(rr[0]), __uint_as_float(rr[1])); }
            const bool first = (t == 0);
            if (first || __builtin_amdgcn_ballot_w64(mx > 0.f) != 0ull) {
                const float d = first ? mx : fmaxf(mx, 0.f); mrun += d;
                if (!first) { const float alpha = ex2(-d); lrun *= alpha;
#pragma unroll
                    for (int r = 0; r < 16; ++r) { o0[r] *= alpha; o1[r] *= alpha; } }
#pragma unroll
                for (int r = 0; r < 16; ++r) { p0[r] -= d; p1[r] -= d; negm[r] = -mrun; }
            }
            float rs0 = 0.f, rs1 = 0.f;
#pragma unroll
            for (int r = 0; r < 16; ++r) { p0[r] = ex2(p0[r]); p1[r] = ex2(p1[r]); rs0 += p0[r]; asm volatile("" : "+v"(rs0)); rs1 += p1[r]; asm volatile("" : "+v"(rs1)); }
            lrun += rs0 + rs1;
            u32x4 pw[4];
#pragma unroll
            for (int j = 0; j < 4; ++j) { pw[0][j] = pk2(p0[2 * j], p0[2 * j + 1]); pw[1][j] = pk2(p0[8 + 2 * j], p0[8 + 2 * j + 1]); pw[2][j] = pk2(p1[2 * j], p1[2 * j + 1]); pw[3][j] = pk2(p1[8 + 2 * j], p1[8 + 2 * j + 1]); }
#pragma unroll
            for (int s = 0; s < 4; ++s) { const bf16x8 pf = __builtin_bit_cast(bf16x8, pw[s]);
                o0 = __builtin_amdgcn_mfma_f32_32x32x16_bf16(vf0[s], pf, o0, 0, 0, 0); o1 = __builtin_amdgcn_mfma_f32_32x32x16_bf16(vf1[s], pf, o1, 0, 0, 0); }
        }
        ATT_BAR();
    }
    if (wid < 4) ATT_BAR();
#undef ATT_DMA
    float ltot; { auto rr = __builtin_amdgcn_permlane32_swap(__float_as_uint(lrun), __float_as_uint(lrun), false, false); ltot = __uint_as_float(rr[0]) + __uint_as_float(rr[1]); }
    const float inv = rcp(ltot);
    bf16* op = OUT + (rowbase + qrow) * 1024 + h * 64 + 4 * hi;
#pragma unroll
    for (int g = 0; g < 4; ++g) {
        u32x2 w0, w1; w0.x = pk2(o0[4 * g] * inv, o0[4 * g + 1] * inv); w0.y = pk2(o0[4 * g + 2] * inv, o0[4 * g + 3] * inv);
        w1.x = pk2(o1[4 * g] * inv, o1[4 * g + 1] * inv); w1.y = pk2(o1[4 * g + 2] * inv, o1[4 * g + 3] * inv);
        *(u32x2*)(op + 8 * g) = w0; *(u32x2*)(op + 32 + 8 * g) = w1; }
    asm volatile("s_waitcnt vmcnt(0)" ::: "memory");
}
}

constexpr size_t MiB = 1u << 20;
constexpr size_t WS_BAR = 32 * 1024;
constexpr size_t WS_SP8 = 0;
constexpr size_t WS_CA = 64 * 1024, WS_CB = WS_CA + 256 * 1024 * 4;
constexpr size_t WS_SSQ = 2 * MiB + 128 * 1024;
constexpr size_t WS_COS = 3 * MiB, WS_SIN = 5 * MiB;
constexpr size_t WS_MN = 7 * MiB;
constexpr size_t WS_MK = 9 * MiB;
constexpr size_t WS_MVT = 11 * MiB;
constexpr size_t WS_W = 13 * MiB;
constexpr size_t W_EVIN = WS_W, W_POOL = W_EVIN + 2 * MiB, W_QUP = W_POOL + MiB, W_KN = W_QUP + MiB, W_V = W_KN + MiB / 4, W_EVOUT = W_KN + MiB;
constexpr size_t W_ODIN = W_EVOUT + 2 * MiB, W_GATE = W_ODIN + 4 * MiB, W_ODOUT = W_GATE + MiB, W_XAQ = W_ODOUT + 2 * MiB  , W_XAKV = W_XAQ + 4 * MiB  ;
constexpr size_t W_XAO = W_XAKV + 8 * MiB  , W_FFN1 = W_XAO + 4 * MiB  , W_FFN2 = W_FFN1 + 22 * MiB  , W_END = W_FFN2 + 11 * MiB;
static_assert(W_END <= 80 * MiB, "weights");
constexpr size_t WS_XN = 80 * MiB;
constexpr size_t WS_MIX = 144 * MiB;
constexpr size_t WS_H = 208 * MiB;
constexpr size_t WS_U = 208 * MiB, WS_CQ = 240 * MiB, WS_CKV = 256 * MiB, WS_KR = 264 * MiB, WS_POOLED = 266 * MiB, WS_CQN = 298 * MiB, WS_CKVN = 314 * MiB, WS_Q = 322 * MiB;
constexpr size_t WS_KN = 384 * MiB, WS_VT = 416 * MiB;
constexpr size_t WS_XQ = 208 * MiB, WS_P = 272 * MiB;
constexpr size_t WS_GB = 208 * MiB, WS_XBP = 272 * MiB, WS_B = 272 * MiB, WS_A = 336 * MiB;
constexpr size_t WS_WPP = 470 * MiB;
constexpr size_t WS_WQK = 478 * MiB;
constexpr size_t WS_SA = 488 * MiB, WS_SB = 492 * MiB;
constexpr size_t WS_NEED = 496 * MiB;

struct Args {
    const float* x; const float* mem; const int* pos;
    const float *ev_norm, *ev_w_in, *ev_pool_w, *ev_pool_scale, *ev_q_norm, *ev_w_q_up, *ev_kv_norm, *ev_w_kv_up, *ev_w_out;
    const float *od_norm, *od_w_in, *od_conv_w, *od_conv_b, *od_w_rgate, *od_b_rgate, *od_w_igate, *od_b_igate, *od_lambda, *od_w_out;
    const float *xa_norm_x, *xa_norm_mem, *xa_w_q, *xa_w_kv, *xa_w_o, *ffn_norm, *ffn_w_gate_up, *ffn_w_down, *final_norm;
    float* out; unsigned char* ws; int ph_lo, ph_hi;
};

template <class RM> __device__ __forceinline__ void tr_matrix(const float* W, int K, int N, int ldd, RM rowptr, LAS float* scr, int gw, int NGW, int lane, int& rot, const float* kg = nullptr) {
    const int nblk = N / 32, nit = (K / 64) * nblk;
    int it = (gw - (rot % NGW) + NGW) % NGW;
    rot += nit;
    float r[32];
    const int lrow = lane >> 5, lcol = lane & 31;
    if (it < nit) { const float* src = W + (size_t)(64 * (it / nblk) + lrow) * N + 32 * (it % nblk) + lcol;
#pragma unroll
        for (int i = 0; i < 32; ++i) r[i] = src[(size_t)(2 * i) * N]; }
    for (; it < nit; it += NGW) {
        const int k0 = 64 * (it / nblk), n0 = 32 * (it % nblk);
#pragma unroll
        for (int i = 0; i < 32; ++i) scr[(2 * i + lrow) * 33 + lcol] = r[i];
        LDS_WAIT(); asm volatile("" ::: "memory");
        const int itn = it + NGW;
        if (itn < nit) { const float* src = W + (size_t)(64 * (itn / nblk) + lrow) * N + 32 * (itn % nblk) + lcol;
#pragma unroll
            for (int i = 0; i < 32; ++i) r[i] = src[(size_t)(2 * i) * N]; }
        const int c = lane & 7; bf16* dst = rowptr(n0);
        f32x4 g0 = (f32x4){1.f, 1.f, 1.f, 1.f}, g1 = g0;
        if (kg) { g0 = *(const f32x4*)(kg + k0 + 8 * c); g1 = *(const f32x4*)(kg + k0 + 8 * c + 4); }
#pragma unroll
        for (int j = 0; j < 4; ++j) { const int n = (lane >> 3) + 8 * j; const LAS float* s = scr + (8 * c) * 33 + n;
            u32x4 o; o.x = pk2(s[0 * 33] * g0[0], s[1 * 33] * g0[1]); o.y = pk2(s[2 * 33] * g0[2], s[3 * 33] * g0[3]); o.z = pk2(s[4 * 33] * g1[0], s[5 * 33] * g1[1]); o.w = pk2(s[6 * 33] * g1[2], s[7 * 33] * g1[3]);
            *(u32x4*)(dst + (size_t)n * ldd + k0 + 8 * c) = o; }
        LDS_WAIT(); asm volatile("" ::: "memory");
    }
}
__device__ __forceinline__ void rms_row_bf16(const float* xrow, const float* g, bf16* orow, int lane) {
    const f32x4* xr = (const f32x4*)xrow + lane; const f32x4* gr = (const f32x4*)g + lane;
    f32x4 v[4]; float s = 0.f;
#pragma unroll
    for (int j = 0; j < 4; ++j) { v[j] = xr[64 * j]; s += (v[j][0] * v[j][0] + v[j][1] * v[j][1]) + (v[j][2] * v[j][2] + v[j][3] * v[j][3]); }
    const float rstd = rsqrtf(wave_sum(s) * (1.f / D) + RMS_EPS);
#pragma unroll
    for (int j = 0; j < 4; ++j) { const f32x4 o = v[j] * rstd * gr[64 * j]; u32x2 w; w.x = pk2(o[0], o[1]); w.y = pk2(o[2], o[3]); *(u32x2*)(orow + 4 * lane + 256 * j) = w; }
}
__device__ __forceinline__ void norm_pass(const float* X, const float* g, bf16* XN, int gw, int NGW, int lane) {
    for (int m = gw; m < M; m += NGW) rms_row_bf16(X + (size_t)m * D, g, XN + (size_t)m * D, lane);
}

__device__ __forceinline__ int fresh_tid(int wave) { int l; asm volatile("v_mbcnt_lo_u32_b32 %0, -1, 0\n\tv_mbcnt_hi_u32_b32 %0, -1, %0" : "=v"(l)); return wave * 64 + l; }
#define XB_TMO      128
#define XB_XCNT(j)  (256  + 64 * (j))
#define XB_XSUB(j)  (1280 + 64 * (j))
#define XB_XGEN(j)  (2304 + 64 * (j))
#define XB_TOP      3328
#define XB_TOPGEN   3392
#define XCD_BAR_WORDS 3456
#define XB_SPIN_CAP (1u << 18)
__device__ __forceinline__ unsigned xb_ld(unsigned* p)              { return __hip_atomic_load(p, __ATOMIC_RELAXED, __HIP_MEMORY_SCOPE_AGENT); }
__device__ __forceinline__ unsigned xb_add(unsigned* p, unsigned v) { return __hip_atomic_fetch_add(p, v, __ATOMIC_RELAXED, __HIP_MEMORY_SCOPE_AGENT); }
__device__ __forceinline__ unsigned xb_xcc_id() { return (unsigned)__builtin_amdgcn_s_getreg((3 << 11) | 20) & 0xFu; }
#define XB_SPIN(cond, bar) do { unsigned _sp = 0; while (cond) { __builtin_amdgcn_s_sleep(1); \
    if ((++_sp & 255u) == 0u) { if (xb_ld(&(bar)[XB_TMO])) break; if (_sp > XB_SPIN_CAP) { atomicAdd(&(bar)[XB_TMO], 1u); break; } } } } while (0)
__device__ __forceinline__ void xcd_barrier_complete(unsigned* bar, unsigned x, unsigned G, unsigned& nloc, unsigned& nx) {
    unsigned sum, cnt, mine, sp = 0u;
    for (;;) {
        sum = 0u; cnt = 0u; mine = 0u;
#pragma unroll
        for (unsigned j = 0; j < 16; ++j) { const unsigned c = xb_ld(&bar[XB_XCNT(j)]); sum += c; cnt += (c > 0u) ? 1u : 0u; mine = (j == x) ? c : mine; }
        if (sum == G) break;
        __builtin_amdgcn_s_sleep(1);
        if ((++sp & 255u) == 0u) { if (xb_ld(&bar[XB_TMO])) break; if (sp > XB_SPIN_CAP) { atomicAdd(&bar[XB_TMO], 1u); break; } }
    }
    nloc = mine > 0u ? mine : 1u; nx = cnt > 0u ? cnt : 1u;
}
__device__ __forceinline__ void xcd_barrier(unsigned* bar, unsigned x, volatile LAS unsigned* st, unsigned G, int tid) {
    asm volatile("s_waitcnt vmcnt(0)" ::: "memory");
    __syncthreads();
    if (tid == 0) {
        __builtin_amdgcn_s_waitcnt(0);
        unsigned nloc = st[0], nx = st[1];
        if (nloc == 0u) { xcd_barrier_complete(bar, x, G, nloc, nx); st[0] = nloc; st[1] = nx; }
        const unsigned old = xb_add(&bar[XB_XSUB(x)], 1u);
        const unsigned gen = old / nloc;
        if (old + 1u == (gen + 1u) * nloc) {
            __builtin_amdgcn_fence(__ATOMIC_RELEASE, "agent");
            asm volatile("s_waitcnt vmcnt(0)" ::: "memory");
            const unsigned og = xb_add(&bar[XB_TOP], 1u);
            const unsigned tg = og / nx;
            if (og + 1u == (tg + 1u) * nx) xb_add(&bar[XB_TOPGEN], 1u);
            else XB_SPIN(xb_ld(&bar[XB_TOPGEN]) == tg, bar);
            __builtin_amdgcn_fence(__ATOMIC_ACQUIRE, "agent");
            xb_add(&bar[XB_XGEN(x)], 1u);
            asm volatile("s_waitcnt vmcnt(0)" ::: "memory");
        } else {
            XB_SPIN(xb_ld(&bar[XB_XGEN(x)]) == gen, bar);
            __builtin_amdgcn_fence(__ATOMIC_ACQUIRE, "agent");
            asm volatile("s_waitcnt vmcnt(0)" ::: "memory");
        }
    }
    __syncthreads();
}

typedef const __attribute__((address_space(4))) Args* KArgs;
__global__ void __launch_bounds__(NTHREADS, 2) hybrid_fwd(Args a_) {
    extern __shared__ __attribute__((aligned(16))) unsigned char lds_raw[];
    LAS unsigned char* lds = (LAS unsigned char*)lds_raw;
    cg::grid_group grid = cg::this_grid();
    const int wave = __builtin_amdgcn_readfirstlane(threadIdx.x >> 6);
    const int G = gridDim.x, bx = blockIdx.x;
    volatile LAS unsigned* const xst = (volatile LAS unsigned*)(lds + EPI_OFF + 16000);
    if (threadIdx.x == 0) { xst[0] = 0u; xst[1] = 0u; }
    if (threadIdx.x == 0) (void)xb_add((unsigned*)(a_.ws + WS_BAR) + XB_XCNT(xb_xcc_id()), 1u);
    __syncthreads();
    if (a_.ph_hi < 0) grid.sync();
    const int vcu = (G % 8 == 0) ? (bx % 8) * (G / 8) + bx / 8 : bx;
    const int gw = vcu * NWAVES + wave, NGW = G * NWAVES;
#ifndef PREFIX_K
#define PREFIX_K 0
#endif
#pragma unroll 1
    for (int pass = (PREFIX_K > 0 ? 0 : 1); pass < 2; ++pass) {
    const int lo = a_.ph_lo, hi = (pass == 0) ? PREFIX_K : a_.ph_hi;
    int ph = 0;
#define a (*ap)
#ifndef PROBE_MASK
#define PROBE_MASK (0ull)
#endif
#define PHASE_BEGIN if (lo <= ph && ph < hi) for (int rep_ = ((PROBE_MASK >> ph) & 1ull) ? 2 : 1; rep_ > 0; --rep_) { KArgs ap = (KArgs)__builtin_amdgcn_kernarg_segment_ptr(); asm volatile("" : "+s"(ap)); int lane; asm volatile("v_mbcnt_lo_u32_b32 %0, -1, 0\n\tv_mbcnt_hi_u32_b32 %0, -1, %0" : "=v"(lane)); const int tid = wave * 64 + lane; (void)tid; unsigned char* const ws = a.ws; float* const outp = a.out; \
    bf16* const XN = WSP(bf16, WS_XN); bf16* const MIX = WSP(bf16, WS_MIX); const float* cosT = WSP(float, WS_COS); const float* sinT = WSP(float, WS_SIN); (void)XN; (void)MIX; (void)cosT; (void)sinT; (void)outp;
#define PHASE_END   if (rep_ == 1 && (ph + 1 < hi || pass == 0)) { xcd_barrier((unsigned*)(ws + WS_BAR), xb_xcc_id(), (volatile LAS unsigned*)(lds + EPI_OFF + 16000), (unsigned)G, tid); } } ++ph;
#define WSP(T, off) ((T*)(ws + (off)))
    using pg8::Gemm; using pg8::Epi; using pg8::StaticOrder;

    PHASE_BEGIN
    {
        LAS float* scr = (LAS float*)(lds + wave * 16384);
        int rot = 0;
        tr_matrix(a.ev_w_in, 1024, 928, 1024, [&](int n0) { return WSP(bf16, W_EVIN) + (size_t)n0 * 1024; }, scr, gw, NGW, lane, rot);
        tr_matrix(a.ev_w_q_up, 256, 768, 256, [&](int n0) { return WSP(bf16, W_QUP) + (size_t)n0 * 256; }, scr, gw, NGW, lane, rot);
        tr_matrix(a.ev_w_kv_up, 128, 1024, 128, [&](int n0) { const int h = n0 >> 7, j0 = n0 & 127; return (j0 < 64 ? WSP(bf16, W_KN) : WSP(bf16, W_V)) + (size_t)(h * 64 + (j0 & 63)) * 128; }, scr, gw, NGW, lane, rot);
        tr_matrix(a.ev_w_out, 1024, 1024, 1024, [&](int n0) { return WSP(bf16, W_EVOUT) + (size_t)n0 * 1024; }, scr, gw, NGW, lane, rot);
        tr_matrix(a.od_w_in, 1024, 2048, 1024, [&](int n0) { return WSP(bf16, W_ODIN) + (size_t)n0 * 1024; }, scr, gw, NGW, lane, rot, a.od_norm);
        for (int h = 0; h < 4; ++h) {
            tr_matrix(a.od_w_rgate + (size_t)h * 65536, 256, 256, 256, [&](int n0) { return WSP(bf16, W_GATE) + (size_t)(256 * (2 * h + (n0 >> 7)) + (n0 & 127)) * 256; }, scr, gw, NGW, lane, rot);
            tr_matrix(a.od_w_igate + (size_t)h * 65536, 256, 256, 256, [&](int n0) { return WSP(bf16, W_GATE) + (size_t)(256 * (2 * h + (n0 >> 7)) + 128 + (n0 & 127)) * 256; }, scr, gw, NGW, lane, rot);
        }
        tr_matrix(a.od_w_out, 1024, 1024, 1024, [&](int n0) { return WSP(bf16, W_ODOUT) + (size_t)n0 * 1024; }, scr, gw, NGW, lane, rot);
        for (int l = 0; l < 2; ++l) {
            tr_matrix(a.xa_w_kv + (size_t)l * 2097152, 1024, 2048, 1024, [&](int n0) { return WSP(bf16, W_XAKV + l * 4 * MiB) + (size_t)n0 * 1024; }, scr, gw, NGW, lane, rot);
            tr_matrix(a.xa_w_o + (size_t)l * 1048576, 1024, 1024, 1024, [&](int n0) { return WSP(bf16, W_XAO + l * 2 * MiB) + (size_t)n0 * 1024; }, scr, gw, NGW, lane, rot);
            tr_matrix(a.ffn_w_gate_up + (size_t)l * 1024 * 5632, 1024, 5632, 1024, [&](int n0) { const int isu = n0 >= DFF, nn = isu ? n0 - DFF : n0; return WSP(bf16, W_FFN1 + l * 11 * MiB) + (size_t)(256 * (nn >> 7) + 128 * isu + (nn & 127)) * 1024; }, scr, gw, NGW, lane, rot, a.ffn_norm + l * D);
            tr_matrix(a.ffn_w_down + (size_t)l * DFF * 1024, DFF, 1024, DFF, [&](int n0) { return WSP(bf16, W_FFN2) + (size_t)l * (1024 * DFF) + (size_t)n0 * DFF; }, scr, gw, NGW, lane, rot);
        }
        const int gt = vcu * NTHREADS + tid, NGT = G * NTHREADS;
        for (int i = gt; i < 512 * 256; i += NGT) { const int n = i >> 8, kk = i & 255, g = n >> 7; float v = 0.f; if ((kk >> 7) == (g & 1)) v = a.ev_pool_w[(size_t)g * 16384 + (size_t)(kk & 127) * 128 + (n & 127)];
            WSP(bf16, W_POOL)[i] = (bf16)(pk2(v, 0.f) & 0xffffu); }
        for (int i = gt; i < 2 * 1024 * 128; i += NGT) { const int l = i >> 17, r = (i >> 7) & 1023, c8 = (i & 127) * 8; const float g = a.xa_norm_x[l * D + r];
            const f32x4 v0 = *(const f32x4*)(a.xa_w_q + (size_t)l * 1048576 + (size_t)r * 1024 + c8), v1 = *(const f32x4*)(a.xa_w_q + (size_t)l * 1048576 + (size_t)r * 1024 + c8 + 4);
            u32x4 o; o.x = pk2(v0[0] * g, v0[1] * g); o.y = pk2(v0[2] * g, v0[3] * g); o.z = pk2(v1[0] * g, v1[1] * g); o.w = pk2(v1[2] * g, v1[3] * g);
            *(u32x4*)(WSP(bf16, W_XAQ + l * 2 * MiB) + (size_t)r * 1024 + c8) = o; }
        for (int i = gt; i < M * 16; i += NGT) { const int row = i >> 4, j = i & 15; const int f = j & 3, e = j >> 2;
            const float fa = f == 0 ? 1.0f : (f == 1 ? 0.5623413251903491f : (f == 2 ? 0.31622776601683794f : 0.1778279410038923f));
            const float fb = e == 0 ? 1.0f : (e == 1 ? 0.1f : (e == 2 ? 0.01f : 0.001f));
            const float inv_freq = fa * fb; const float ang = (float)a.pos[row] * inv_freq;
            const double t = (double)ang * 0.15915494309189535; const float fr = (float)(t - __builtin_floor(t));
            WSP(float, WS_COS)[i] = __builtin_amdgcn_cosf(fr); WSP(float, WS_SIN)[i] = __builtin_amdgcn_sinf(fr); }
        for (int i = gt; i < 6 * M; i += NGT) WSP(float, WS_SSQ)[i] = 0.f;
        for (int i = gt; i < 1024; i += NGT) { const float l = a.od_lambda[i]; const float y = ex2(-l * LOG2E);
            const float sp = (y < 0.03f) ? y * (1.0f - y * (0.5f - y * (1.0f / 3.0f - 0.25f * y))) : 0.6931471805599453f * __builtin_amdgcn_logf(1.0f + y);
            WSP(float, WS_SP8)[i] = 8.0f * sp; }
        for (int r = gw; r < 1024; r += NGW) { const int l = r >> 9, mr = r & 511; rms_row_bf16(a.mem + (size_t)mr * D, a.xa_norm_mem + l * D, WSP(bf16, WS_MN) + (size_t)r * D, lane); }
        norm_pass(a.x, a.ev_norm, XN, gw, NGW, lane);
    }
    PHASE_END

    PHASE_BEGIN
    {
        { Gemm g = pg8::mk(XN, WSP(bf16, W_EVIN), M, 1024, 1024); StaticOrder S; S.init(M, 1024, G, bx);
          Epi E{}; E.mode = pg8::E_EVIN; E.O = WSP(bf16, WS_U); E.O2 = WSP(bf16, WS_CQ); E.O3 = WSP(bf16, WS_CKV); E.O4 = WSP(bf16, WS_KR); E.cosT = cosT; E.sinT = sinT;
          pg8::gemm_phase(lds, g, S, E, fresh_tid(wave)); }
    }
    PHASE_END

    PHASE_BEGIN
    {
        const int NMEMWG = (G >= 64) ? 32 : 0;
        if (bx < NMEMWG) {
            const int l = bx >> 4, isv = (bx >> 3) & 1;
            if (!isv) { Gemm g = pg8::mk(WSP(bf16, WS_MN) + (size_t)l * 512 * D, WSP(bf16, W_XAKV + l * 4 * MiB), 512, 1024, 1024); StaticOrder S; S.init(512, 1024, G, bx & 7);
              Epi E{}; E.mode = pg8::E_PLAIN; E.O = WSP(bf16, WS_MK) + (size_t)l * 512 * D; E.ldc = 1024; E.scale = 1.f; pg8::gemm_phase(lds, g, S, E, fresh_tid(wave)); }
            else { Gemm g = pg8::mk(WSP(bf16, WS_MN) + (size_t)l * 512 * D, WSP(bf16, W_XAKV + l * 4 * MiB) + (size_t)1024 * 1024, 512, 1024, 1024); StaticOrder S; S.init(512, 1024, G, bx & 7);
              Epi E{}; E.mode = pg8::E_PLAIN; E.O = WSP(bf16, WS_MVT) + (size_t)l * 512 * D; E.ldc = 1024; E.scale = 1.f; pg8::gemm_phase(lds, g, S, E, fresh_tid(wave)); }
        } else {
        const int gw = (bx - NMEMWG) * NWAVES + wave, NGW = (G - NMEMWG) * NWAVES;
        const bf16* U = WSP(bf16, WS_U); const bf16* CQ = WSP(bf16, WS_CQ); const bf16* CKV = WSP(bf16, WS_CKV);
        bf16* PO = WSP(bf16, WS_POOLED); bf16* CQN = WSP(bf16, WS_CQN); bf16* CKVN = WSP(bf16, WS_CKVN);
        const int w = 2 << (lane >> 4);
        const f32x4 gq = *(const f32x4*)(a.ev_q_norm + 4 * lane); const f32x2 gk = *(const f32x2*)(a.ev_kv_norm + 2 * lane);
        for (int row = gw; row < M; row += NGW) {
            const int s = row & (SEQ - 1); const int cnt = (s + 1 < w) ? s + 1 : w;
            float sum[8]; float self[8];
            { const u32x4 v = *(const u32x4*)(U + (size_t)row * 512 + 8 * lane);
              self[0] = bflo(v.x); self[1] = bfhi(v.x); self[2] = bflo(v.y); self[3] = bfhi(v.y); self[4] = bflo(v.z); self[5] = bfhi(v.z); self[6] = bflo(v.w); self[7] = bfhi(v.w);
#pragma unroll
              for (int e = 0; e < 8; ++e) sum[e] = self[e]; }
            for (int tt = 1; tt < cnt; ++tt) { const u32x4 v = *(const u32x4*)(U + (size_t)(row - tt) * 512 + 8 * lane);
                sum[0] += bflo(v.x); sum[1] += bfhi(v.x); sum[2] += bflo(v.y); sum[3] += bfhi(v.y); sum[4] += bflo(v.z); sum[5] += bfhi(v.z); sum[6] += bflo(v.w); sum[7] += bfhi(v.w); }
            const float ic = 1.0f / (float)cnt;
            u32x4 o; o.x = pk2(sum[0] * ic - self[0], sum[1] * ic - self[1]); o.y = pk2(sum[2] * ic - self[2], sum[3] * ic - self[3]);
            o.z = pk2(sum[4] * ic - self[4], sum[5] * ic - self[5]); o.w = pk2(sum[6] * ic - self[6], sum[7] * ic - self[7]);
            *(u32x4*)(PO + (size_t)row * 512 + 8 * lane) = o;
            { const u32x2 v = *(const u32x2*)(CQ + (size_t)row * 256 + 4 * lane); const float x0 = bflo(v.x), x1 = bfhi(v.x), x2 = bflo(v.y), x3 = bfhi(v.y);
              const float rstd = rsqrtf(wave_sum((x0 * x0 + x1 * x1) + (x2 * x2 + x3 * x3)) * (1.f / 256.f) + RMS_EPS);
              u32x2 q; q.x = pk2(x0 * rstd * gq[0], x1 * rstd * gq[1]); q.y = pk2(x2 * rstd * gq[2], x3 * rstd * gq[3]); *(u32x2*)(CQN + (size_t)row * 256 + 4 * lane) = q; }
            { const unsigned v = *(const unsigned*)(CKV + (size_t)row * 128 + 2 * lane); const float x0 = bflo(v), x1 = bfhi(v);
              const float rstd = rsqrtf(wave_sum(x0 * x0 + x1 * x1) * (1.f / 128.f) + RMS_EPS);
              *(unsigned*)(CKVN + (size_t)row * 128 + 2 * lane) = pk2(x0 * rstd * gk[0], x1 * rstd * gk[1]); }
        }
        }
    }
    PHASE_END

    PHASE_BEGIN
    {
        { Gemm g = pg8::mk(WSP(bf16, WS_CQN), WSP(bf16, W_QUP), M, 768, 256); StaticOrder S; S.init(M, 768, G, bx);
          Epi E{}; E.mode = pg8::E_QROPE; E.O = WSP(bf16, WS_Q); E.scale = 0.10206207261596577f * LOG2E; E.cosT = cosT; E.sinT = sinT; pg8::gemm_phase(lds, g, S, E, fresh_tid(wave)); }
        { Gemm g = pg8::mk(WSP(bf16, WS_CKVN), WSP(bf16, W_KN), M, 512, 128); StaticOrder S; S.init(M, 512, G, bx);
          Epi E{}; E.mode = pg8::E_PLAIN; E.O = WSP(bf16, WS_KN); E.ldc = 512; E.scale = 1.f; pg8::gemm_phase(lds, g, S, E, fresh_tid(wave)); }
        { Gemm g = pg8::mk(WSP(bf16, W_V), WSP(bf16, WS_CKVN), 512, M, 128); StaticOrder S; S.init(512, M, G, bx);
          Epi E{}; E.mode = pg8::E_VT; E.O = WSP(bf16, WS_VT); E.ldc = M; pg8::gemm_phase(lds, g, S, E, fresh_tid(wave)); }
        { Gemm g = pg8::mk(WSP(bf16, WS_POOLED), WSP(bf16, W_POOL), M, 512, 256); g.lda = 512; g.a_pm_off = 256L * 512; g.a_pn_off = 256; StaticOrder S; S.init(M, 512, G, bx);
          Epi E{}; E.mode = pg8::E_POOL; E.O = MIX; E.ldc = 1024; E.vec0 = a.ev_pool_scale; pg8::gemm_phase(lds, g, S, E, fresh_tid(wave)); }
        { const int idx = bx >> 2;
          if (idx < 16) { const int l = idx >> 3, b = (idx >> 2) & 1, h = idx & 3;
            Gemm g = pg8::mk(WSP(bf16, W_XAO + l * 2 * MiB) + h * 256, WSP(bf16, WS_MVT) + (size_t)l * 512 * D + (size_t)b * 256 * D + h * 256, 1024, 256, 256); g.lda = 1024; g.a_pm_off = 256L * 1024; g.ldb = 1024;
            StaticOrder S; S.init(1024, 256, G, bx & 3);
            Epi E{}; E.mode = pg8::E_PLAIN; E.O = WSP(bf16, WS_WPP) + (size_t)(l * 2 + b) * 1024 * 1024 + h * 256; E.ldc = 1024; E.scale = 1.f; pg8::gemm_phase(lds, g, S, E, fresh_tid(wave)); }
          else if (idx < 32) { const int i2 = idx - 16, l = i2 >> 3, b = (i2 >> 2) & 1, h = i2 & 3;
            Gemm g = pg8::mk(WSP(bf16, WS_MK) + (size_t)l * 512 * D + (size_t)b * 256 * D + h * 256, WSP(bf16, W_XAQ + l * 2 * MiB) + h * 256, 256, 1024, 256); g.lda = 1024; g.ldb = 1024; g.b_pn_off = 256L * 1024;
            StaticOrder S; S.init(256, 1024, G, bx & 3);
            Epi E{}; E.mode = pg8::E_PLAIN; E.O = WSP(bf16, WS_WQK) + (size_t)(l * 2 + b) * 1024 * 1024 + (size_t)h * 256 * 1024; E.ldc = 1024; E.scale = 1.f; pg8::gemm_phase(lds, g, S, E, fresh_tid(wave)); } }
    }
    PHASE_END

    PHASE_BEGIN
    {
        for (int vw = vcu; vw < 256; vw += G) { const int bh = vw >> 4, s = vw & 15;
#pragma unroll 1
            for (int i = 0; i < 4; ++i) { const int qb = (i == 0) ? 63 - s : (i == 1) ? s : (i == 2) ? 32 + s : 31 - s;
                size_t z0 = 0; asm volatile("" : "+s"(z0)); unsigned char* w2 = ws + z0;
                att::attn_unit(bh >> 3, bh & 7, qb, (const bf16*)(w2 + WS_Q), (const bf16*)(w2 + WS_KN), (const bf16*)(w2 + WS_KR), (const bf16*)(w2 + WS_VT), (bf16*)(w2 + WS_MIX) + 512, lds, fresh_tid(wave)); } }
    }
    PHASE_END

    PHASE_BEGIN
    { Gemm g = pg8::mk(MIX, WSP(bf16, W_EVOUT), M, 1024, 1024); StaticOrder S; S.init(M, 1024, G, bx);
      Epi E{}; E.mode = pg8::E_RES; E.base = a.x; E.out = outp; E.O = XN; E.aout = WSP(float, WS_SSQ); pg8::gemm_phase(lds, g, S, E, fresh_tid(wave)); }
    PHASE_END

#pragma unroll 1
    for (int l = 0; l < 2; ++l) {
        if (l == 1) {
            PHASE_BEGIN
            { Gemm g = pg8::mk(XN, WSP(bf16, W_ODIN), M, 2048, 1024); StaticOrder S; S.init(M, 2048, G, bx);
              Epi E{}; E.mode = pg8::E_ODIN; E.O = WSP(bf16, WS_GB); E.O2 = WSP(bf16, WS_XBP); E.vec0 = WSP(float, WS_SSQ) + 2 * (size_t)M; pg8::gemm_phase(lds, g, S, E, fresh_tid(wave)); }
            PHASE_END
            PHASE_BEGIN
            {
                const bf16* XBP = WSP(bf16, WS_XBP); bf16* XB = XN;
                const int half = gw & 1; const int c0 = half * 512 + 8 * lane;
                float wv[4][8], bias[8];
#pragma unroll
                for (int j = 0; j < 4; ++j)
#pragma unroll
                    for (int e = 0; e < 8; ++e) wv[j][e] = a.od_conv_w[j * 1024 + c0 + e];
#pragma unroll
                for (int e = 0; e < 8; ++e) bias[e] = a.od_conv_b[c0 + e];
                const int NW2 = NGW >> 1, RPW = (M + NW2 - 1) / NW2, r0 = (gw >> 1) * RPW, r1 = (r0 + RPW < M) ? r0 + RPW : M;
                float h1[8], h2[8], h3[8];
#pragma unroll
                for (int e = 0; e < 8; ++e) { h1[e] = 0.f; h2[e] = 0.f; h3[e] = 0.f; }
                if (r0 < M) { const int s0 = r0 & (SEQ - 1);
                    if (s0 >= 1) { const u32x4 v = *(const u32x4*)(XBP + (size_t)(r0 - 1) * D + c0); h1[0] = bflo(v.x); h1[1] = bfhi(v.x); h1[2] = bflo(v.y); h1[3] = bfhi(v.y); h1[4] = bflo(v.z); h1[5] = bfhi(v.z); h1[6] = bflo(v.w); h1[7] = bfhi(v.w); }
                    if (s0 >= 2) { const u32x4 v = *(const u32x4*)(XBP + (size_t)(r0 - 2) * D + c0); h2[0] = bflo(v.x); h2[1] = bfhi(v.x); h2[2] = bflo(v.y); h2[3] = bfhi(v.y); h2[4] = bflo(v.z); h2[5] = bfhi(v.z); h2[6] = bflo(v.w); h2[7] = bfhi(v.w); }
                    if (s0 >= 3) { const u32x4 v = *(const u32x4*)(XBP + (size_t)(r0 - 3) * D + c0); h3[0] = bflo(v.x); h3[1] = bfhi(v.x); h3[2] = bflo(v.y); h3[3] = bfhi(v.y); h3[4] = bflo(v.z); h3[5] = bfhi(v.z); h3[6] = bflo(v.w); h3[7] = bfhi(v.w); } }
                for (int rb = r0; rb < r1; rb += 8) {
                    u32x4 vv[8];
#pragma unroll
                    for (int q = 0; q < 8; ++q) { const int row = (rb + q < r1) ? rb + q : r1 - 1; vv[q] = *(const u32x4*)(XBP + (size_t)row * D + c0); }
#pragma unroll
                    for (int q = 0; q < 8; ++q) { const int row = rb + q;
                        if (row < r1) {
                            if ((row & (SEQ - 1)) == 0) {
#pragma unroll
                                for (int e = 0; e < 8; ++e) { h1[e] = 0.f; h2[e] = 0.f; h3[e] = 0.f; } }
                            const float cur[8] = {bflo(vv[q].x), bfhi(vv[q].x), bflo(vv[q].y), bfhi(vv[q].y), bflo(vv[q].z), bfhi(vv[q].z), bflo(vv[q].w), bfhi(vv[q].w)};
                            float acc[8];
#pragma unroll
                            for (int e = 0; e < 8; ++e) { acc[e] = bias[e] + wv[0][e] * h3[e] + wv[1][e] * h2[e] + wv[2][e] * h1[e] + wv[3][e] * cur[e]; h3[e] = h2[e]; h2[e] = h1[e]; h1[e] = cur[e]; }
                            u32x4 o; o.x = pk2(acc[0], acc[1]); o.y = pk2(acc[2], acc[3]); o.z = pk2(acc[4], acc[5]); o.w = pk2(acc[6], acc[7]);
                            *(u32x4*)(XB + (size_t)row * D + c0) = o; } }
                }
            }
            PHASE_END
            PHASE_BEGIN
            { Gemm g = pg8::mk(XN, WSP(bf16, W_GATE), M, 2048, 256); g.lda = 1024; g.a_pm_off = 256L * 1024; g.a_pn_off = 256; g.a_pn_shift = 1; StaticOrder S; S.init(M, 2048, G, bx);
              Epi E{}; E.mode = pg8::E_GATE; E.O = WSP(bf16, WS_B); E.aout = WSP(float, WS_A); E.vec0 = a.od_b_rgate; E.vec1 = a.od_b_igate; E.vec2 = WSP(float, WS_SP8); E.pos = a.pos; E.xb = XN;
              pg8::gemm_phase(lds, g, S, E, fresh_tid(wave)); }
            PHASE_END
            PHASE_BEGIN
            {
                const float* A_ = WSP(float, WS_A); const bf16* B_ = WSP(bf16, WS_B);
                const int grp = tid >> 7, c = 8 * (tid & 127);
                LAS float* X = (LAS float*)lds;
                for (int it = vcu; it < 256; it += G) { const size_t r0 = (size_t)it * 128 + 32 * grp;
                    float A[8], B[8];
#pragma unroll
                    for (int e = 0; e < 8; ++e) { A[e] = 1.f; B[e] = 0.f; }
#pragma unroll 8
                    for (int t = 0; t < 32; ++t) { const f32x4 a0 = *(const f32x4*)(A_ + (r0 + t) * D + c), a1 = *(const f32x4*)(A_ + (r0 + t) * D + c + 4); const u32x4 bw = *(const u32x4*)(B_ + (r0 + t) * D + c);
                        const float av[8] = {a0[0], a0[1], a0[2], a0[3], a1[0], a1[1], a1[2], a1[3]}; const float bv[8] = {bflo(bw.x), bfhi(bw.x), bflo(bw.y), bfhi(bw.y), bflo(bw.z), bfhi(bw.z), bflo(bw.w), bfhi(bw.w)};
#pragma unroll
                        for (int e = 0; e < 8; ++e) { B[e] = av[e] * B[e] + bv[e]; A[e] *= av[e]; } }
                    float* sa = WSP(float, WS_SA) + ((size_t)it * 4 + grp) * D + c; float* sb = WSP(float, WS_SB) + ((size_t)it * 4 + grp) * D + c;
                    *(f32x4*)sa = (f32x4){A[0], A[1], A[2], A[3]}; *(f32x4*)(sa + 4) = (f32x4){A[4], A[5], A[6], A[7]};
                    *(f32x4*)sb = (f32x4){B[0], B[1], B[2], B[3]}; *(f32x4*)(sb + 4) = (f32x4){B[4], B[5], B[6], B[7]};
                    LAS float* xp = X + (grp * 128 + (tid & 127)) * 16;
#pragma unroll
                    for (int e = 0; e < 8; ++e) { xp[e] = A[e]; xp[8 + e] = B[e]; }
                    __syncthreads();
                    if (grp == 0) { float CA_[8], CB_[8];
#pragma unroll
                        for (int e = 0; e < 8; ++e) { CA_[e] = A[e]; CB_[e] = B[e]; }
#pragma unroll
                        for (int g2 = 1; g2 < 4; ++g2) { const LAS float* yp = X + (g2 * 128 + tid) * 16;
#pragma unroll
                            for (int e = 0; e < 8; ++e) { const float a2 = yp[e], b2 = yp[8 + e]; CB_[e] = a2 * CB_[e] + b2; CA_[e] *= a2; } }
                        float* ca = WSP(float, WS_CA) + (size_t)it * D + c; float* cb = WSP(float, WS_CB) + (size_t)it * D + c;
                        *(f32x4*)ca = (f32x4){CA_[0], CA_[1], CA_[2], CA_[3]}; *(f32x4*)(ca + 4) = (f32x4){CA_[4], CA_[5], CA_[6], CA_[7]};
                        *(f32x4*)cb = (f32x4){CB_[0], CB_[1], CB_[2], CB_[3]}; *(f32x4*)(cb + 4) = (f32x4){CB_[4], CB_[5], CB_[6], CB_[7]}; }
                    __syncthreads(); }
            }
            PHASE_END
            PHASE_BEGIN
            {
                const float* A_ = WSP(float, WS_A); const bf16* B_ = WSP(bf16, WS_B); const bf16* GB = WSP(bf16, WS_GB);
                const int grp = tid >> 7, c = 8 * (tid & 127);
                for (int it = vcu; it < 256; it += G) { const size_t r0 = (size_t)it * 128 + 32 * grp; const int j = it & 127, it0 = it - j;
                    float h[8];
                    { float PA[8], PB[8];
#pragma unroll
                      for (int e = 0; e < 8; ++e) { PA[e] = 1.f; PB[e] = 0.f; }
                      const int q0 = (j * grp) >> 2, q1 = (j * (grp + 1)) >> 2;
#pragma unroll 4
                      for (int jj = q0; jj < q1; ++jj) { const float* ca = WSP(float, WS_CA) + (size_t)(it0 + jj) * D + c; const float* cb = WSP(float, WS_CB) + (size_t)(it0 + jj) * D + c;
                          const f32x4 a0 = *(const f32x4*)ca, a1 = *(const f32x4*)(ca + 4), b0 = *(const f32x4*)cb, b1 = *(const f32x4*)(cb + 4);
#pragma unroll
                          for (int e = 0; e < 4; ++e) { PB[e] = a0[e] * PB[e] + b0[e]; PA[e] *= a0[e]; PB[4 + e] = a1[e] * PB[4 + e] + b1[e]; PA[4 + e] *= a1[e]; } }
                      LAS float* X = (LAS float*)lds; LAS float* xp = X + (grp * 128 + (tid & 127)) * 16;
#pragma unroll
                      for (int e = 0; e < 8; ++e) { xp[e] = PA[e]; xp[8 + e] = PB[e]; }
                      __syncthreads();
#pragma unroll
                      for (int e = 0; e < 8; ++e) h[e] = 0.f;
#pragma unroll
                      for (int g2 = 0; g2 < 4; ++g2) { const LAS float* yp = X + (g2 * 128 + (tid & 127)) * 16;
#pragma unroll
                          for (int e = 0; e < 8; ++e) h[e] = yp[e] * h[e] + yp[8 + e]; }
                      __syncthreads(); }
                    for (int g2 = 0; g2 < grp; ++g2) { const float* sa = WSP(float, WS_SA) + ((size_t)it * 4 + g2) * D + c; const float* sb = WSP(float, WS_SB) + ((size_t)it * 4 + g2) * D + c;
                        const f32x4 a0 = *(const f32x4*)sa, a1 = *(const f32x4*)(sa + 4), b0 = *(const f32x4*)sb, b1 = *(const f32x4*)(sb + 4);
#pragma unroll
                        for (int e = 0; e < 4; ++e) { h[e] = a0[e] * h[e] + b0[e]; h[4 + e] = a1[e] * h[4 + e] + b1[e]; } }
#pragma unroll 8
                    for (int t = 0; t < 32; ++t) { const f32x4 a0 = *(const f32x4*)(A_ + (r0 + t) * D + c), a1 = *(const f32x4*)(A_ + (r0 + t) * D + c + 4); const u32x4 bw = *(const u32x4*)(B_ + (r0 + t) * D + c), gv = *(const u32x4*)(GB + (r0 + t) * D + c);
                        const float av[8] = {a0[0], a0[1], a0[2], a0[3], a1[0], a1[1], a1[2], a1[3]}; const float bv[8] = {bflo(bw.x), bfhi(bw.x), bflo(bw.y), bfhi(bw.y), bflo(bw.z), bfhi(bw.z), bflo(bw.w), bfhi(bw.w)};
                        const float gg[8] = {bflo(gv.x), bfhi(gv.x), bflo(gv.y), bfhi(gv.y), bflo(gv.z), bfhi(gv.z), bflo(gv.w), bfhi(gv.w)};
#pragma unroll
                        for (int e = 0; e < 8; ++e) h[e] = av[e] * h[e] + bv[e];
                        u32x4 o; o.x = pk2(gg[0] * h[0], gg[1] * h[1]); o.y = pk2(gg[2] * h[2], gg[3] * h[3]); o.z = pk2(gg[4] * h[4], gg[5] * h[5]); o.w = pk2(gg[6] * h[6], gg[7] * h[7]);
                        *(u32x4*)(MIX + (r0 + t) * D + c) = o; }
                }
            }
            PHASE_END
            PHASE_BEGIN
            { Gemm g = pg8::mk(MIX, WSP(bf16, W_ODOUT), M, 1024, 1024); StaticOrder S; S.init(M, 1024, G, bx);
              Epi E{}; E.mode = pg8::E_RES; E.base = outp; E.out = outp; E.O = XN; E.aout = WSP(float, WS_SSQ) + 3 * (size_t)M; pg8::gemm_phase(lds, g, S, E, fresh_tid(wave)); }
            PHASE_END
        }
        PHASE_BEGIN
        { Gemm g = pg8::mk(XN, WSP(bf16, WS_WQK) + (size_t)l * 2 * 1024 * 1024, M, 1024, 1024); g.b_pm_div = 64; g.b_pm_off = 1024L * 1024; StaticOrder S; S.init(M, 1024, G, bx);
          Epi E{}; E.mode = pg8::E_SOFTMAX; E.O = WSP(bf16, WS_P); E.ldc = 1024; E.scale = 0.0625f * LOG2E; E.vec0 = WSP(float, WS_SSQ) + (size_t)(3 * l) * M; pg8::gemm_phase(lds, g, S, E, fresh_tid(wave)); }
        PHASE_END
        PHASE_BEGIN
        { Gemm g = pg8::mk(WSP(bf16, WS_P), WSP(bf16, WS_WPP) + (size_t)l * 2 * 1024 * 1024, M, 1024, 1024); g.b_pm_div = 64; g.b_pm_off = 1024L * 1024; StaticOrder S; S.init(M, 1024, G, bx);
          Epi E{}; E.mode = pg8::E_RES; E.base = outp; E.out = outp; E.O = XN; E.aout = WSP(float, WS_SSQ) + (size_t)(3 * l + 1) * M; pg8::gemm_phase(lds, g, S, E, fresh_tid(wave)); }
        PHASE_END
        PHASE_BEGIN
        { Gemm g = pg8::mk(XN, WSP(bf16, W_FFN1 + l * 11 * MiB), M, 2 * DFF, 1024); StaticOrder S; S.init(M, 2 * DFF, G, bx);
          Epi E{}; E.mode = pg8::E_SWIGLU; E.O = WSP(bf16, WS_H); E.vec0 = WSP(float, WS_SSQ) + (size_t)(3 * l + 1) * M; pg8::gemm_phase(lds, g, S, E, fresh_tid(wave)); }
        PHASE_END
        PHASE_BEGIN
        { Gemm g = pg8::mk(WSP(bf16, WS_H), WSP(bf16, W_FFN2) + (size_t)l * (1024 * DFF), M, 1024, DFF); StaticOrder S; S.init(M, 1024, G, bx);
          Epi E{}; E.mode = pg8::E_RES; E.base = outp; E.out = outp; E.O = (l == 0) ? XN : nullptr; E.aout = WSP(float, WS_SSQ) + (size_t)(l == 0 ? 2 : 5) * M; pg8::gemm_phase(lds, g, S, E, fresh_tid(wave)); }
        PHASE_END
    }

    PHASE_BEGIN
    {
        const f32x4* gr = (const f32x4*)a.final_norm + lane; const float* ssq = WSP(float, WS_SSQ) + 5 * (size_t)M;
        f32x4 gg[4];
#pragma unroll
        for (int j = 0; j < 4; ++j) gg[j] = gr[64 * j];
        int m = gw;
        for (; m + 3 * NGW < M; m += 4 * NGW) {
            f32x4 v[4][4]; float rs[4];
#pragma unroll
            for (int q = 0; q < 4; ++q) { const f32x4* xr = (const f32x4*)(outp + (size_t)(m + q * NGW) * D) + lane; rs[q] = ssq[m + q * NGW];
#pragma unroll
                for (int j = 0; j < 4; ++j) v[q][j] = xr[64 * j]; }
#pragma unroll
            for (int q = 0; q < 4; ++q) { f32x4* xr = (f32x4*)(outp + (size_t)(m + q * NGW) * D) + lane; const float rstd = rsqrtf(rs[q] * (1.f / D) + RMS_EPS);
#pragma unroll
                for (int j = 0; j < 4; ++j) xr[64 * j] = v[q][j] * rstd * gg[j]; }
        }
        for (; m < M; m += NGW) { f32x4* xr = (f32x4*)(outp + (size_t)m * D) + lane; const float rstd = rsqrtf(ssq[m] * (1.f / D) + RMS_EPS);
#pragma unroll
            for (int j = 0; j < 4; ++j) xr[64 * j] = xr[64 * j] * rstd * gg[j]; }
    }
    PHASE_END
    }
}
#undef a
constexpr int N_PHASES = 6 + 6 + 8 + 1;

#ifndef MK_N_LAUNCHES
#define MK_N_LAUNCHES 1
#endif
extern "C" void kernel_launch(void* const* d_in, const int* in_sizes, int n_in, void* d_out, int out_size, void* d_ws, size_t ws_size, hipStream_t stream) {
    static int grid = 0;
    if (grid == 0) {
        if (n_in != 31 || ws_size < WS_NEED) { fprintf(stderr, "kernel_launch: unexpected n_in %d or ws_size %zu\n", n_in, ws_size); grid = -1; return; }
        int dev = 0, cus = 0, per_cu = 0;
        hipGetDevice(&dev); hipDeviceGetAttribute(&cus, hipDeviceAttributeMultiprocessorCount, dev);
        if (hipFuncSetAttribute((const void*)hybrid_fwd, hipFuncAttributeMaxDynamicSharedMemorySize, LDS_BYTES) != hipSuccess) { fprintf(stderr, "kernel_launch: hipFuncSetAttribute failed\n"); grid = -1; return; }
        hipOccupancyMaxActiveBlocksPerMultiprocessor(&per_cu, (const void*)hybrid_fwd, NTHREADS, LDS_BYTES);
        (void)hipGetLastError();
        if (per_cu < 1) per_cu = 1;
        grid = cus * 1;
        if (grid > 256) grid = 256;
    }
    if (grid < 0) return;
    Args a{};
    const float* const* f = (const float* const*)d_in;
    a.x = f[0]; a.mem = f[1]; a.pos = (const int*)d_in[2];
    a.ev_norm = f[3]; a.ev_w_in = f[4]; a.ev_pool_w = f[5]; a.ev_pool_scale = f[6]; a.ev_q_norm = f[7]; a.ev_w_q_up = f[8]; a.ev_kv_norm = f[9]; a.ev_w_kv_up = f[10]; a.ev_w_out = f[11];
    a.od_norm = f[12]; a.od_w_in = f[13]; a.od_conv_w = f[14]; a.od_conv_b = f[15]; a.od_w_rgate = f[16]; a.od_b_rgate = f[17]; a.od_w_igate = f[18]; a.od_b_igate = f[19]; a.od_lambda = f[20]; a.od_w_out = f[21];
    a.xa_norm_x = f[22]; a.xa_norm_mem = f[23]; a.xa_w_q = f[24]; a.xa_w_kv = f[25]; a.xa_w_o = f[26]; a.ffn_norm = f[27]; a.ffn_w_gate_up = f[28]; a.ffn_w_down = f[29]; a.final_norm = f[30];
    a.out = (float*)d_out; a.ws = (unsigned char*)d_ws;
#if MK_N_LAUNCHES == 1
    if (hipMemsetAsync((unsigned char*)d_ws + WS_BAR, 0, 16384, stream) != hipSuccess) { fprintf(stderr, "kernel_launch: memset failed\n"); return; }
    a.ph_lo = 0; a.ph_hi = N_PHASES;
    void* args[] = {&a};
    hipError_t e = hipLaunchCooperativeKernel((const void*)hybrid_fwd, dim3(grid), dim3(NTHREADS), args, LDS_BYTES, stream);
    if (e != hipSuccess) fprintf(stderr, "kernel_launch: cooperative launch failed: %s (grid %d)\n", hipGetErrorString(e), grid);
#else
    for (int p = 0; p < N_PHASES; ++p) { a.ph_lo = p; a.ph_hi = p + 1; hipLaunchKernelGGL(hybrid_fwd, dim3(grid), dim3(NTHREADS), LDS_BYTES, stream, a); }
#endif
}
```
